# Optimizing an MI355X kernel written in HIP

```python
import jax, jax.numpy as jnp
from jax import lax
import numpy as np

D_MODEL = 1024
BATCH = 16
SEQ = 2048
DEPTH = 1
DEC_BATCH = 16
DEC_SEQ = 32
PAST_LEN = 2048

CHUNK = 64
D_RNN = 1024
N_RNN_HEADS = 16
RNN_HEAD_DIM = D_RNN // N_RNN_HEADS
CONV_W = 4
LRU_C = 8.0
D_GMLP = 1024
N_GMLP_GROUPS = 8
GMLP_GROUP_DIM = D_GMLP // N_GMLP_GROUPS
MLP_CHUNK = 128
D_FF = ((8 * D_MODEL // 3 + 255) // 256) * 256
D_IN = 2 * D_RNN + 2 * D_GMLP + 2 * D_MODEL
EPS = 1e-6

kernel_name = "hawk_gmlp_parallel_streaming_encoder"


def rmsnorm(x, g):
    xf = x.astype(jnp.float32)
    y = xf * lax.rsqrt(jnp.mean(xf * xf, axis=-1, keepdims=True) + EPS) * g.astype(jnp.float32)
    return y.astype(x.dtype)


def layernorm(x, g, b):
    xf = x.astype(jnp.float32)
    mu = jnp.mean(xf, axis=-1, keepdims=True)
    var = jnp.mean(jnp.square(xf - mu), axis=-1, keepdims=True)
    y = (xf - mu) * lax.rsqrt(var + EPS) * g.astype(jnp.float32) + b.astype(jnp.float32)
    return y.astype(x.dtype)


def causal_conv(x, prev, w, b):
    T = x.shape[1]
    xp = jnp.concatenate([prev.astype(x.dtype), x], axis=1)
    y = b + sum(xp[:, k:k + T] * w[k] for k in range(CONV_W))
    return y, xp[:, -(CONV_W - 1):]


def _lin_combine(left, right):
    a1, b1 = left
    a2, b2 = right
    return a1 * a2, a2 * b1 + b2


def rglru(x, h0, w_a, b_a, w_x, b_x, lam):
    B, T, _ = x.shape
    xh = x.reshape(B, T, N_RNN_HEADS, RNN_HEAD_DIM)
    r = jax.nn.sigmoid(jnp.einsum('bthi,hij->bthj', xh, w_a) + b_a).reshape(B, T, D_RNN)
    i = jax.nn.sigmoid(jnp.einsum('bthi,hij->bthj', xh, w_x) + b_x).reshape(B, T, D_RNN)
    log_a = -LRU_C * r.astype(jnp.float32) * jax.nn.softplus(-lam.astype(jnp.float32))
    a = jnp.exp(log_a)
    mult = jnp.sqrt(-jnp.expm1(2.0 * log_a))
    u = mult * (i * x).astype(jnp.float32)
    u = u.at[:, 0].add(a[:, 0] * h0.astype(jnp.float32))
    _, h = lax.associative_scan(_lin_combine, (a, u), axis=1)
    return h.astype(x.dtype), h[:, -1].astype(x.dtype)


def spatial_gate(v, w_s, b_s):
    B, T, _ = v.shape
    L = min(T, MLP_CHUNK)
    N = T // L
    vh = v.reshape(B, N, L, N_GMLP_GROUPS, GMLP_GROUP_DIM)
    pos = jnp.arange(L)
    mask = (pos[None, :] // CHUNK) <= (pos[:, None] // CHUNK)
    w = jnp.where(mask[None], w_s[:, :L, :L], jnp.zeros((), w_s.dtype))
    out = jnp.einsum('gpq,bnqgd->bnpgd', w, vh) + b_s[:, :L].T[None, None, :, :, None]
    return out.reshape(B, T, D_GMLP)


def layer(x, h0, conv_prev, g_pre_mix, w_in, conv_w, conv_b, w_a, b_a, w_x, b_x, lam,
          w_br_a, ln_g, ln_b, w_s, b_s, w_br_b, w_out, g_post_mix,
          g_pre_ffn, w_ffn_in, w_ffn_out, g_post_ffn):
    xn = rmsnorm(x, g_pre_mix)
    z = xn @ w_in
    xa, ga, u, v, gates = jnp.split(
        z, [D_RNN, 2 * D_RNN, 2 * D_RNN + D_GMLP, 2 * D_RNN + 2 * D_GMLP], axis=-1)
    xc, conv_new = causal_conv(xa, conv_prev, conv_w, conv_b)
    hseq, h_last = rglru(xc, h0, w_a, b_a, w_x, b_x, lam)
    o_a = (hseq * jax.nn.gelu(ga)) @ w_br_a
    vn = layernorm(jax.nn.gelu(v), ln_g, ln_b)
    o_b = (jax.nn.gelu(u) * spatial_gate(vn, w_s, b_s)) @ w_br_b
    g_a, g_b = jnp.split(jax.nn.sigmoid(gates), 2, axis=-1)
    mix = (g_a * o_a + g_b * o_b) @ w_out
    x = x + rmsnorm(mix, g_post_mix)
    hn = rmsnorm(x, g_pre_ffn)
    gate, up = jnp.split(hn @ w_ffn_in, 2, axis=-1)
    f = (jax.nn.silu(gate) * up) @ w_ffn_out
    x = x + rmsnorm(f, g_post_ffn)
    return x, h_last, conv_new, vn


def setup_inputs(seed: int = 0) -> dict:
    key = jax.random.key(seed)
    ks = jax.random.split(key, 32)
    f32 = jnp.float32

    def nrm(k, shape, scale):
        return jax.random.normal(k, shape, f32) * scale

    def gain(k, shape):
        return 1.0 + 0.05 * jax.random.normal(k, shape, f32)

    a0 = jax.random.uniform(ks[11], (DEPTH, D_RNN), f32, 0.9, 0.999)
    sp = -jnp.log(a0) / LRU_C
    lam = -jnp.log(jnp.expm1(sp))
    return {
        "x_prompt": nrm(ks[0], (BATCH, SEQ, D_MODEL), 1.0),
        "x_sample": nrm(ks[1], (DEC_BATCH, DEC_SEQ, D_MODEL), 1.0),
        "state_rglru_h": nrm(ks[2], (DEPTH, DEC_BATCH, D_RNN), 0.5),
        "state_rglru_conv": nrm(ks[3], (DEPTH, DEC_BATCH, CONV_W - 1, D_RNN), 1.0),
        "g_pre_mix": gain(ks[4], (DEPTH, D_MODEL)),
        "w_in": nrm(ks[5], (DEPTH, D_MODEL, D_IN), D_MODEL ** -0.5),
        "conv_w": nrm(ks[6], (DEPTH, CONV_W, D_RNN), CONV_W ** -0.5),
        "conv_b": nrm(ks[7], (DEPTH, D_RNN), 0.01),
        "w_a": nrm(ks[8], (DEPTH, N_RNN_HEADS, RNN_HEAD_DIM, RNN_HEAD_DIM), RNN_HEAD_DIM ** -0.5),
        "b_a": nrm(ks[9], (DEPTH, N_RNN_HEADS, RNN_HEAD_DIM), 0.01),
        "w_x": nrm(ks[10], (DEPTH, N_RNN_HEADS, RNN_HEAD_DIM, RNN_HEAD_DIM), RNN_HEAD_DIM ** -0.5),
        "b_x": nrm(ks[12], (DEPTH, N_RNN_HEADS, RNN_HEAD_DIM), 0.01),
        "lam": lam,
        "w_br_a": nrm(ks[13], (DEPTH, D_RNN, D_MODEL), D_RNN ** -0.5),
        "ln_g": gain(ks[14], (DEPTH, D_GMLP)),
        "ln_b": nrm(ks[15], (DEPTH, D_GMLP), 0.01),
        "w_s": nrm(ks[16], (DEPTH, N_GMLP_GROUPS, MLP_CHUNK, MLP_CHUNK), MLP_CHUNK ** -0.5),
        "b_s": gain(ks[17], (DEPTH, N_GMLP_GROUPS, MLP_CHUNK)),
        "w_br_b": nrm(ks[18], (DEPTH, D_GMLP, D_MODEL), D_GMLP ** -0.5),
        "w_out": nrm(ks[19], (DEPTH, D_MODEL, D_MODEL), D_MODEL ** -0.5),
        "g_post_mix": gain(ks[20], (DEPTH, D_MODEL)),
        "g_pre_ffn": gain(ks[21], (DEPTH, D_MODEL)),
        "w_ffn_in": nrm(ks[22], (DEPTH, D_MODEL, 2 * D_FF), D_MODEL ** -0.5),
        "w_ffn_out": nrm(ks[23], (DEPTH, D_FF, D_MODEL), D_FF ** -0.5),
        "g_post_ffn": gain(ks[24], (DEPTH, D_MODEL)),
    }


def reference(x_prompt, x_sample, state_rglru_h, state_rglru_conv,
              g_pre_mix, w_in, conv_w, conv_b, w_a, b_a, w_x, b_x, lam,
              w_br_a, ln_g, ln_b, w_s, b_s, w_br_b, w_out, g_post_mix,
              g_pre_ffn, w_ffn_in, w_ffn_out, g_post_ffn):
    xp = x_prompt
    xs = x_sample
    bp = x_prompt.shape[0]
    hp_list, cp_list, hs_list, cs_list, vs_list = [], [], [], [], []
    for l in range(DEPTH):
        params = (g_pre_mix[l], w_in[l], conv_w[l], conv_b[l], w_a[l], b_a[l], w_x[l], b_x[l], lam[l],
                  w_br_a[l], ln_g[l], ln_b[l], w_s[l], b_s[l], w_br_b[l], w_out[l], g_post_mix[l],
                  g_pre_ffn[l], w_ffn_in[l], w_ffn_out[l], g_post_ffn[l])
        h0_p = jnp.zeros((bp, D_RNN), xp.dtype)
        c0_p = jnp.zeros((bp, CONV_W - 1, D_RNN), xp.dtype)
        xp, hp, cp, _ = layer(xp, h0_p, c0_p, *params)
        xs, hs, cs, vs = layer(xs, state_rglru_h[l], state_rglru_conv[l], *params)
        hp_list.append(hp)
        cp_list.append(cp)
        hs_list.append(hs)
        cs_list.append(cs)
        vs_list.append(vs)
    new_h_prompt = jnp.stack(hp_list)
    new_conv_prompt = jnp.stack(cp_list)
    new_h_sample = jnp.stack(hs_list)
    new_conv_sample = jnp.stack(cs_list)
    new_v_sample = jnp.stack(vs_list)
    return (xp, xs, new_h_prompt, new_conv_prompt, new_h_sample, new_conv_sample, new_v_sample)
```

```cpp
#include <hip/hip_runtime.h>
#include <cstdio>
#include <cstdint>

#ifndef MK_N_LAUNCHES
#define MK_N_LAUNCHES 1
#endif

namespace pg8 {
#define PG8_LAS __attribute__((address_space(3)))
typedef unsigned short bf16_t;
typedef short bf16x8 __attribute__((ext_vector_type(8)));
typedef float f32x4 __attribute__((ext_vector_type(4)));
typedef unsigned u32x4 __attribute__((ext_vector_type(4)));
constexpr int BM = 256, BK = 64, HALF = 128, HTB = HALF * BK * 2  , STAGE_BYTES = 8 * HTB, NXCD = 8, WGM = 8;

__host__ __device__ __forceinline__ int lds_byte(int r, int c) { const int st = (r >> 4) * 2 + (c >> 5), rr = r & 15, cc = c & 31, ob = rr * 64 + cc * 2; return st * 1024 + (ob ^ (((ob >> 9) & 1) << 5)); }
__host__ __device__ __forceinline__ void stage_rc(int b, int& R, int& C) { const int st = b / 1024, sb = b % 1024, swz = sb ^ (((sb >> 9) & 1) << 5); R = (st >> 1) * 16 + swz / 64; C = (st & 1) * 32 + (swz % 64) / 2; }
__host__ __device__ __forceinline__ int perm32(int rho) { const int n = rho >> 4, i = rho & 15; return 8 * (i >> 2) + 4 * n + (i & 3); }

struct Unit { int pm, pn; };
struct Gemm { const bf16_t* A; const bf16_t* Bt; int lda, ldb, K; };

struct StaticOrder {
    int nM, nN, nwg, G, c;
    __host__ __device__ void init(int M, int N, int G_, int c_) { nM = M / BM; nN = N / BM; nwg = nM * nN; G = G_; c = c_; }
    __host__ __device__ bool next(int i, Unit& u) const {
        const long L = (long)i * G + c; if (L >= nwg) return false;
        int wgid = (int)L; { const int q = nwg / NXCD, r = nwg % NXCD, xcd = wgid % NXCD, off = wgid / NXCD; wgid = (xcd < r ? xcd * (q + 1) : r * (q + 1) + (xcd - r) * q) + off; }
        const int nig = WGM * nN, gid = wgid / nig, fm = gid * WGM, gsz = (nM - fm) < WGM ? (nM - fm) : WGM;
        u.pm = fm + ((wgid % nig) % gsz); u.pn = (wgid % nig) / gsz; return true;
    }
    __device__ __forceinline__ void a_ready(const Unit&) const {}
    __device__ __forceinline__ void done(const Unit&) const {}
};

__device__ __forceinline__ unsigned cvt_pk_bf16(float lo, float hi) { unsigned r; asm volatile("v_cvt_pk_bf16_f32 %0, %1, %2" : "=v"(r) : "v"(lo), "v"(hi)); return r; }
__device__ __forceinline__ float bf_lo(unsigned w) { return __uint_as_float(w << 16); }
__device__ __forceinline__ float bf_hi(unsigned w) { return __uint_as_float(w & 0xffff0000u); }
__device__ __forceinline__ float sigmoid_f(float x) { return __builtin_amdgcn_rcpf(1.0f + __builtin_amdgcn_exp2f(-1.4426950408889634f * x)); }
__device__ __forceinline__ float gelu_tanh_f(float x) { const float t = x * (-2.3022081986f + -0.1029432446f * x * x); return x * __builtin_amdgcn_rcpf(1.0f + __builtin_amdgcn_exp2f(t)); }
__device__ __forceinline__ float silu_f(float x) { return x * sigmoid_f(x); }

struct EpiZ {
    static constexpr bool PERM = true, AFTER_DRAIN = false, HAS_MID = false; static constexpr int TMID = -1;
    bf16_t* Z; int ldc;
    __device__ __forceinline__ void mid(f32x4 (&)[2][2][4][2], const Unit&, int, int, int, int) const {}
    __device__ __forceinline__ void operator()(const f32x4 (&acc)[2][2][4][2], const Unit& u, int wr, int wc, int fr, int fq) const {
        int row0 = u.pm * BM + wr * 64 + fr; const int col0 = u.pn * BM + wc * 32 + 8 * fq; asm volatile("" : "+v"(row0));
        const int mode = u.pn < 4 ? 0 : (u.pn < 16 ? 1 : 2);
#pragma unroll
        for (int ai = 0; ai < 2; ++ai)
#pragma unroll
            for (int m = 0; m < 4; ++m) { bf16_t* rowp = Z + (size_t)(row0 + ai * HALF + m * 16) * ldc + col0;
#pragma unroll
                for (int bj = 0; bj < 2; ++bj) { f32x4 v0 = acc[ai][bj][m][0], v1 = acc[ai][bj][m][1];
                    if (mode == 1) {
#pragma unroll
                        for (int j = 0; j < 4; ++j) { v0[j] = gelu_tanh_f(v0[j]); v1[j] = gelu_tanh_f(v1[j]); } }
                    else if (mode == 2) {
#pragma unroll
                        for (int j = 0; j < 4; ++j) { v0[j] = sigmoid_f(v0[j]); v1[j] = sigmoid_f(v1[j]); } }
                    u32x4 w; w.x = cvt_pk_bf16(v0[0], v0[1]); w.y = cvt_pk_bf16(v0[2], v0[3]); w.z = cvt_pk_bf16(v1[0], v1[1]); w.w = cvt_pk_bf16(v1[2], v1[3]);
                    *(u32x4*)(rowp + bj * HALF) = w; } }
    }
};
struct EpiBf16 {
    static constexpr bool PERM = true, AFTER_DRAIN = false, HAS_MID = false; static constexpr int TMID = -1;
    bf16_t* O; int ldc;
    __device__ __forceinline__ void mid(f32x4 (&)[2][2][4][2], const Unit&, int, int, int, int) const {}
    __device__ __forceinline__ void operator()(const f32x4 (&acc)[2][2][4][2], const Unit& u, int wr, int wc, int fr, int fq) const {
        int row0 = u.pm * BM + wr * 64 + fr; const int col0 = u.pn * BM + wc * 32 + 8 * fq; asm volatile("" : "+v"(row0));
#pragma unroll
        for (int ai = 0; ai < 2; ++ai)
#pragma unroll
            for (int m = 0; m < 4; ++m) { bf16_t* rowp = O + (size_t)(row0 + ai * HALF + m * 16) * ldc + col0;
#pragma unroll
                for (int bj = 0; bj < 2; ++bj) { const f32x4 v0 = acc[ai][bj][m][0], v1 = acc[ai][bj][m][1];
                    u32x4 w; w.x = cvt_pk_bf16(v0[0], v0[1]); w.y = cvt_pk_bf16(v0[2], v0[3]); w.z = cvt_pk_bf16(v1[0], v1[1]); w.w = cvt_pk_bf16(v1[2], v1[3]);
                    *(u32x4*)(rowp + bj * HALF) = w; } }
    }
};
struct EpiGate {
    static constexpr bool PERM = true, AFTER_DRAIN = false, HAS_MID = true; static constexpr int TMID = 16;
    const bf16_t* Zg; int ldz;
    bf16_t* O; int ldc;
    __device__ __forceinline__ void mid(f32x4 (&acc)[2][2][4][2], const Unit& u, int wr, int wc, int fr, int fq) const {
        int row0 = u.pm * BM + wr * 64 + fr; const int col0 = u.pn * BM + wc * 32 + 8 * fq; asm volatile("" : "+v"(row0));
#pragma unroll
        for (int ai = 0; ai < 2; ++ai)
#pragma unroll
            for (int m = 0; m < 4; ++m) { const bf16_t* rowp = Zg + (size_t)(row0 + ai * HALF + m * 16) * ldz + col0;
#pragma unroll
                for (int bj = 0; bj < 2; ++bj) { const u32x4 ga = *(const u32x4*)(rowp + bj * HALF), gb = *(const u32x4*)(rowp + 1024 + bj * HALF);
                    f32x4 r0, r1;
                    r0[0] = bf_lo(ga.x) * __builtin_amdgcn_rcpf(fmaxf(bf_lo(gb.x), 1e-30f)); r0[1] = bf_hi(ga.x) * __builtin_amdgcn_rcpf(fmaxf(bf_hi(gb.x), 1e-30f));
                    r0[2] = bf_lo(ga.y) * __builtin_amdgcn_rcpf(fmaxf(bf_lo(gb.y), 1e-30f)); r0[3] = bf_hi(ga.y) * __builtin_amdgcn_rcpf(fmaxf(bf_hi(gb.y), 1e-30f));
                    r1[0] = bf_lo(ga.z) * __builtin_amdgcn_rcpf(fmaxf(bf_lo(gb.z), 1e-30f)); r1[1] = bf_hi(ga.z) * __builtin_amdgcn_rcpf(fmaxf(bf_hi(gb.z), 1e-30f));
                    r1[2] = bf_lo(ga.w) * __builtin_amdgcn_rcpf(fmaxf(bf_lo(gb.w), 1e-30f)); r1[3] = bf_hi(ga.w) * __builtin_amdgcn_rcpf(fmaxf(bf_hi(gb.w), 1e-30f));
                    acc[ai][bj][m][0] *= r0; acc[ai][bj][m][1] *= r1; } }
    }
    __device__ __forceinline__ void operator()(const f32x4 (&acc)[2][2][4][2], const Unit& u, int wr, int wc, int fr, int fq) const {
        int row0 = u.pm * BM + wr * 64 + fr; const int col0 = u.pn * BM + wc * 32 + 8 * fq; asm volatile("" : "+v"(row0));
#pragma unroll
        for (int ai = 0; ai < 2; ++ai)
#pragma unroll
            for (int m = 0; m < 4; ++m) { const size_t r = (size_t)(row0 + ai * HALF + m * 16);
#pragma unroll
                for (int bj = 0; bj < 2; ++bj) { const u32x4 gb = *(const u32x4*)(Zg + r * ldz + col0 + 1024 + bj * HALF);
                    f32x4 v0 = acc[ai][bj][m][0], v1 = acc[ai][bj][m][1];
                    v0[0] *= fmaxf(bf_lo(gb.x), 1e-30f); v0[1] *= fmaxf(bf_hi(gb.x), 1e-30f); v0[2] *= fmaxf(bf_lo(gb.y), 1e-30f); v0[3] *= fmaxf(bf_hi(gb.y), 1e-30f);
                    v1[0] *= fmaxf(bf_lo(gb.z), 1e-30f); v1[1] *= fmaxf(bf_hi(gb.z), 1e-30f); v1[2] *= fmaxf(bf_lo(gb.w), 1e-30f); v1[3] *= fmaxf(bf_hi(gb.w), 1e-30f);
                    u32x4 w; w.x = cvt_pk_bf16(v0[0], v0[1]); w.y = cvt_pk_bf16(v0[2], v0[3]); w.z = cvt_pk_bf16(v1[0], v1[1]); w.w = cvt_pk_bf16(v1[2], v1[3]);
                    *(u32x4*)(O + r * ldc + col0 + bj * HALF) = w; } }
    }
};
struct EpiSwiGLU {
    static constexpr bool PERM = true, AFTER_DRAIN = false, HAS_MID = false; static constexpr int TMID = -1;
    bf16_t* O; int ldc;
    __device__ __forceinline__ void mid(f32x4 (&)[2][2][4][2], const Unit&, int, int, int, int) const {}
    __device__ __forceinline__ void operator()(const f32x4 (&acc)[2][2][4][2], const Unit& u, int wr, int wc, int fr, int fq) const {
        int row0 = u.pm * BM + wr * 64 + fr; const int col0 = u.pn * HALF + wc * 32 + 8 * fq; asm volatile("" : "+v"(row0));
#pragma unroll
        for (int ai = 0; ai < 2; ++ai)
#pragma unroll
            for (int m = 0; m < 4; ++m) { bf16_t* rowp = O + (size_t)(row0 + ai * HALF + m * 16) * ldc + col0;
                f32x4 v0, v1;
#pragma unroll
                for (int j = 0; j < 4; ++j) { v0[j] = silu_f(acc[ai][0][m][0][j]) * acc[ai][1][m][0][j]; v1[j] = silu_f(acc[ai][0][m][1][j]) * acc[ai][1][m][1][j]; }
                u32x4 w; w.x = cvt_pk_bf16(v0[0], v0[1]); w.y = cvt_pk_bf16(v0[2], v0[3]); w.z = cvt_pk_bf16(v1[0], v1[1]); w.w = cvt_pk_bf16(v1[2], v1[3]);
                *(u32x4*)rowp = w; }
    }
};

template <class Epi, class Sched, bool ALIGN_EPI = false, bool SP2 = false>
__device__ __forceinline__ void gemm_phase(PG8_LAS unsigned char* lds, const Gemm g, const Sched& S, const Epi& E) {
    const int tid = threadIdx.x, wid = __builtin_amdgcn_readfirstlane(tid >> 6), lane = tid & 63, wr = wid >> 2, wc = wid & 3, fr = lane & 15, fq = lane >> 4;
    const int K = g.K, nt = K / BK;
    unsigned voffA[2], voffB[2];
#pragma unroll
    for (int i = 0; i < 2; ++i) { int R, C; stage_rc(tid * 16 + i * 8192, R, C); const int Rb = Epi::PERM ? ((R & ~31) + perm32(R & 31)) : R;
        voffA[i] = (unsigned)(R * g.lda + C) * 2u; voffB[i] = (unsigned)(Rb * g.ldb + C) * 2u; }
    const size_t kstep = (size_t)(BK * 2);
    const size_t hstepA = (size_t)HALF * g.lda * 2, hstepB = (size_t)HALF * g.ldb * 2;
    const size_t tstepA = 2 * hstepA, tstepB = 2 * hstepB;
    const unsigned ldsw = (unsigned)wid * 1024u;
    const int aoff = lds_byte(wr * 64 + fr, fq * 8), boff = lds_byte(wc * 32 + fr, fq * 8);
#define PG8_SA(b, h) (((b) * 2 + (h)) * HTB)
#define PG8_SB(b, h) ((4 + (b) * 2 + (h)) * HTB)
#define PG8_STAGE(bufoff, gbase, voff) do { _Pragma("unroll") for (int _i = 0; _i < 2; ++_i) \
        __builtin_amdgcn_global_load_lds((const unsigned*)((const char*)(gbase) + (voff)[_i]), (PG8_LAS unsigned*)(lds + (bufoff) + ldsw + _i * 8192), 16, 0, 0); } while (0)
#define PG8_LDA(dst, b, h) do { _Pragma("unroll") for (int m = 0; m < 4; ++m) _Pragma("unroll") for (int k = 0; k < 2; ++k) dst[m][k] = *(const PG8_LAS bf16x8*)(lds + PG8_SA(b, h) + aoff + m * 2048 + k * 1024); } while (0)
#define PG8_LDB(dst, b, h) do { _Pragma("unroll") for (int n = 0; n < 2; ++n) _Pragma("unroll") for (int k = 0; k < 2; ++k) dst[n][k] = *(const PG8_LAS bf16x8*)(lds + PG8_SB(b, h) + boff + n * 2048 + k * 1024); } while (0)
#define PG8_MMA(ai, bj, At, Bt) do { __builtin_amdgcn_s_setprio(1); _Pragma("unroll") for (int m = 0; m < 4; ++m) _Pragma("unroll") for (int n = 0; n < 2; ++n) _Pragma("unroll") for (int k = 0; k < 2; ++k) \
        acc[ai][bj][m][n] = __builtin_amdgcn_mfma_f32_16x16x32_bf16(Bt[n][k], At[m][k], acc[ai][bj][m][n], 0, 0, 0); __builtin_amdgcn_s_setprio(0); } while (0)
#define PG8_WAIT_V(n) asm volatile("s_waitcnt vmcnt(" #n ")" ::: "memory")
#define PG8_WAIT_L(n) asm volatile("s_waitcnt lgkmcnt(" #n ")" ::: "memory")
#define PG8_BAR __builtin_amdgcn_s_barrier()
#define PG8_SCHED __builtin_amdgcn_sched_barrier(0)
    Unit cur, nxt; int ui = 0;
    if (!S.next(0, cur)) return;
    f32x4 acc[2][2][4][2];
#pragma unroll
    for (int a = 0; a < 2; ++a)
#pragma unroll
        for (int b = 0; b < 2; ++b)
#pragma unroll
            for (int m = 0; m < 4; ++m)
#pragma unroll
                for (int n = 0; n < 2; ++n) acc[a][b][m][n] = (f32x4){0.f, 0.f, 0.f, 0.f};
    bf16x8 At[4][2], B0[2][2], B1[2][2];
    const char* cA = (const char*)g.A + (size_t)cur.pm * tstepA; const char* cB = (const char*)g.Bt + (size_t)cur.pn * tstepB;
    S.a_ready(cur);
    if constexpr (SP2) {
        PG8_STAGE(PG8_SB(0, 0), cB, voffB); PG8_STAGE(PG8_SB(0, 1), cB + hstepB, voffB); PG8_STAGE(PG8_SA(0, 0), cA, voffA); PG8_STAGE(PG8_SA(0, 1), cA + hstepA, voffA);
        if (wr == 1) PG8_BAR;
        PG8_WAIT_V(2); PG8_BAR;
        PG8_STAGE(PG8_SB(1, 0), cB + kstep, voffB); PG8_STAGE(PG8_SA(1, 0), cA + kstep, voffA); PG8_STAGE(PG8_SB(1, 1), cB + hstepB + kstep, voffB);
        PG8_WAIT_V(6); PG8_BAR;
    } else {
        PG8_STAGE(PG8_SB(0, 0), cB, voffB); PG8_STAGE(PG8_SA(0, 0), cA, voffA); PG8_STAGE(PG8_SB(0, 1), cB + hstepB, voffB); PG8_STAGE(PG8_SA(0, 1), cA + hstepA, voffA);
        if (wr == 1) PG8_BAR;
        PG8_WAIT_V(4); PG8_BAR;
        PG8_STAGE(PG8_SB(1, 0), cB + kstep, voffB); PG8_STAGE(PG8_SA(1, 0), cA + kstep, voffA); PG8_STAGE(PG8_SB(1, 1), cB + hstepB + kstep, voffB);
        PG8_WAIT_V(6); PG8_BAR;
    }
    for (;;) {
        const bool has_next = S.next(ui + 1, nxt);
        const char* nA = has_next ? (const char*)g.A + (size_t)nxt.pm * tstepA : cA; const char* nB = has_next ? (const char*)g.Bt + (size_t)nxt.pn * tstepB : cB;
        for (int t = 0; t < nt; t += 2) {
            const bool last = (t == nt - 2);
            const char* a1 = cA + (size_t)(t + 1) * kstep;
            const char* a2 = last ? nA : cA + (size_t)(t + 2) * kstep; const char* b2 = last ? nB : cB + (size_t)(t + 2) * kstep;
            const char* a3 = a2 + kstep; const char* b3 = b2 + kstep;
            if (last && has_next) S.a_ready(nxt);
            if constexpr (Epi::HAS_MID) { if (t == Epi::TMID) E.mid(acc, cur, wr, wc, fr, fq); }
            if constexpr (SP2) {
            PG8_LDB(B0, 0, 0); PG8_LDB(B1, 0, 1); PG8_SCHED; PG8_LDA(At, 0, 0); PG8_STAGE(PG8_SA(1, 1), a1 + hstepA, voffA);
            PG8_WAIT_V(8); PG8_WAIT_L(0); PG8_BAR; PG8_MMA(0, 0, At, B0); PG8_MMA(0, 1, At, B1); PG8_BAR; PG8_SCHED;
            PG8_LDA(At, 0, 1); PG8_STAGE(PG8_SB(0, 0), b2, voffB); PG8_STAGE(PG8_SB(0, 1), b2 + hstepB, voffB); PG8_STAGE(PG8_SA(0, 0), a2, voffA);
            PG8_WAIT_V(8); PG8_WAIT_L(0); PG8_BAR; PG8_MMA(1, 0, At, B0); PG8_MMA(1, 1, At, B1); PG8_BAR; PG8_SCHED;
            PG8_LDB(B0, 1, 0); PG8_LDB(B1, 1, 1); PG8_SCHED; PG8_LDA(At, 1, 0); PG8_STAGE(PG8_SA(0, 1), a2 + hstepA, voffA);
            PG8_WAIT_V(8); PG8_WAIT_L(0); PG8_BAR; PG8_MMA(0, 0, At, B0); PG8_MMA(0, 1, At, B1); PG8_BAR; PG8_SCHED;
            PG8_LDA(At, 1, 1); PG8_STAGE(PG8_SB(1, 0), b3, voffB); PG8_STAGE(PG8_SB(1, 1), b3 + hstepB, voffB); PG8_STAGE(PG8_SA(1, 0), a3, voffA);
            PG8_WAIT_V(8); PG8_WAIT_L(0); PG8_BAR; PG8_MMA(1, 0, At, B0); PG8_MMA(1, 1, At, B1); PG8_BAR; PG8_SCHED;
            } else {
            PG8_LDB(B0, 0, 0); PG8_SCHED; PG8_LDA(At, 0, 0); PG8_STAGE(PG8_SA(1, 1), a1 + hstepA, voffA);
            PG8_WAIT_L(8); PG8_BAR; PG8_WAIT_L(0); PG8_MMA(0, 0, At, B0); PG8_BAR; PG8_SCHED;
            PG8_LDB(B1, 0, 1); PG8_STAGE(PG8_SB(0, 0), b2, voffB);
            PG8_BAR; PG8_WAIT_L(0); PG8_MMA(0, 1, At, B1); PG8_BAR;
            PG8_LDA(At, 0, 1); PG8_STAGE(PG8_SA(0, 0), a2, voffA);
            PG8_BAR; PG8_WAIT_L(0); PG8_MMA(1, 0, At, B0); PG8_BAR; PG8_SCHED;
            PG8_STAGE(PG8_SB(0, 1), b2 + hstepB, voffB);
            PG8_WAIT_V(6); PG8_BAR; PG8_MMA(1, 1, At, B1); PG8_BAR;
            PG8_LDB(B0, 1, 0); PG8_SCHED; PG8_LDA(At, 1, 0); PG8_STAGE(PG8_SA(0, 1), a2 + hstepA, voffA);
            PG8_WAIT_L(8); PG8_BAR; PG8_WAIT_L(0); PG8_MMA(0, 0, At, B0); PG8_BAR; PG8_SCHED;
            PG8_LDB(B1, 1, 1); PG8_STAGE(PG8_SB(1, 0), b3, voffB);
            PG8_BAR; PG8_WAIT_L(0); PG8_MMA(0, 1, At, B1); PG8_BAR;
            PG8_LDA(At, 1, 1); PG8_STAGE(PG8_SA(1, 0), a3, voffA);
            PG8_BAR; PG8_WAIT_L(0); PG8_MMA(1, 0, At, B0); PG8_BAR; PG8_SCHED;
            PG8_STAGE(PG8_SB(1, 1), b3 + hstepB, voffB);
            PG8_WAIT_V(6); PG8_BAR; PG8_MMA(1, 1, At, B1); PG8_BAR;
            }
        }
        if constexpr (ALIGN_EPI) { if (wr == 0) PG8_BAR; }
        E(acc, cur, wr, wc, fr, fq); S.done(cur);
        if (!has_next) break;
#pragma unroll
        for (int a = 0; a < 2; ++a)
#pragma unroll
            for (int b = 0; b < 2; ++b)
#pragma unroll
                for (int m = 0; m < 4; ++m)
#pragma unroll
                    for (int n = 0; n < 2; ++n) acc[a][b][m][n] = (f32x4){0.f, 0.f, 0.f, 0.f};
        cur = nxt; cA = nA; cB = nB; ++ui;
        if constexpr (ALIGN_EPI) { if (wr == 1) PG8_BAR; }
    }
    PG8_WAIT_V(0);
    if constexpr (!ALIGN_EPI) { if (wr == 0) PG8_BAR; }
    PG8_BAR;
#undef PG8_SA
#undef PG8_SB
#undef PG8_STAGE
#undef PG8_LDA
#undef PG8_LDB
#undef PG8_MMA
#undef PG8_WAIT_V
#undef PG8_WAIT_L
#undef PG8_BAR
#undef PG8_SCHED
}
}

#ifndef PG8_SP2
#define PG8_SP2 true
#endif
#ifndef PG8_ALIGN
#define PG8_ALIGN true
#endif

constexpr int NWAVES = 8;
constexpr int N_LAUNCHES = MK_N_LAUNCHES;
constexpr int PER_PHASE = 9;
constexpr int DM = 1024, SEQ = 2048, NB = 16, DEC_T = 32;
constexpr int MP = NB * SEQ, MS = NB * DEC_T, M = MP + MS;
constexpr int DIN = 6144, DFF = 2816, DFF2 = 5632;
constexpr float EPS = 1e-6f;
static_assert(M % 256 == 0, "M");
enum { I_XP = 0, I_XS, I_SH, I_SC, I_GPRE, I_WIN, I_CW, I_CB, I_WA, I_BA, I_WX, I_BX, I_LAM, I_WBRA, I_LNG, I_LNB, I_WS, I_BS, I_WBRB, I_WOUT, I_GPOST, I_GFFN, I_WFI, I_WFO, I_GPF, N_IN };
constexpr size_t O_Y = 0, O_HP = (size_t)M * DM, O_CP = O_HP + NB * DM, O_HS = O_CP + (size_t)NB * 3 * DM, O_CS = O_HS + NB * DM, O_VS = O_CS + (size_t)NB * 3 * DM, O_END = O_VS + (size_t)MS * DM;
static_assert(O_END == 34734080, "output size");

constexpr size_t MiB = 1u << 20;
constexpr size_t WS_CTL = 0, CTL_ZERO_BYTES = 1 * MiB;
constexpr size_t WS_W1 = 1 * MiB;
constexpr size_t WS_W2 = WS_W1 + (size_t)DIN * DM * 2;
constexpr size_t WS_W3 = WS_W2 + (size_t)DM * 2048 * 2;
constexpr size_t WS_W4 = WS_W3 + (size_t)DM * DM * 2;
constexpr size_t WS_W5 = WS_W4 + (size_t)DFF2 * DM * 2;
constexpr size_t WS_GT = WS_W5 + (size_t)DM * DFF * 2;
constexpr size_t WS_WSM = WS_GT + 16 * 128 * 64 * 2;
constexpr size_t WS_WSS = WS_WSM + 8 * 128 * 128 * 2;
constexpr size_t WS_WEND = WS_WSS + 8 * 128 * 128 * 2;
constexpr size_t WS_XN = 40 * MiB;
constexpr size_t WS_Z = 105 * MiB;
constexpr size_t WS_MIX = WS_Z;
constexpr size_t WS_FIN = WS_Z + 65 * MiB;
constexpr size_t WS_F = WS_FIN + 179 * MiB;
constexpr size_t WS_END = WS_Z + (size_t)M * DIN * 2;
static_assert(WS_WEND <= WS_XN && WS_XN + (size_t)M * DM * 2 <= WS_Z && WS_FIN + (size_t)M * DFF * 2 <= WS_F && WS_F + (size_t)M * DM * 2 <= WS_END && WS_END <= 512 * MiB, "d_ws map");
constexpr int CW_TMO = 0, CW_BAR = 4096;

constexpr int RING_OFF = 0, RING_BYTES = 131072;
constexpr int LDSCTL_OFF = RING_BYTES, MISC_OFF = LDSCTL_OFF + 320;
constexpr int LDS_BYTES = 147456;

#define GAS __attribute__((address_space(1)))
#define LAS __attribute__((address_space(3)))
typedef unsigned short bf16;
typedef unsigned v4u __attribute__((ext_vector_type(4)));
typedef unsigned v2u __attribute__((ext_vector_type(2)));
typedef float f32x4 __attribute__((ext_vector_type(4)));
typedef float f32x16 __attribute__((ext_vector_type(16)));
typedef short bf16x8 __attribute__((ext_vector_type(8)));
typedef GAS unsigned gu32;
#define RLX_AGENT __ATOMIC_RELAXED, __HIP_MEMORY_SCOPE_AGENT
#define LDS_WAIT() asm volatile("s_waitcnt lgkmcnt(0)" ::: "memory")
#define VM_WAIT() asm volatile("s_waitcnt vmcnt(0)" ::: "memory")
__device__ __forceinline__ unsigned f2bf(float f) { unsigned u = __builtin_bit_cast(unsigned, f); return (u + 0x7fffu + ((u >> 16) & 1u)) >> 16; }
__device__ __forceinline__ unsigned pk2(float lo, float hi) { return f2bf(lo) | (f2bf(hi) << 16); }
__device__ __forceinline__ float bflo(unsigned w) { return __uint_as_float(w << 16); }
__device__ __forceinline__ float bfhi(unsigned w) { return __uint_as_float(w & 0xffff0000u); }

#define XB_TMO      128
#define XB_XCNT(j)  (256  + 64 * (j))
#define XB_XSUB(j)  (1280 + 64 * (j))
#define XB_XGEN(j)  (2304 + 64 * (j))
#define XB_TOP      3328
#define XB_TOPGEN   3392
#define XCD_BAR_WORDS 3456
#define XB_SPIN_CAP (1u << 22)

__device__ __forceinline__ unsigned xb_ld(unsigned* p)              { return __hip_atomic_load(p, __ATOMIC_RELAXED, __HIP_MEMORY_SCOPE_AGENT); }
__device__ __forceinline__ unsigned xb_add(unsigned* p, unsigned v) { return __hip_atomic_fetch_add(p, v, __ATOMIC_RELAXED, __HIP_MEMORY_SCOPE_AGENT); }
__device__ __forceinline__ unsigned xb_xcc_id() { return (unsigned)__builtin_amdgcn_s_getreg((3 << 11) | 20) & 0xFu; }
#define XB_SPIN(cond, bar) do { unsigned _sp = 0; while (cond) { __builtin_amdgcn_s_sleep(1); \
    if ((++_sp & 255u) == 0u) { if (xb_ld(&(bar)[XB_TMO])) break; if (_sp > XB_SPIN_CAP) { atomicAdd(&(bar)[XB_TMO], 1u); break; } } } } while (0)

struct XcdBarrier { unsigned* bar; unsigned x; volatile LAS unsigned* st; };

__device__ __forceinline__ XcdBarrier xcd_barrier_post(unsigned* bar, volatile LAS unsigned* st) {
    XcdBarrier b; b.bar = bar; b.x = xb_xcc_id(); b.st = st;
    if (threadIdx.x == 0) (void)xb_add(&bar[XB_XCNT(b.x)], 1u);
    return b;
}
__device__ __forceinline__ void xcd_barrier_complete(unsigned* bar, unsigned x, unsigned& nloc, unsigned& nx) {
    const unsigned G = gridDim.x * gridDim.y * gridDim.z;
    unsigned sum, cnt, mine, sp = 0u;
    for (;;) {
        sum = 0u; cnt = 0u; mine = 0u;
#pragma unroll
        for (unsigned j = 0; j < 16; ++j) { const unsigned c = xb_ld(&bar[XB_XCNT(j)]); sum += c; cnt += (c > 0u) ? 1u : 0u; mine = (j == x) ? c : mine; }
        if (sum == G) break;
        __builtin_amdgcn_s_sleep(1);
        if ((++sp & 255u) == 0u) { if (xb_ld(&bar[XB_TMO])) break; if (sp > XB_SPIN_CAP) { atomicAdd(&bar[XB_TMO], 1u); break; } }
    }
    nloc = mine > 0u ? mine : 1u; nx = cnt > 0u ? cnt : 1u;
}
__device__ __forceinline__ void xcd_barrier(const XcdBarrier& b) {
    asm volatile("s_waitcnt vmcnt(0)" ::: "memory");
    __syncthreads();
    if (threadIdx.x == 0) {
        unsigned* bar = b.bar;
        __builtin_amdgcn_s_waitcnt(0);
        unsigned nloc = b.st[0], nx = b.st[1];
        if (nloc == 0u) { xcd_barrier_complete(bar, b.x, nloc, nx); b.st[0] = nloc; b.st[1] = nx; }
        const unsigned old = xb_add(&bar[XB_XSUB(b.x)], 1u);
        const unsigned gen = old / nloc;
        if (old + 1u == (gen + 1u) * nloc) {
            __builtin_amdgcn_fence(__ATOMIC_RELEASE, "agent");
            asm volatile("s_waitcnt vmcnt(0)" ::: "memory");
            const unsigned og = xb_add(&bar[XB_TOP], 1u);
            const unsigned tg = og / nx;
            if (og + 1u == (tg + 1u) * nx) xb_add(&bar[XB_TOPGEN], 1u);
            else XB_SPIN(xb_ld(&bar[XB_TOPGEN]) == tg, bar);
            __builtin_amdgcn_fence(__ATOMIC_ACQUIRE, "agent");
            xb_add(&bar[XB_XGEN(b.x)], 1u);
            asm volatile("s_waitcnt vmcnt(0)" ::: "memory");
        } else {
            XB_SPIN(xb_ld(&bar[XB_XGEN(b.x)]) == gen, bar);
            __builtin_amdgcn_fence(__ATOMIC_ACQUIRE, "agent");
            asm volatile("s_waitcnt vmcnt(0)" ::: "memory");
        }
    }
    __syncthreads();
}

struct Args { const float* in[N_IN]; float* out; unsigned char* ws; int ph_lo, ph_hi, li, pad; };
struct Frame {
    LAS unsigned char* lds;
    volatile LAS unsigned* MISC;
    gu32* ctl;
    int tid, lane, wave, vcu, G;
};
__device__ __forceinline__ float wave_sum(float v) {
#pragma unroll
    for (int o = 1; o < 64; o <<= 1) v += __shfl_xor(v, o);
    return v;
}
__device__ __forceinline__ const float* xrow_ptr(const Args& a, int m) { return m < MP ? a.in[I_XP] + (size_t)m * DM : a.in[I_XS] + (size_t)(m - MP) * DM; }

__device__ __forceinline__ void p0_transpose_item(const float* W, int N, bf16* WT, int ldk, int dcol0, int k0, int n0, int drow0, LAS float* scr, int lane) {
#pragma unroll 8
    for (int i = 0; i < 32; ++i) { const int kk = 2 * i + (lane >> 5); scr[kk * 33 + (lane & 31)] = W[(size_t)(k0 + kk) * N + n0 + (lane & 31)]; }
    LDS_WAIT(); asm volatile("" ::: "memory");
    const int c = lane & 7;
#pragma unroll
    for (int j = 0; j < 4; ++j) { const int n = (lane >> 3) + 8 * j; const LAS float* s = scr + (8 * c) * 33 + n;
        v4u o; o.x = pk2(s[0 * 33], s[1 * 33]); o.y = pk2(s[2 * 33], s[3 * 33]); o.z = pk2(s[4 * 33], s[5 * 33]); o.w = pk2(s[6 * 33], s[7 * 33]);
        *(GAS v4u*)(WT + (size_t)(drow0 + n) * ldk + dcol0 + k0 + 8 * c) = o; }
    LDS_WAIT(); asm volatile("" ::: "memory");
}

__device__ __forceinline__ void p0_prologue(Frame& F, const Args& a) {
    unsigned char* ws = a.ws;
    LAS float* scr = (LAS float*)(F.lds + RING_OFF + F.wave * 16384);
    const int gw = F.vcu * NWAVES + F.wave, NGW = F.G * NWAVES;
    constexpr int I1 = (DM / 64) * (DIN / 32), I2 = (DM / 64) * (DM / 32), I4 = (DM / 64) * (DFF2 / 32), I5 = (DFF / 64) * (DM / 32), IG = 64;
    constexpr int NITEMS = I1 + 3 * I2 + I4 + I5 + IG;
    for (int it = gw; it < NITEMS; it += NGW) {
        int r = it;
        if (r < I1) { const int nb = DIN / 32, kb = r / nb, n0 = 32 * (r % nb); p0_transpose_item(a.in[I_WIN], DIN, (bf16*)(ws + WS_W1), DM, 0, 64 * kb, n0, n0, scr, F.lane); continue; } r -= I1;
        if (r < I2) { const int nb = DM / 32, kb = r / nb, n0 = 32 * (r % nb); p0_transpose_item(a.in[I_WBRA], DM, (bf16*)(ws + WS_W2), 2048, 0, 64 * kb, n0, n0, scr, F.lane); continue; } r -= I2;
        if (r < I2) { const int nb = DM / 32, kb = r / nb, n0 = 32 * (r % nb); p0_transpose_item(a.in[I_WBRB], DM, (bf16*)(ws + WS_W2), 2048, 1024, 64 * kb, n0, n0, scr, F.lane); continue; } r -= I2;
        if (r < I2) { const int nb = DM / 32, kb = r / nb, n0 = 32 * (r % nb); p0_transpose_item(a.in[I_WOUT], DM, (bf16*)(ws + WS_W3), DM, 0, 64 * kb, n0, n0, scr, F.lane); continue; } r -= I2;
        if (r < I4) { const int nb = DFF2 / 32, kb = r / nb, n0 = 32 * (r % nb); const int s = n0 / DFF, j0 = n0 % DFF, drow0 = 256 * (j0 / 128) + 128 * s + (j0 % 128);
                      p0_transpose_item(a.in[I_WFI], DFF2, (bf16*)(ws + WS_W4), DM, 0, 64 * kb, n0, drow0, scr, F.lane); continue; } r -= I4;
        if (r < I5) { const int nb = DM / 32, kb = r / nb, n0 = 32 * (r % nb); p0_transpose_item(a.in[I_WFO], DM, (bf16*)(ws + WS_W5), DFF, 0, 64 * kb, n0, n0, scr, F.lane); continue; } r -= I5;
        { const int hd = r >> 2, which = (r >> 1) & 1, n0 = 32 * (r & 1);
          p0_transpose_item((which ? a.in[I_WX] : a.in[I_WA]) + (size_t)hd * 4096, 64, (bf16*)(ws + WS_GT) + (size_t)hd * 8192, 64, 0, 0, n0, which * 64 + n0, scr, F.lane); }
    }
    { const float* wsp = a.in[I_WS]; bf16* wsm = (bf16*)(ws + WS_WSM); bf16* wss = (bf16*)(ws + WS_WSS);
      for (int i = gw * 64 + F.lane; i < 8 * 128 * 128; i += NGW * 64) { const int g = i >> 14, p = (i >> 7) & 127, q = i & 127;
          wsm[i] = (bf16)(((q >> 6) <= (p >> 6)) ? f2bf(wsp[i]) : 0u);
          wss[i] = (bf16)(((q >> 5) == (p >> 5)) ? f2bf(wsp[(g << 14) + ((p & 31) << 7) + (q & 31)]) : 0u); } }
    { const GAS f32x4* gp = (const GAS f32x4*)a.in[I_GPRE] + F.lane; f32x4 gg[4];
#pragma unroll
      for (int j = 0; j < 4; ++j) gg[j] = gp[64 * j];
      bf16* XN = (bf16*)(ws + WS_XN);
      for (int m = gw; m < M; m += NGW) { const GAS f32x4* xr = (const GAS f32x4*)xrow_ptr(a, m) + F.lane; f32x4 v[4]; float s = 0.f;
#pragma unroll
          for (int j = 0; j < 4; ++j) { v[j] = xr[64 * j]; s += (v[j].x * v[j].x + v[j].y * v[j].y) + (v[j].z * v[j].z + v[j].w * v[j].w); }
          const float rstd = 1.0f / sqrtf(wave_sum(s) * (1.f / DM) + EPS);
          GAS v2u* o8 = (GAS v2u*)(XN + (size_t)m * DM) + F.lane;
#pragma unroll
          for (int j = 0; j < 4; ++j) { v2u o; o.x = pk2(v[j].x * rstd * gg[j].x, v[j].y * rstd * gg[j].y); o.y = pk2(v[j].z * rstd * gg[j].z, v[j].w * rstd * gg[j].w); o8[64 * j] = o; } } }
}

__device__ __forceinline__ void p2a_item(Frame& F, const Args& a, int row0, int T, int hd, const float* h0, const float* cprev, float* out_h, float* out_conv) {
    LAS unsigned char* lds = F.lds;
    LAS float* XC = (LAS float*)(lds);
    LAS float* AS = (LAS float*)(lds + 32768);
    LAS float* US = (LAS float*)(lds + 65536);
    LAS bf16* XCB = (LAS bf16*)(lds + 98304);
    LAS float* SEGA = (LAS float*)(lds + 116736);
    LAS float* SEGB = (LAS float*)(lds + 118784);
    LAS float* CAR = (LAS float*)(lds + 120832);
    bf16* Z = (bf16*)(a.ws + WS_Z);
    const int tid = F.tid, lane = F.lane, wave = F.wave;
    const int tr = tid >> 3, cg = tid & 7, ch0 = hd * 64 + cg * 8;
    const int sc = tid & 63, seg = tid >> 6;
    const int tb = wave >> 1, cb = wave & 1, jl = cb * 32 + (lane & 31), hi = lane >> 5;
    __syncthreads();
    float cw[4][8], cbv[8];
#pragma unroll
    for (int k = 0; k < 4; ++k) { const f32x4 w0 = *(const GAS f32x4*)(a.in[I_CW] + k * DM + ch0), w1 = *(const GAS f32x4*)(a.in[I_CW] + k * DM + ch0 + 4);
        cw[k][0] = w0.x; cw[k][1] = w0.y; cw[k][2] = w0.z; cw[k][3] = w0.w; cw[k][4] = w1.x; cw[k][5] = w1.y; cw[k][6] = w1.z; cw[k][7] = w1.w; }
    { const f32x4 w0 = *(const GAS f32x4*)(a.in[I_CB] + ch0), w1 = *(const GAS f32x4*)(a.in[I_CB] + ch0 + 4);
      cbv[0] = w0.x; cbv[1] = w0.y; cbv[2] = w0.z; cbv[3] = w0.w; cbv[4] = w1.x; cbv[5] = w1.y; cbv[6] = w1.z; cbv[7] = w1.w; }
    bf16x8 Br[4], Bi[4];
    { const bf16* gt = (const bf16*)(a.ws + WS_GT) + (size_t)hd * 8192;
#pragma unroll
      for (int ks = 0; ks < 4; ++ks) { Br[ks] = *(const GAS bf16x8*)(gt + jl * 64 + ks * 16 + hi * 8); Bi[ks] = *(const GAS bf16x8*)(gt + (64 + jl) * 64 + ks * 16 + hi * 8); } }
    const float ba = a.in[I_BA][hd * 64 + jl], bx = a.in[I_BX][hd * 64 + jl];
    const float cA = -8.0f * log1pf(expf(-a.in[I_LAM][hd * 64 + jl])) * 1.4426950408889634f;
    if (tid < 64) CAR[tid] = h0 ? h0[hd * 64 + tid] : 0.f;
    const int ntiles = (T + 127) >> 7;
    for (int tile = 0; tile < ntiles; ++tile) {
        const int t0 = tile << 7, nrows = (T - t0) < 128 ? (T - t0) : 128, par = tile & 1;
        {
            float f[5][8];
#pragma unroll
            for (int r = 0; r < 5; ++r) { const int tt = t0 + 2 * tr - 3 + r;
                if (tt < 0) {
                    if (cprev) { const f32x4 p0 = *(const GAS f32x4*)(cprev + (tt + 3) * DM + ch0), p1 = *(const GAS f32x4*)(cprev + (tt + 3) * DM + ch0 + 4);
                        f[r][0] = p0.x; f[r][1] = p0.y; f[r][2] = p0.z; f[r][3] = p0.w; f[r][4] = p1.x; f[r][5] = p1.y; f[r][6] = p1.z; f[r][7] = p1.w; }
                    else {
#pragma unroll
                        for (int e = 0; e < 8; ++e) f[r][e] = 0.f; }
                } else if (tt < T) { const v4u w = *(const GAS v4u*)(Z + (size_t)(row0 + tt) * DIN + ch0);
                    f[r][0] = bflo(w.x); f[r][1] = bfhi(w.x); f[r][2] = bflo(w.y); f[r][3] = bfhi(w.y); f[r][4] = bflo(w.z); f[r][5] = bfhi(w.z); f[r][6] = bflo(w.w); f[r][7] = bfhi(w.w);
                } else {
#pragma unroll
                    for (int e = 0; e < 8; ++e) f[r][e] = 0.f; }
            }
#pragma unroll
            for (int rr = 0; rr < 2; ++rr) { const int tl = 2 * tr + rr, t = t0 + tl; float xc[8];
#pragma unroll
                for (int e = 0; e < 8; ++e) xc[e] = cbv[e] + cw[0][e] * f[rr][e] + cw[1][e] * f[rr + 1][e] + cw[2][e] * f[rr + 2][e] + cw[3][e] * f[rr + 3][e];
                *(LAS f32x4*)(XC + tl * 64 + cg * 8) = (f32x4){xc[0], xc[1], xc[2], xc[3]}; *(LAS f32x4*)(XC + tl * 64 + cg * 8 + 4) = (f32x4){xc[4], xc[5], xc[6], xc[7]};
                v4u pw; pw.x = pk2(xc[0], xc[1]); pw.y = pk2(xc[2], xc[3]); pw.z = pk2(xc[4], xc[5]); pw.w = pk2(xc[6], xc[7]);
                *(LAS v4u*)(XCB + tl * 72 + cg * 8) = pw;
                if (t >= T - 3 && t < T) { float* oc = out_conv + (size_t)(t - (T - 3)) * DM + ch0;
                    *(GAS f32x4*)oc = (f32x4){f[rr + 3][0], f[rr + 3][1], f[rr + 3][2], f[rr + 3][3]}; *(GAS f32x4*)(oc + 4) = (f32x4){f[rr + 3][4], f[rr + 3][5], f[rr + 3][6], f[rr + 3][7]}; }
            }
        }
        __syncthreads();
        if (tb * 32 < nrows) {
            f32x16 accr, acci;
#pragma unroll
            for (int i = 0; i < 16; ++i) { accr[i] = 0.f; acci[i] = 0.f; }
#pragma unroll
            for (int ks = 0; ks < 4; ++ks) { const bf16x8 A = *(const LAS bf16x8*)(XCB + (tb * 32 + (lane & 31)) * 72 + ks * 16 + hi * 8);
                accr = __builtin_amdgcn_mfma_f32_32x32x16_bf16(A, Br[ks], accr, 0, 0, 0);
                acci = __builtin_amdgcn_mfma_f32_32x32x16_bf16(A, Bi[ks], acci, 0, 0, 0); }
#pragma unroll
            for (int rg = 0; rg < 16; ++rg) { const int tl = tb * 32 + (rg & 3) + 8 * (rg >> 2) + 4 * hi;
                const float xcv = XC[tl * 64 + jl];
                const float r = pg8::sigmoid_f(accr[rg] + ba), ig = pg8::sigmoid_f(acci[rg] + bx);
                const float l2a = cA * r;
                const float av = __builtin_amdgcn_exp2f(l2a);
                const float y = l2a * 1.3862943611198906f;
                const float ser = -y * (1.0f + y * (0.5f + y * (0.16666667f + y * (0.041666668f + y * (0.0083333338f + y * 0.0013888889f)))));
                const float om = (y > -0.25f) ? ser : (1.0f - av * av);
                const float uv = sqrtf(om) * (ig * xcv);
                AS[tl * 64 + jl] = av; US[tl * 64 + jl] = uv; }
        }
        __syncthreads();
        if (seg * 16 < nrows) { float Ap = 1.f, Bp = 0.f;
#pragma unroll
            for (int s = 0; s < 16; ++s) { const float av = AS[(seg * 16 + s) * 64 + sc], uv = US[(seg * 16 + s) * 64 + sc]; Bp = av * Bp + uv; Ap *= av; }
            SEGA[seg * 64 + sc] = Ap; SEGB[seg * 64 + sc] = Bp; }
        __syncthreads();
        if (seg * 16 < nrows) { float h = CAR[par * 64 + sc];
            for (int sg = 0; sg < seg; ++sg) h = SEGA[sg * 64 + sc] * h + SEGB[sg * 64 + sc];
#pragma unroll
            for (int s = 0; s < 16; ++s) { const int tl = seg * 16 + s; h = AS[tl * 64 + sc] * h + US[tl * 64 + sc]; US[tl * 64 + sc] = h;
                if (t0 + tl == T - 1) out_h[hd * 64 + sc] = h; }
            if (seg == 7) CAR[(par ^ 1) * 64 + sc] = h; }
        __syncthreads();
#pragma unroll
        for (int rr = 0; rr < 2; ++rr) { const int tl = 2 * tr + rr;
            if (tl < nrows) { bf16* zp = Z + (size_t)(row0 + t0 + tl) * DIN + 1024 + ch0; const v4u w = *(const GAS v4u*)zp;
                const f32x4 h0v = *(const LAS f32x4*)(US + tl * 64 + cg * 8), h1v = *(const LAS f32x4*)(US + tl * 64 + cg * 8 + 4);
                v4u o; o.x = pk2(h0v.x * bflo(w.x), h0v.y * bfhi(w.x)); o.y = pk2(h0v.z * bflo(w.y), h0v.w * bfhi(w.y));
                o.z = pk2(h1v.x * bflo(w.z), h1v.y * bfhi(w.z)); o.w = pk2(h1v.z * bflo(w.w), h1v.w * bfhi(w.w));
                *(GAS v4u*)zp = o; } }
    }
}

__device__ __forceinline__ int vt_off(int d, int q) { return d * 256 + ((((q >> 3) ^ (d & 15) ^ ((d >> 4) & 7)) & 15) << 4) + (q & 7) * 2; }
__device__ __forceinline__ void p2b_item(Frame& F, const Args& a, int item) {
    LAS unsigned char* lds = F.lds;
    LAS unsigned char* VT = lds;
    LAS float* ST = (LAS float*)(lds + 32768);
    bf16* Z = (bf16*)(a.ws + WS_Z);
    const int tid = F.tid, lane = F.lane, wave = F.wave;
    const bool sample = item >= MP / 128;
    const int row0 = item * 128;
    const bf16* Wm = (const bf16*)(a.ws + (sample ? WS_WSS : WS_WSM));
    __syncthreads();
    for (int rr = 0; rr < 16; ++rr) { const int q = wave * 16 + rr; const bf16* zp = Z + (size_t)(row0 + q) * DIN + 3072;
        const v4u w0 = *(const GAS v4u*)(zp + lane * 8), w1 = *(const GAS v4u*)(zp + 512 + lane * 8);
        float v[16]; v[0] = bflo(w0.x); v[1] = bfhi(w0.x); v[2] = bflo(w0.y); v[3] = bfhi(w0.y); v[4] = bflo(w0.z); v[5] = bfhi(w0.z); v[6] = bflo(w0.w); v[7] = bfhi(w0.w);
        v[8] = bflo(w1.x); v[9] = bfhi(w1.x); v[10] = bflo(w1.y); v[11] = bfhi(w1.y); v[12] = bflo(w1.z); v[13] = bfhi(w1.z); v[14] = bflo(w1.w); v[15] = bfhi(w1.w);
        float s = 0.f;
#pragma unroll
        for (int e = 0; e < 16; ++e) s += v[e];
        const float mean = wave_sum(s) * (1.f / 1024.f); float s2 = 0.f;
#pragma unroll
        for (int e = 0; e < 16; ++e) { const float d = v[e] - mean; s2 += d * d; }
        const float rstd = 1.0f / sqrtf(wave_sum(s2) * (1.f / 1024.f) + EPS);
        if (lane == 0) { ST[q * 2] = mean; ST[q * 2 + 1] = rstd; } }
    __syncthreads();
    const int cchunk = tid & 15, qg = tid >> 4;
    const int db = wave & 3, pb0 = (wave >> 2) * 2, hi = lane >> 5;
    for (int g = 0; g < 8; ++g) {
        { const int d0 = cchunk * 8, col = g * 128 + d0;
          const f32x4 g0 = *(const GAS f32x4*)(a.in[I_LNG] + col), g1 = *(const GAS f32x4*)(a.in[I_LNG] + col + 4), b0 = *(const GAS f32x4*)(a.in[I_LNB] + col), b1 = *(const GAS f32x4*)(a.in[I_LNB] + col + 4);
          const float lg[8] = {g0.x, g0.y, g0.z, g0.w, g1.x, g1.y, g1.z, g1.w}, lb[8] = {b0.x, b0.y, b0.z, b0.w, b1.x, b1.y, b1.z, b1.w};
          float vn[4][8];
#pragma unroll
          for (int r = 0; r < 4; ++r) { const int q = qg * 4 + r; const v4u w = *(const GAS v4u*)(Z + (size_t)(row0 + q) * DIN + 3072 + col);
              const float mean = ST[q * 2], rstd = ST[q * 2 + 1];
              const float x[8] = {bflo(w.x), bfhi(w.x), bflo(w.y), bfhi(w.y), bflo(w.z), bfhi(w.z), bflo(w.w), bfhi(w.w)};
#pragma unroll
              for (int e = 0; e < 8; ++e) vn[r][e] = (x[e] - mean) * rstd * lg[e] + lb[e];
              if (sample) { float* ov = a.out + O_VS + (size_t)(row0 - MP + q) * DM + col;
                  *(GAS f32x4*)ov = (f32x4){vn[r][0], vn[r][1], vn[r][2], vn[r][3]}; *(GAS f32x4*)(ov + 4) = (f32x4){vn[r][4], vn[r][5], vn[r][6], vn[r][7]}; } }
#pragma unroll
          for (int e = 0; e < 8; ++e) { v2u o; o.x = pk2(vn[0][e], vn[1][e]); o.y = pk2(vn[2][e], vn[3][e]); *(LAS v2u*)(VT + vt_off(d0 + e, qg * 4)) = o; } }
        __syncthreads();
        { f32x16 acc[2];
#pragma unroll
          for (int i = 0; i < 16; ++i) { acc[0][i] = 0.f; acc[1][i] = 0.f; }
          const bf16* wg = Wm + (size_t)g * 16384;
          const int kmax = (!sample && pb0 == 0) ? 4 : 8;
          const int d = db * 32 + (lane & 31);
          for (int ks = 0; ks < kmax; ++ks) { const bf16x8 A = *(const LAS bf16x8*)(VT + vt_off(d, ks * 16 + hi * 8));
#pragma unroll
              for (int pi = 0; pi < 2; ++pi) { const bf16x8 B = *(const GAS bf16x8*)(wg + ((pb0 + pi) * 32 + (lane & 31)) * 128 + ks * 16 + hi * 8);
                  acc[pi] = __builtin_amdgcn_mfma_f32_32x32x16_bf16(A, B, acc[pi], 0, 0, 0); } }
#pragma unroll
          for (int pi = 0; pi < 2; ++pi) { const int p = (pb0 + pi) * 32 + (lane & 31); const float bs = a.in[I_BS][g * 128 + (sample ? (p & 31) : p)];
              bf16* zrow = Z + (size_t)(row0 + p) * DIN + 2048 + g * 128 + db * 32 + 4 * hi;
#pragma unroll
              for (int rq = 0; rq < 4; ++rq) { bf16* zp = zrow + 8 * rq; const v2u w = *(const GAS v2u*)zp;
                  v2u o; o.x = pk2((acc[pi][rq * 4 + 0] + bs) * bflo(w.x), (acc[pi][rq * 4 + 1] + bs) * bfhi(w.x)); o.y = pk2((acc[pi][rq * 4 + 2] + bs) * bflo(w.y), (acc[pi][rq * 4 + 3] + bs) * bfhi(w.y));
                  *(GAS v2u*)zp = o; } } }
        __syncthreads();
    }
}

__device__ __forceinline__ void p5_rows(Frame& F, const Args& a) {
    const int gw = F.vcu * NWAVES + F.wave, NGW = F.G * NWAVES, lane = F.lane;
    const bf16* MIX = (const bf16*)(a.ws + WS_MIX); bf16* HN = (bf16*)(a.ws + WS_XN);
    f32x4 g1[4], g2[4];
#pragma unroll
    for (int j = 0; j < 4; ++j) { g1[j] = ((const GAS f32x4*)a.in[I_GPOST])[lane + 64 * j]; g2[j] = ((const GAS f32x4*)a.in[I_GFFN])[lane + 64 * j]; }
    for (int m = gw; m < M; m += NGW) { const GAS f32x4* xr = (const GAS f32x4*)xrow_ptr(a, m) + lane; const GAS v2u* mr = (const GAS v2u*)(MIX + (size_t)m * DM) + lane;
        f32x4 x[4], mx[4]; float s = 0.f;
#pragma unroll
        for (int j = 0; j < 4; ++j) { x[j] = xr[64 * j]; const v2u w = mr[64 * j]; mx[j] = (f32x4){bflo(w.x), bfhi(w.x), bflo(w.y), bfhi(w.y)};
            s += (mx[j].x * mx[j].x + mx[j].y * mx[j].y) + (mx[j].z * mx[j].z + mx[j].w * mx[j].w); }
        const float r1 = 1.0f / sqrtf(wave_sum(s) * (1.f / DM) + EPS); float s2 = 0.f;
#pragma unroll
        for (int j = 0; j < 4; ++j) { x[j] = x[j] + mx[j] * r1 * g1[j]; s2 += (x[j].x * x[j].x + x[j].y * x[j].y) + (x[j].z * x[j].z + x[j].w * x[j].w); }
        const float r2 = 1.0f / sqrtf(wave_sum(s2) * (1.f / DM) + EPS);
        GAS v2u* o8 = (GAS v2u*)(HN + (size_t)m * DM) + lane;
#pragma unroll
        for (int j = 0; j < 4; ++j) { const f32x4 h = x[j] * r2 * g2[j]; v2u o; o.x = pk2(h.x, h.y); o.y = pk2(h.z, h.w); o8[64 * j] = o; } }
}
__device__ __forceinline__ void p8_rows(Frame& F, const Args& a) {
    const int gw = F.vcu * NWAVES + F.wave, NGW = F.G * NWAVES, lane = F.lane;
    const bf16* MIX = (const bf16*)(a.ws + WS_MIX); const bf16* FF = (const bf16*)(a.ws + WS_F);
    f32x4 g1[4], g3[4];
#pragma unroll
    for (int j = 0; j < 4; ++j) { g1[j] = ((const GAS f32x4*)a.in[I_GPOST])[lane + 64 * j]; g3[j] = ((const GAS f32x4*)a.in[I_GPF])[lane + 64 * j]; }
    for (int m = gw; m < M; m += NGW) { const GAS f32x4* xr = (const GAS f32x4*)xrow_ptr(a, m) + lane; const GAS v2u* mr = (const GAS v2u*)(MIX + (size_t)m * DM) + lane; const GAS v2u* fr = (const GAS v2u*)(FF + (size_t)m * DM) + lane;
        f32x4 x[4], mx[4], fx[4]; float s = 0.f, sf = 0.f;
#pragma unroll
        for (int j = 0; j < 4; ++j) { x[j] = xr[64 * j]; const v2u w = mr[64 * j]; mx[j] = (f32x4){bflo(w.x), bfhi(w.x), bflo(w.y), bfhi(w.y)}; const v2u wf = fr[64 * j]; fx[j] = (f32x4){bflo(wf.x), bfhi(wf.x), bflo(wf.y), bfhi(wf.y)};
            s += (mx[j].x * mx[j].x + mx[j].y * mx[j].y) + (mx[j].z * mx[j].z + mx[j].w * mx[j].w); sf += (fx[j].x * fx[j].x + fx[j].y * fx[j].y) + (fx[j].z * fx[j].z + fx[j].w * fx[j].w); }
        const float r1 = 1.0f / sqrtf(wave_sum(s) * (1.f / DM) + EPS), r3 = 1.0f / sqrtf(wave_sum(sf) * (1.f / DM) + EPS);
        GAS f32x4* o = (GAS f32x4*)(a.out + O_Y + (size_t)m * DM) + lane;
#pragma unroll
        for (int j = 0; j < 4; ++j) o[64 * j] = x[j] + mx[j] * r1 * g1[j] + fx[j] * r3 * g3[j]; }
}

__global__ void __launch_bounds__(NWAVES * 64, 2) hawk_fwd(Args args) {
    extern __shared__ __attribute__((aligned(16))) unsigned char lds[];
    Frame F;
    F.lds = (LAS unsigned char*)lds;
    F.MISC = (volatile LAS unsigned*)(F.lds + MISC_OFF);
    F.tid = threadIdx.x; F.lane = F.tid & 63; F.wave = __builtin_amdgcn_readfirstlane(F.tid >> 6);
    F.G = gridDim.x; { const int bx = blockIdx.x; F.vcu = (F.G % 8 == 0) ? (bx % 8) * (F.G / 8) + bx / 8 : bx; }
    unsigned char* ws = args.ws;
    F.ctl = (gu32*)(ws + WS_CTL);
    for (int u = F.tid; u < (LDS_BYTES - LDSCTL_OFF) / 4; u += NWAVES * 64) ((LAS unsigned*)(F.lds + LDSCTL_OFF))[u] = 0u;
    __syncthreads();
    XcdBarrier bar; bar.bar = (unsigned*)(F.ctl + CW_BAR); bar.x = 0; bar.st = nullptr;
    if (N_LAUNCHES != PER_PHASE) bar = xcd_barrier_post((unsigned*)(F.ctl + CW_BAR), F.MISC + 8);
#define GRID_BAR() do { if (N_LAUNCHES != PER_PHASE) xcd_barrier(bar); } while (0)
    const int lo = args.ph_lo, hi = args.ph_hi;
#define IN(k) (lo <= (k) && (k) < hi)
#define BOTH(k) (IN(k) && IN((k) + 1))
    bf16* XN = (bf16*)(ws + WS_XN); bf16* Z = (bf16*)(ws + WS_Z);

    if (IN(0)) { p0_prologue(F, args); if (BOTH(0)) GRID_BAR(); }

    if (IN(1)) {
        pg8::Gemm g{XN, (const bf16*)(ws + WS_W1), DM, DM, DM}; pg8::StaticOrder S; S.init(M, DIN, F.G, (int)blockIdx.x);
        pg8::EpiZ E{Z, DIN};
        pg8::gemm_phase<pg8::EpiZ, pg8::StaticOrder, PG8_ALIGN, PG8_SP2>(F.lds + RING_OFF, g, S, E);
        if (BOTH(1)) GRID_BAR();
    }
    if (IN(2)) {
        for (int it = blockIdx.x; it < 2 * NB * 16; it += F.G) {
            if (it < NB * 16) { const int b = it >> 4, hd = it & 15;
                p2a_item(F, args, b * SEQ, SEQ, hd, nullptr, nullptr, args.out + O_HP + (size_t)b * DM, args.out + O_CP + (size_t)b * 3 * DM); }
            else { const int b = (it - NB * 16) >> 4, hd = it & 15;
                p2a_item(F, args, MP + b * DEC_T, DEC_T, hd, args.in[I_SH] + (size_t)b * DM, args.in[I_SC] + (size_t)b * 3 * DM, args.out + O_HS + (size_t)b * DM, args.out + O_CS + (size_t)b * 3 * DM); }
        }
        for (int it = blockIdx.x; it < M / 128; it += F.G) p2b_item(F, args, it);
        if (BOTH(2)) GRID_BAR();
    }
    if (IN(3)) {
        pg8::Gemm g{Z + 1024, (const bf16*)(ws + WS_W2), DIN, 2048, 2048}; pg8::StaticOrder S; S.init(M, DM, F.G, (int)blockIdx.x);
        pg8::EpiGate E{Z + 4096, DIN, XN, DM};
        pg8::gemm_phase<pg8::EpiGate, pg8::StaticOrder, PG8_ALIGN, PG8_SP2>(F.lds + RING_OFF, g, S, E);
        if (BOTH(3)) GRID_BAR();
    }
    if (IN(4)) {
        pg8::Gemm g{XN, (const bf16*)(ws + WS_W3), DM, DM, DM}; pg8::StaticOrder S; S.init(M, DM, F.G, (int)blockIdx.x);
        pg8::EpiBf16 E{(bf16*)(ws + WS_MIX), DM};
        pg8::gemm_phase<pg8::EpiBf16, pg8::StaticOrder, PG8_ALIGN, PG8_SP2>(F.lds + RING_OFF, g, S, E);
        if (BOTH(4)) GRID_BAR();
    }
    if (IN(5)) { p5_rows(F, args); if (BOTH(5)) GRID_BAR(); }
    if (IN(6)) {
        pg8::Gemm g{XN, (const bf16*)(ws + WS_W4), DM, DM, DM}; pg8::StaticOrder S; S.init(M, DFF2, F.G, (int)blockIdx.x);
        pg8::EpiSwiGLU E{(bf16*)(ws + WS_FIN), DFF};
        pg8::gemm_phase<pg8::EpiSwiGLU, pg8::StaticOrder, PG8_ALIGN, PG8_SP2>(F.lds + RING_OFF, g, S, E);
        if (BOTH(6)) GRID_BAR();
    }
    if (IN(7)) {
        pg8::Gemm g{(const bf16*)(ws + WS_FIN), (const bf16*)(ws + WS_W5), DFF, DFF, DFF}; pg8::StaticOrder S; S.init(M, DM, F.G, (int)blockIdx.x);
        pg8::EpiBf16 E{(bf16*)(ws + WS_F), DM};
        pg8::gemm_phase<pg8::EpiBf16, pg8::StaticOrder, PG8_ALIGN, PG8_SP2>(F.lds + RING_OFF, g, S, E);
        if (BOTH(7)) GRID_BAR();
    }
    if (IN(8)) { p8_rows(F, args); }
#undef IN
#undef BOTH
#undef GRID_BAR
}

extern "C" void kernel_launch(void* const* d_in, const int* in_sizes, int n_in, void* d_out, int out_size, void* d_ws, size_t ws_size, hipStream_t stream) {
    static int grid = 0;
    if (grid == 0) {
        if (n_in != N_IN || in_sizes[0] != MP * DM || (size_t)out_size != O_END || ws_size < WS_END) {
            fprintf(stderr, "kernel_launch: shape mismatch (n_in %d, in0 %d, out %d, ws %zu; need ws >= %zu); nothing launched\n", n_in, n_in > 0 ? in_sizes[0] : -1, out_size, ws_size, (size_t)WS_END); grid = -1; return; }
        int dev = 0, cus = 0, per_cu = 0;
        if (hipGetDevice(&dev) != hipSuccess || hipDeviceGetAttribute(&cus, hipDeviceAttributeMultiprocessorCount, dev) != hipSuccess) { fprintf(stderr, "kernel_launch: device query failed\n"); grid = -1; return; }
        if (hipFuncSetAttribute((const void*)hawk_fwd, hipFuncAttributeMaxDynamicSharedMemorySize, LDS_BYTES) != hipSuccess) { fprintf(stderr, "kernel_launch: hipFuncSetAttribute failed\n"); grid = -1; return; }
        if (hipOccupancyMaxActiveBlocksPerMultiprocessor(&per_cu, (const void*)hawk_fwd, NWAVES * 64, LDS_BYTES) != hipSuccess || per_cu < 1) {
            fprintf(stderr, "kernel_launch: occupancy query reports %d workgroups per CU; nothing launched\n", per_cu); (void)hipGetLastError(); grid = -1; return; }
        grid = cus;
    }
    if (grid < 0) return;
    if (hipMemsetAsync((char*)d_ws + WS_CTL, 0, CTL_ZERO_BYTES, stream) != hipSuccess) { fprintf(stderr, "kernel_launch: memset failed\n"); return; }
    Args a{};
    for (int i = 0; i < N_IN; ++i) a.in[i] = (const float*)d_in[i];
    a.out = (float*)d_out; a.ws = (unsigned char*)d_ws;
    for (int li = 0; li < N_LAUNCHES; ++li) {
        a.ph_lo = (N_LAUNCHES == PER_PHASE) ? li : 0; a.ph_hi = (N_LAUNCHES == PER_PHASE) ? li + 1 : PER_PHASE; a.li = li;
        hipLaunchKernelGGL(hawk_fwd, dim3(grid), dim3(NWAVES * 64), LDS_BYTES, stream, a);
        const hipError_t le = hipPeekAtLastError();
        if (le != hipSuccess) { fprintf(stderr, "kernel_launch: launch %d failed: %s\n", li, hipGetErrorName(le)); break; }
    }
}
```

```cpp
#include <hip/hip_runtime.h>
#include <cstdio>
#include <cstdint>

#ifndef MK_N_LAUNCHES
#define MK_N_LAUNCHES 1
#endif
#ifndef PROBE_DOUBLE
#define PROBE_DOUBLE -1
#endif

namespace pg8 {
#define PG8_LAS __attribute__((address_space(3)))
typedef unsigned short bf16_t;
typedef short bf16x8 __attribute__((ext_vector_type(8)));
typedef float f32x4 __attribute__((ext_vector_type(4)));
typedef unsigned u32x4 __attribute__((ext_vector_type(4)));
constexpr int BM = 256, BK = 64, HALF = 128, HTB = HALF * BK * 2  , STAGE_BYTES = 8 * HTB, NXCD = 8, WGM = 8;

__host__ __device__ __forceinline__ int lds_byte(int r, int c) { const int st = (r >> 4) * 2 + (c >> 5), rr = r & 15, cc = c & 31, ob = rr * 64 + cc * 2; return st * 1024 + (ob ^ (((ob >> 9) & 1) << 5)); }
__host__ __device__ __forceinline__ void stage_rc(int b, int& R, int& C) { const int st = b / 1024, sb = b % 1024, swz = sb ^ (((sb >> 9) & 1) << 5); R = (st >> 1) * 16 + swz / 64; C = (st & 1) * 32 + (swz % 64) / 2; }
__host__ __device__ __forceinline__ int perm32(int rho) { const int n = rho >> 4, i = rho & 15; return 8 * (i >> 2) + 4 * n + (i & 3); }

struct Unit { int pm, pn; };
struct Gemm { const bf16_t* A; const bf16_t* Bt; int lda, ldb, K; };

struct StaticOrder {
    int nM, nN, nwg, G, c;
    __host__ __device__ void init(int M, int N, int G_, int c_) { nM = M / BM; nN = N / BM; nwg = nM * nN; G = G_; c = c_; }
    __host__ __device__ bool next(int i, Unit& u) const {
        const long L = (long)i * G + c; if (L >= nwg) return false;
        int wgid = (int)L; { const int q = nwg / NXCD, r = nwg % NXCD, xcd = wgid % NXCD, off = wgid / NXCD; wgid = (xcd < r ? xcd * (q + 1) : r * (q + 1) + (xcd - r) * q) + off; }
        const int nig = WGM * nN, gid = wgid / nig, fm = gid * WGM, gsz = (nM - fm) < WGM ? (nM - fm) : WGM;
        u.pm = fm + ((wgid % nig) % gsz); u.pn = (wgid % nig) / gsz; return true;
    }
    __device__ __forceinline__ void a_ready(const Unit&) const {}
    __device__ __forceinline__ void done(const Unit&) const {}
};

__device__ __forceinline__ unsigned cvt_pk_bf16(float lo, float hi) { unsigned r; asm volatile("v_cvt_pk_bf16_f32 %0, %1, %2" : "=v"(r) : "v"(lo), "v"(hi)); return r; }
__device__ __forceinline__ float bf_lo(unsigned w) { return __uint_as_float(w << 16); }
__device__ __forceinline__ float bf_hi(unsigned w) { return __uint_as_float(w & 0xffff0000u); }
__device__ __forceinline__ float sigmoid_f(float x) { return __builtin_amdgcn_rcpf(1.0f + __builtin_amdgcn_exp2f(-1.4426950408889634f * x)); }
__device__ __forceinline__ float gelu_tanh_f(float x) { const float t = x * (-2.3022081986f + -0.1029432446f * x * x); return x * __builtin_amdgcn_rcpf(1.0f + __builtin_amdgcn_exp2f(t)); }
__device__ __forceinline__ float silu_f(float x) { return x * sigmoid_f(x); }

struct EpiZ {
    static constexpr bool PERM = true, AFTER_DRAIN = false, HAS_MID = false; static constexpr int TMID = -1;
    bf16_t* Z; int ldc;
    __device__ __forceinline__ void mid(f32x4 (&)[2][2][4][2], const Unit&, int, int, int, int) const {}
    __device__ __forceinline__ void operator()(const f32x4 (&acc)[2][2][4][2], const Unit& u, int wr, int wc, int fr, int fq) const {
        int row0 = u.pm * BM + wr * 64 + fr; const int col0 = u.pn * BM + wc * 32 + 8 * fq; asm volatile("" : "+v"(row0));
        const int mode = u.pn < 4 ? 0 : (u.pn < 16 ? 1 : 2);
#pragma unroll
        for (int ai = 0; ai < 2; ++ai)
#pragma unroll
            for (int m = 0; m < 4; ++m) { bf16_t* rowp = Z + (size_t)(row0 + ai * HALF + m * 16) * ldc + col0;
#pragma unroll
                for (int bj = 0; bj < 2; ++bj) { f32x4 v0 = acc[ai][bj][m][0], v1 = acc[ai][bj][m][1];
                    if (mode == 1) {
#pragma unroll
                        for (int j = 0; j < 4; ++j) { v0[j] = gelu_tanh_f(v0[j]); v1[j] = gelu_tanh_f(v1[j]); } }
                    else if (mode == 2) {
#pragma unroll
                        for (int j = 0; j < 4; ++j) { v0[j] = sigmoid_f(v0[j]); v1[j] = sigmoid_f(v1[j]); } }
                    u32x4 w; w.x = cvt_pk_bf16(v0[0], v0[1]); w.y = cvt_pk_bf16(v0[2], v0[3]); w.z = cvt_pk_bf16(v1[0], v1[1]); w.w = cvt_pk_bf16(v1[2], v1[3]);
                    *(u32x4*)(rowp + bj * HALF) = w; } }
    }
};
struct EpiBf16 {
    static constexpr bool PERM = true, AFTER_DRAIN = false, HAS_MID = false; static constexpr int TMID = -1;
    bf16_t* O; int ldc;
    __device__ __forceinline__ void mid(f32x4 (&)[2][2][4][2], const Unit&, int, int, int, int) const {}
    __device__ __forceinline__ void operator()(const f32x4 (&acc)[2][2][4][2], const Unit& u, int wr, int wc, int fr, int fq) const {
        int row0 = u.pm * BM + wr * 64 + fr; const int col0 = u.pn * BM + wc * 32 + 8 * fq; asm volatile("" : "+v"(row0));
#pragma unroll
        for (int ai = 0; ai < 2; ++ai)
#pragma unroll
            for (int m = 0; m < 4; ++m) { bf16_t* rowp = O + (size_t)(row0 + ai * HALF + m * 16) * ldc + col0;
#pragma unroll
                for (int bj = 0; bj < 2; ++bj) { const f32x4 v0 = acc[ai][bj][m][0], v1 = acc[ai][bj][m][1];
                    u32x4 w; w.x = cvt_pk_bf16(v0[0], v0[1]); w.y = cvt_pk_bf16(v0[2], v0[3]); w.z = cvt_pk_bf16(v1[0], v1[1]); w.w = cvt_pk_bf16(v1[2], v1[3]);
                    *(u32x4*)(rowp + bj * HALF) = w; } }
    }
};
struct EpiGate {
    static constexpr bool PERM = true, AFTER_DRAIN = false, HAS_MID = true; static constexpr int TMID = 16;
    const bf16_t* Zg; int ldz;
    bf16_t* O; int ldc;
    __device__ __forceinline__ void mid(f32x4 (&acc)[2][2][4][2], const Unit& u, int wr, int wc, int fr, int fq) const {
        int row0 = u.pm * BM + wr * 64 + fr; const int col0 = u.pn * BM + wc * 32 + 8 * fq; asm volatile("" : "+v"(row0));
#pragma unroll
        for (int ai = 0; ai < 2; ++ai)
#pragma unroll
            for (int m = 0; m < 4; ++m) { const bf16_t* rowp = Zg + (size_t)(row0 + ai * HALF + m * 16) * ldz + col0;
#pragma unroll
                for (int bj = 0; bj < 2; ++bj) { const u32x4 ga = *(const u32x4*)(rowp + bj * HALF), gb = *(const u32x4*)(rowp + 1024 + bj * HALF);
                    f32x4 r0, r1;
                    r0[0] = bf_lo(ga.x) * __builtin_amdgcn_rcpf(fmaxf(bf_lo(gb.x), 1e-30f)); r0[1] = bf_hi(ga.x) * __builtin_amdgcn_rcpf(fmaxf(bf_hi(gb.x), 1e-30f));
                    r0[2] = bf_lo(ga.y) * __builtin_amdgcn_rcpf(fmaxf(bf_lo(gb.y), 1e-30f)); r0[3] = bf_hi(ga.y) * __builtin_amdgcn_rcpf(fmaxf(bf_hi(gb.y), 1e-30f));
                    r1[0] = bf_lo(ga.z) * __builtin_amdgcn_rcpf(fmaxf(bf_lo(gb.z), 1e-30f)); r1[1] = bf_hi(ga.z) * __builtin_amdgcn_rcpf(fmaxf(bf_hi(gb.z), 1e-30f));
                    r1[2] = bf_lo(ga.w) * __builtin_amdgcn_rcpf(fmaxf(bf_lo(gb.w), 1e-30f)); r1[3] = bf_hi(ga.w) * __builtin_amdgcn_rcpf(fmaxf(bf_hi(gb.w), 1e-30f));
                    acc[ai][bj][m][0] *= r0; acc[ai][bj][m][1] *= r1; } }
    }
    __device__ __forceinline__ void operator()(const f32x4 (&acc)[2][2][4][2], const Unit& u, int wr, int wc, int fr, int fq) const {
        int row0 = u.pm * BM + wr * 64 + fr; const int col0 = u.pn * BM + wc * 32 + 8 * fq; asm volatile("" : "+v"(row0));
#pragma unroll
        for (int ai = 0; ai < 2; ++ai)
#pragma unroll
            for (int m = 0; m < 4; ++m) { const size_t r = (size_t)(row0 + ai * HALF + m * 16);
#pragma unroll
                for (int bj = 0; bj < 2; ++bj) { const u32x4 gb = *(const u32x4*)(Zg + r * ldz + col0 + 1024 + bj * HALF);
                    f32x4 v0 = acc[ai][bj][m][0], v1 = acc[ai][bj][m][1];
                    v0[0] *= fmaxf(bf_lo(gb.x), 1e-30f); v0[1] *= fmaxf(bf_hi(gb.x), 1e-30f); v0[2] *= fmaxf(bf_lo(gb.y), 1e-30f); v0[3] *= fmaxf(bf_hi(gb.y), 1e-30f);
                    v1[0] *= fmaxf(bf_lo(gb.z), 1e-30f); v1[1] *= fmaxf(bf_hi(gb.z), 1e-30f); v1[2] *= fmaxf(bf_lo(gb.w), 1e-30f); v1[3] *= fmaxf(bf_hi(gb.w), 1e-30f);
                    u32x4 w; w.x = cvt_pk_bf16(v0[0], v0[1]); w.y = cvt_pk_bf16(v0[2], v0[3]); w.z = cvt_pk_bf16(v1[0], v1[1]); w.w = cvt_pk_bf16(v1[2], v1[3]);
                    *(u32x4*)(O + r * ldc + col0 + bj * HALF) = w; } }
    }
};
struct EpiSwiGLU {
    static constexpr bool PERM = true, AFTER_DRAIN = false, HAS_MID = false; static constexpr int TMID = -1;
    bf16_t* O; int ldc;
    __device__ __forceinline__ void mid(f32x4 (&)[2][2][4][2], const Unit&, int, int, int, int) const {}
    __device__ __forceinline__ void operator()(const f32x4 (&acc)[2][2][4][2], const Unit& u, int wr, int wc, int fr, int fq) const {
        int row0 = u.pm * BM + wr * 64 + fr; const int col0 = u.pn * HALF + wc * 32 + 8 * fq; asm volatile("" : "+v"(row0));
#pragma unroll
        for (int ai = 0; ai < 2; ++ai)
#pragma unroll
            for (int m = 0; m < 4; ++m) { bf16_t* rowp = O + (size_t)(row0 + ai * HALF + m * 16) * ldc + col0;
                f32x4 v0, v1;
#pragma unroll
                for (int j = 0; j < 4; ++j) { v0[j] = silu_f(acc[ai][0][m][0][j]) * acc[ai][1][m][0][j]; v1[j] = silu_f(acc[ai][0][m][1][j]) * acc[ai][1][m][1][j]; }
                u32x4 w; w.x = cvt_pk_bf16(v0[0], v0[1]); w.y = cvt_pk_bf16(v0[2], v0[3]); w.z = cvt_pk_bf16(v1[0], v1[1]); w.w = cvt_pk_bf16(v1[2], v1[3]);
                *(u32x4*)rowp = w; }
    }
};

template <class Epi, class Sched, bool ALIGN_EPI = false, bool SP2 = false>
__device__ __forceinline__ void gemm_phase(PG8_LAS unsigned char* lds, const Gemm g, const Sched& S, const Epi& E) {
    const int tid = threadIdx.x, wid = __builtin_amdgcn_readfirstlane(tid >> 6), lane = tid & 63, wr = wid >> 2, wc = wid & 3, fr = lane & 15, fq = lane >> 4;
    const int K = g.K, nt = K / BK;
    unsigned voffA[2], voffB[2];
#pragma unroll
    for (int i = 0; i < 2; ++i) { int R, C; stage_rc(tid * 16 + i * 8192, R, C); const int Rb = Epi::PERM ? ((R & ~31) + perm32(R & 31)) : R;
        voffA[i] = (unsigned)(R * g.lda + C) * 2u; voffB[i] = (unsigned)(Rb * g.ldb + C) * 2u; }
    const size_t kstep = (size_t)(BK * 2);
    const size_t hstepA = (size_t)HALF * g.lda * 2, hstepB = (size_t)HALF * g.ldb * 2;
    const size_t tstepA = 2 * hstepA, tstepB = 2 * hstepB;
    const unsigned ldsw = (unsigned)wid * 1024u;
    const int aoff = lds_byte(wr * 64 + fr, fq * 8), boff = lds_byte(wc * 32 + fr, fq * 8);
#define PG8_SA(b, h) (((b) * 2 + (h)) * HTB)
#define PG8_SB(b, h) ((4 + (b) * 2 + (h)) * HTB)
#define PG8_STAGE(bufoff, gbase, voff) do { _Pragma("unroll") for (int _i = 0; _i < 2; ++_i) \
        __builtin_amdgcn_global_load_lds((const unsigned*)((const char*)(gbase) + (voff)[_i]), (PG8_LAS unsigned*)(lds + (bufoff) + ldsw + _i * 8192), 16, 0, 0); } while (0)
#define PG8_LDA(dst, b, h) do { _Pragma("unroll") for (int m = 0; m < 4; ++m) _Pragma("unroll") for (int k = 0; k < 2; ++k) dst[m][k] = *(const PG8_LAS bf16x8*)(lds + PG8_SA(b, h) + aoff + m * 2048 + k * 1024); } while (0)
#define PG8_LDB(dst, b, h) do { _Pragma("unroll") for (int n = 0; n < 2; ++n) _Pragma("unroll") for (int k = 0; k < 2; ++k) dst[n][k] = *(const PG8_LAS bf16x8*)(lds + PG8_SB(b, h) + boff + n * 2048 + k * 1024); } while (0)
#define PG8_MMA(ai, bj, At, Bt) do { __builtin_amdgcn_s_setprio(1); _Pragma("unroll") for (int m = 0; m < 4; ++m) _Pragma("unroll") for (int n = 0; n < 2; ++n) _Pragma("unroll") for (int k = 0; k < 2; ++k) \
        acc[ai][bj][m][n] = __builtin_amdgcn_mfma_f32_16x16x32_bf16(Bt[n][k], At[m][k], acc[ai][bj][m][n], 0, 0, 0); __builtin_amdgcn_s_setprio(0); } while (0)
#define PG8_WAIT_V(n) asm volatile("s_waitcnt vmcnt(" #n ")" ::: "memory")
#define PG8_WAIT_L(n) asm volatile("s_waitcnt lgkmcnt(" #n ")" ::: "memory")
#define PG8_BAR __builtin_amdgcn_s_barrier()
#define PG8_SCHED __builtin_amdgcn_sched_barrier(0)
    Unit cur, nxt; int ui = 0;
    if (!S.next(0, cur)) return;
    f32x4 acc[2][2][4][2];
#pragma unroll
    for (int a = 0; a < 2; ++a)
#pragma unroll
        for (int b = 0; b < 2; ++b)
#pragma unroll
            for (int m = 0; m < 4; ++m)
#pragma unroll
                for (int n = 0; n < 2; ++n) acc[a][b][m][n] = (f32x4){0.f, 0.f, 0.f, 0.f};
    bf16x8 At[4][2], B0[2][2], B1[2][2];
    const char* cA = (const char*)g.A + (size_t)cur.pm * tstepA; const char* cB = (const char*)g.Bt + (size_t)cur.pn * tstepB;
    S.a_ready(cur);
    if constexpr (SP2) {
        PG8_STAGE(PG8_SB(0, 0), cB, voffB); PG8_STAGE(PG8_SB(0, 1), cB + hstepB, voffB); PG8_STAGE(PG8_SA(0, 0), cA, voffA); PG8_STAGE(PG8_SA(0, 1), cA + hstepA, voffA);
        if (wr == 1) PG8_BAR;
        PG8_WAIT_V(2); PG8_BAR;
        PG8_STAGE(PG8_SB(1, 0), cB + kstep, voffB); PG8_STAGE(PG8_SA(1, 0), cA + kstep, voffA); PG8_STAGE(PG8_SB(1, 1), cB + hstepB + kstep, voffB);
        PG8_WAIT_V(6); PG8_BAR;
    } else {
        PG8_STAGE(PG8_SB(0, 0), cB, voffB); PG8_STAGE(PG8_SA(0, 0), cA, voffA); PG8_STAGE(PG8_SB(0, 1), cB + hstepB, voffB); PG8_STAGE(PG8_SA(0, 1), cA + hstepA, voffA);
        if (wr == 1) PG8_BAR;
        PG8_WAIT_V(4); PG8_BAR;
        PG8_STAGE(PG8_SB(1, 0), cB + kstep, voffB); PG8_STAGE(PG8_SA(1, 0), cA + kstep, voffA); PG8_STAGE(PG8_SB(1, 1), cB + hstepB + kstep, voffB);
        PG8_WAIT_V(6); PG8_BAR;
    }
    for (;;) {
        const bool has_next = S.next(ui + 1, nxt);
        const char* nA = has_next ? (const char*)g.A + (size_t)nxt.pm * tstepA : cA; const char* nB = has_next ? (const char*)g.Bt + (size_t)nxt.pn * tstepB : cB;
        for (int t = 0; t < nt; t += 2) {
            const bool last = (t == nt - 2);
            const char* a1 = cA + (size_t)(t + 1) * kstep;
            const char* a2 = last ? nA : cA + (size_t)(t + 2) * kstep; const char* b2 = last ? nB : cB + (size_t)(t + 2) * kstep;
            const char* a3 = a2 + kstep; const char* b3 = b2 + kstep;
            if (last && has_next) S.a_ready(nxt);
            if constexpr (Epi::HAS_MID) { if (t == Epi::TMID) E.mid(acc, cur, wr, wc, fr, fq); }
            if constexpr (SP2) {
            PG8_LDB(B0, 0, 0); PG8_LDB(B1, 0, 1); PG8_SCHED; PG8_LDA(At, 0, 0); PG8_STAGE(PG8_SA(1, 1), a1 + hstepA, voffA);
            PG8_WAIT_V(8); PG8_WAIT_L(0); PG8_BAR; PG8_MMA(0, 0, At, B0); PG8_MMA(0, 1, At, B1); PG8_BAR; PG8_SCHED;
            PG8_LDA(At, 0, 1); PG8_STAGE(PG8_SB(0, 0), b2, voffB); PG8_STAGE(PG8_SB(0, 1), b2 + hstepB, voffB); PG8_STAGE(PG8_SA(0, 0), a2, voffA);
            PG8_WAIT_V(8); PG8_WAIT_L(0); PG8_BAR; PG8_MMA(1, 0, At, B0); PG8_MMA(1, 1, At, B1); PG8_BAR; PG8_SCHED;
            PG8_LDB(B0, 1, 0); PG8_LDB(B1, 1, 1); PG8_SCHED; PG8_LDA(At, 1, 0); PG8_STAGE(PG8_SA(0, 1), a2 + hstepA, voffA);
            PG8_WAIT_V(8); PG8_WAIT_L(0); PG8_BAR; PG8_MMA(0, 0, At, B0); PG8_MMA(0, 1, At, B1); PG8_BAR; PG8_SCHED;
            PG8_LDA(At, 1, 1); PG8_STAGE(PG8_SB(1, 0), b3, voffB); PG8_STAGE(PG8_SB(1, 1), b3 + hstepB, voffB); PG8_STAGE(PG8_SA(1, 0), a3, voffA);
            PG8_WAIT_V(8); PG8_WAIT_L(0); PG8_BAR; PG8_MMA(1, 0, At, B0); PG8_MMA(1, 1, At, B1); PG8_BAR; PG8_SCHED;
            } else {
            PG8_LDB(B0, 0, 0); PG8_SCHED; PG8_LDA(At, 0, 0); PG8_STAGE(PG8_SA(1, 1), a1 + hstepA, voffA);
            PG8_WAIT_L(8); PG8_BAR; PG8_WAIT_L(0); PG8_MMA(0, 0, At, B0); PG8_BAR; PG8_SCHED;
            PG8_LDB(B1, 0, 1); PG8_STAGE(PG8_SB(0, 0), b2, voffB);
            PG8_BAR; PG8_WAIT_L(0); PG8_MMA(0, 1, At, B1); PG8_BAR;
            PG8_LDA(At, 0, 1); PG8_STAGE(PG8_SA(0, 0), a2, voffA);
            PG8_BAR; PG8_WAIT_L(0); PG8_MMA(1, 0, At, B0); PG8_BAR; PG8_SCHED;
            PG8_STAGE(PG8_SB(0, 1), b2 + hstepB, voffB);
            PG8_WAIT_V(6); PG8_BAR; PG8_MMA(1, 1, At, B1); PG8_BAR;
            PG8_LDB(B0, 1, 0); PG8_SCHED; PG8_LDA(At, 1, 0); PG8_STAGE(PG8_SA(0, 1), a2 + hstepA, voffA);
            PG8_WAIT_L(8); PG8_BAR; PG8_WAIT_L(0); PG8_MMA(0, 0, At, B0); PG8_BAR; PG8_SCHED;
            PG8_LDB(B1, 1, 1); PG8_STAGE(PG8_SB(1, 0), b3, voffB);
            PG8_BAR; PG8_WAIT_L(0); PG8_MMA(0, 1, At, B1); PG8_BAR;
            PG8_LDA(At, 1, 1); PG8_STAGE(PG8_SA(1, 0), a3, voffA);
            PG8_BAR; PG8_WAIT_L(0); PG8_MMA(1, 0, At, B0); PG8_BAR; PG8_SCHED;
            PG8_STAGE(PG8_SB(1, 1), b3 + hstepB, voffB);
            PG8_WAIT_V(6); PG8_BAR; PG8_MMA(1, 1, At, B1); PG8_BAR;
            }
        }
        if constexpr (ALIGN_EPI) { if (wr == 0) PG8_BAR; }
        E(acc, cur, wr, wc, fr, fq); S.done(cur);
        if (!has_next) break;
#pragma unroll
        for (int a = 0; a < 2; ++a)
#pragma unroll
            for (int b = 0; b < 2; ++b)
#pragma unroll
                for (int m = 0; m < 4; ++m)
#pragma unroll
                    for (int n = 0; n < 2; ++n) acc[a][b][m][n] = (f32x4){0.f, 0.f, 0.f, 0.f};
        cur = nxt; cA = nA; cB = nB; ++ui;
        if constexpr (ALIGN_EPI) { if (wr == 1) PG8_BAR; }
    }
    PG8_WAIT_V(0);
    if constexpr (!ALIGN_EPI) { if (wr == 0) PG8_BAR; }
    PG8_BAR;
#undef PG8_SA
#undef PG8_SB
#undef PG8_STAGE
#undef PG8_LDA
#undef PG8_LDB
#undef PG8_MMA
#undef PG8_WAIT_V
#undef PG8_WAIT_L
#undef PG8_BAR
#undef PG8_SCHED
}
}

#ifndef PG8_SP2
#define PG8_SP2 true
#endif
#ifndef PG8_ALIGN
#define PG8_ALIGN true
#endif

constexpr int NWAVES = 8;
constexpr int N_LAUNCHES = MK_N_LAUNCHES;
constexpr int PER_PHASE = 9;
constexpr int DM = 1024, SEQ = 2048, NB = 16, DEC_T = 32;
constexpr int MP = NB * SEQ, MS = NB * DEC_T, M = MP + MS;
constexpr int DIN = 6144, DFF = 2816, DFF2 = 5632;
constexpr float EPS = 1e-6f;
static_assert(M % 256 == 0, "M");
enum { I_XP = 0, I_XS, I_SH, I_SC, I_GPRE, I_WIN, I_CW, I_CB, I_WA, I_BA, I_WX, I_BX, I_LAM, I_WBRA, I_LNG, I_LNB, I_WS, I_BS, I_WBRB, I_WOUT, I_GPOST, I_GFFN, I_WFI, I_WFO, I_GPF, N_IN };
constexpr size_t O_Y = 0, O_HP = (size_t)M * DM, O_CP = O_HP + NB * DM, O_HS = O_CP + (size_t)NB * 3 * DM, O_CS = O_HS + NB * DM, O_VS = O_CS + (size_t)NB * 3 * DM, O_END = O_VS + (size_t)MS * DM;
static_assert(O_END == 34734080, "output size");

constexpr size_t MiB = 1u << 20;
constexpr size_t WS_CTL = 0, CTL_ZERO_BYTES = 1 * MiB;
constexpr size_t WS_W1 = 1 * MiB;
constexpr size_t WS_W2 = WS_W1 + (size_t)DIN * DM * 2;
constexpr size_t WS_W3 = WS_W2 + (size_t)DM * 2048 * 2;
constexpr size_t WS_W4 = WS_W3 + (size_t)DM * DM * 2;
constexpr size_t WS_W5 = WS_W4 + (size_t)DFF2 * DM * 2;
constexpr size_t WS_GT = WS_W5 + (size_t)DM * DFF * 2;
constexpr size_t WS_WSM = WS_GT + 16 * 128 * 64 * 2;
constexpr size_t WS_WSS = WS_WSM + 8 * 128 * 128 * 2;
constexpr size_t WS_WEND = WS_WSS + 8 * 128 * 128 * 2;
constexpr size_t WS_XN = 40 * MiB;
constexpr size_t WS_Z = 105 * MiB;
constexpr size_t WS_MIX = WS_Z;
constexpr size_t WS_FIN = WS_Z + 65 * MiB;
constexpr size_t WS_F = WS_FIN + 179 * MiB;
constexpr size_t WS_END = WS_Z + (size_t)M * DIN * 2;
static_assert(WS_WEND <= WS_XN && WS_XN + (size_t)M * DM * 2 <= WS_Z && WS_FIN + (size_t)M * DFF * 2 <= WS_F && WS_F + (size_t)M * DM * 2 <= WS_END && WS_END <= 512 * MiB, "d_ws map");
constexpr int CW_TMO = 0, CW_BAR = 4096;

constexpr int RING_OFF = 0, RING_BYTES = 131072;
constexpr int LDSCTL_OFF = RING_BYTES, MISC_OFF = LDSCTL_OFF + 320;
constexpr int LDS_BYTES = 147456;

#define GAS __attribute__((address_space(1)))
#define LAS __attribute__((address_space(3)))
typedef unsigned short bf16;
typedef unsigned v4u __attribute__((ext_vector_type(4)));
typedef unsigned v2u __attribute__((ext_vector_type(2)));
typedef float f32x4 __attribute__((ext_vector_type(4)));
typedef float f32x16 __attribute__((ext_vector_type(16)));
typedef short bf16x8 __attribute__((ext_vector_type(8)));
typedef GAS unsigned gu32;
#define RLX_AGENT __ATOMIC_RELAXED, __HIP_MEMORY_SCOPE_AGENT
#define LDS_WAIT() asm volatile("s_waitcnt lgkmcnt(0)" ::: "memory")
#define VM_WAIT() asm volatile("s_waitcnt vmcnt(0)" ::: "memory")
__device__ __forceinline__ unsigned f2bf(float f) { unsigned u = __builtin_bit_cast(unsigned, f); return (u + 0x7fffu + ((u >> 16) & 1u)) >> 16; }
__device__ __forceinline__ unsigned pk2(float lo, float hi) { return f2bf(lo) | (f2bf(hi) << 16); }
__device__ __forceinline__ float bflo(unsigned w) { return __uint_as_float(w << 16); }
__device__ __forceinline__ float bfhi(unsigned w) { return __uint_as_float(w & 0xffff0000u); }

#define XB_TMO      128
#define XB_XCNT(j)  (256  + 64 * (j))
#define XB_XSUB(j)  (1280 + 64 * (j))
#define XB_XGEN(j)  (2304 + 64 * (j))
#define XB_TOP      3328
#define XB_TOPGEN   3392
#define XCD_BAR_WORDS 3456
#define XB_SPIN_CAP (1u << 22)

__device__ __forceinline__ unsigned xb_ld(unsigned* p)              { return __hip_atomic_load(p, __ATOMIC_RELAXED, __HIP_MEMORY_SCOPE_AGENT); }
__device__ __forceinline__ unsigned xb_add(unsigned* p, unsigned v) { return __hip_atomic_fetch_add(p, v, __ATOMIC_RELAXED, __HIP_MEMORY_SCOPE_AGENT); }
__device__ __forceinline__ unsigned xb_xcc_id() { return (unsigned)__builtin_amdgcn_s_getreg((3 << 11) | 20) & 0xFu; }
#define XB_SPIN(cond, bar) do { unsigned _sp = 0; while (cond) { __builtin_amdgcn_s_sleep(1); \
    if ((++_sp & 255u) == 0u) { if (xb_ld(&(bar)[XB_TMO])) break; if (_sp > XB_SPIN_CAP) { atomicAdd(&(bar)[XB_TMO], 1u); break; } } } } while (0)

struct XcdBarrier { unsigned* bar; unsigned x; volatile LAS unsigned* st; };

__device__ __forceinline__ XcdBarrier xcd_barrier_post(unsigned* bar, volatile LAS unsigned* st) {
    XcdBarrier b; b.bar = bar; b.x = xb_xcc_id(); b.st = st;
    if (threadIdx.x == 0) (void)xb_add(&bar[XB_XCNT(b.x)], 1u);
    return b;
}
__device__ __forceinline__ void xcd_barrier_complete(unsigned* bar, unsigned x, unsigned& nloc, unsigned& nx) {
    const unsigned G = gridDim.x * gridDim.y * gridDim.z;
    unsigned sum, cnt, mine, sp = 0u;
    for (;;) {
        sum = 0u; cnt = 0u; mine = 0u;
#pragma unroll
        for (unsigned j = 0; j < 16; ++j) { const unsigned c = xb_ld(&bar[XB_XCNT(j)]); sum += c; cnt += (c > 0u) ? 1u : 0u; mine = (j == x) ? c : mine; }
        if (sum == G) break;
        __builtin_amdgcn_s_sleep(1);
        if ((++sp & 255u) == 0u) { if (xb_ld(&bar[XB_TMO])) break; if (sp > XB_SPIN_CAP) { atomicAdd(&bar[XB_TMO], 1u); break; } }
    }
    nloc = mine > 0u ? mine : 1u; nx = cnt > 0u ? cnt : 1u;
}
__device__ __forceinline__ void xcd_barrier(const XcdBarrier& b) {
    asm volatile("s_waitcnt vmcnt(0)" ::: "memory");
    __syncthreads();
    if (threadIdx.x == 0) {
        unsigned* bar = b.bar;
        __builtin_amdgcn_s_waitcnt(0);
        unsigned nloc = b.st[0], nx = b.st[1];
        if (nloc == 0u) { xcd_barrier_complete(bar, b.x, nloc, nx); b.st[0] = nloc; b.st[1] = nx; }
        const unsigned old = xb_add(&bar[XB_XSUB(b.x)], 1u);
        const unsigned gen = old / nloc;
        if (old + 1u == (gen + 1u) * nloc) {
            __builtin_amdgcn_fence(__ATOMIC_RELEASE, "agent");
            asm volatile("s_waitcnt vmcnt(0)" ::: "memory");
            const unsigned og = xb_add(&bar[XB_TOP], 1u);
            const unsigned tg = og / nx;
            if (og + 1u == (tg + 1u) * nx) xb_add(&bar[XB_TOPGEN], 1u);
            else XB_SPIN(xb_ld(&bar[XB_TOPGEN]) == tg, bar);
            __builtin_amdgcn_fence(__ATOMIC_ACQUIRE, "agent");
            xb_add(&bar[XB_XGEN(b.x)], 1u);
            asm volatile("s_waitcnt vmcnt(0)" ::: "memory");
        } else {
            XB_SPIN(xb_ld(&bar[XB_XGEN(b.x)]) == gen, bar);
            __builtin_amdgcn_fence(__ATOMIC_ACQUIRE, "agent");
            asm volatile("s_waitcnt vmcnt(0)" ::: "memory");
        }
    }
    __syncthreads();
}

struct Args { const float* in[N_IN]; float* out; unsigned char* ws; int ph_lo, ph_hi, li, pad; };
struct Frame {
    LAS unsigned char* lds;
    volatile LAS unsigned* MISC;
    gu32* ctl;
    int tid, lane, wave, vcu, G;
};
__device__ __forceinline__ float wave_sum(float v) {
#pragma unroll
    for (int o = 1; o < 64; o <<= 1) v += __shfl_xor(v, o);
    return v;
}
__device__ __forceinline__ const float* xrow_ptr(const Args& a, int m) { return m < MP ? a.in[I_XP] + (size_t)m * DM : a.in[I_XS] + (size_t)(m - MP) * DM; }

__device__ __forceinline__ void p0_transpose_item(const float* W, int N, bf16* WT, int ldk, int dcol0, int k0, int n0, int drow0, LAS float* scr, int lane) {
#pragma unroll 8
    for (int i = 0; i < 32; ++i) { const int kk = 2 * i + (lane >> 5); scr[kk * 33 + (lane & 31)] = W[(size_t)(k0 + kk) * N + n0 + (lane & 31)]; }
    LDS_WAIT(); asm volatile("" ::: "memory");
    const int c = lane & 7;
#pragma unroll
    for (int j = 0; j < 4; ++j) { const int n = (lane >> 3) + 8 * j; const LAS float* s = scr + (8 * c) * 33 + n;
        v4u o; o.x = pk2(s[0 * 33], s[1 * 33]); o.y = pk2(s[2 * 33], s[3 * 33]); o.z = pk2(s[4 * 33], s[5 * 33]); o.w = pk2(s[6 * 33], s[7 * 33]);
        *(GAS v4u*)(WT + (size_t)(drow0 + n) * ldk + dcol0 + k0 + 8 * c) = o; }
    LDS_WAIT(); asm volatile("" ::: "memory");
}

__device__ __forceinline__ void p0_prologue(Frame& F, const Args& a) {
    unsigned char* ws = a.ws;
    LAS float* scr = (LAS float*)(F.lds + RING_OFF + F.wave * 16384);
    const int gw = F.vcu * NWAVES + F.wave, NGW = F.G * NWAVES;
    constexpr int I1 = (DM / 64) * (DIN / 32), I2 = (DM / 64) * (DM / 32), I4 = (DM / 64) * (DFF2 / 32), I5 = (DFF / 64) * (DM / 32), IG = 64;
    constexpr int NITEMS = I1 + 3 * I2 + I4 + I5 + IG;
    for (int it = gw; it < NITEMS; it += NGW) {
        int r = it;
        if (r < I1) { const int nb = DIN / 32, kb = r / nb, n0 = 32 * (r % nb); p0_transpose_item(a.in[I_WIN], DIN, (bf16*)(ws + WS_W1), DM, 0, 64 * kb, n0, n0, scr, F.lane); continue; } r -= I1;
        if (r < I2) { const int nb = DM / 32, kb = r / nb, n0 = 32 * (r % nb); p0_transpose_item(a.in[I_WBRA], DM, (bf16*)(ws + WS_W2), 2048, 0, 64 * kb, n0, n0, scr, F.lane); continue; } r -= I2;
        if (r < I2) { const int nb = DM / 32, kb = r / nb, n0 = 32 * (r % nb); p0_transpose_item(a.in[I_WBRB], DM, (bf16*)(ws + WS_W2), 2048, 1024, 64 * kb, n0, n0, scr, F.lane); continue; } r -= I2;
        if (r < I2) { const int nb = DM / 32, kb = r / nb, n0 = 32 * (r % nb); p0_transpose_item(a.in[I_WOUT], DM, (bf16*)(ws + WS_W3), DM, 0, 64 * kb, n0, n0, scr, F.lane); continue; } r -= I2;
        if (r < I4) { const int nb = DFF2 / 32, kb = r / nb, n0 = 32 * (r % nb); const int s = n0 / DFF, j0 = n0 % DFF, drow0 = 256 * (j0 / 128) + 128 * s + (j0 % 128);
                      p0_transpose_item(a.in[I_WFI], DFF2, (bf16*)(ws + WS_W4), DM, 0, 64 * kb, n0, drow0, scr, F.lane); continue; } r -= I4;
        if (r < I5) { const int nb = DM / 32, kb = r / nb, n0 = 32 * (r % nb); p0_transpose_item(a.in[I_WFO], DM, (bf16*)(ws + WS_W5), DFF, 0, 64 * kb, n0, n0, scr, F.lane); continue; } r -= I5;
        { const int hd = r >> 2, which = (r >> 1) & 1, n0 = 32 * (r & 1);
          p0_transpose_item((which ? a.in[I_WX] : a.in[I_WA]) + (size_t)hd * 4096, 64, (bf16*)(ws + WS_GT) + (size_t)hd * 8192, 64, 0, 0, n0, which * 64 + n0, scr, F.lane); }
    }
    { const float* wsp = a.in[I_WS]; bf16* wsm = (bf16*)(ws + WS_WSM); bf16* wss = (bf16*)(ws + WS_WSS);
      for (int i = gw * 64 + F.lane; i < 8 * 128 * 128; i += NGW * 64) { const int g = i >> 14, p = (i >> 7) & 127, q = i & 127;
          wsm[i] = (bf16)(((q >> 6) <= (p >> 6)) ? f2bf(wsp[i]) : 0u);
          wss[i] = (bf16)(((q >> 5) == (p >> 5)) ? f2bf(wsp[(g << 14) + ((p & 31) << 7) + (q & 31)]) : 0u); } }
    { const GAS f32x4* gp = (const GAS f32x4*)a.in[I_GPRE] + F.lane; f32x4 gg[4];
#pragma unroll
      for (int j = 0; j < 4; ++j) gg[j] = gp[64 * j];
      bf16* XN = (bf16*)(ws + WS_XN);
      for (int m = gw; m < M; m += NGW) { const GAS f32x4* xr = (const GAS f32x4*)xrow_ptr(a, m) + F.lane; f32x4 v[4]; float s = 0.f;
#pragma unroll
          for (int j = 0; j < 4; ++j) { v[j] = xr[64 * j]; s += (v[j].x * v[j].x + v[j].y * v[j].y) + (v[j].z * v[j].z + v[j].w * v[j].w); }
          const float rstd = 1.0f / sqrtf(wave_sum(s) * (1.f / DM) + EPS);
          GAS v2u* o8 = (GAS v2u*)(XN + (size_t)m * DM) + F.lane;
#pragma unroll
          for (int j = 0; j < 4; ++j) { v2u o; o.x = pk2(v[j].x * rstd * gg[j].x, v[j].y * rstd * gg[j].y); o.y = pk2(v[j].z * rstd * gg[j].z, v[j].w * rstd * gg[j].w); o8[64 * j] = o; } } }
}

__device__ __forceinline__ void p2a_item(Frame& F, const Args& a, int row0, int T, int hd, const float* h0, const float* cprev, float* out_h, float* out_conv) {
    LAS unsigned char* lds = F.lds;
    LAS float* XC = (LAS float*)(lds);
    LAS float* AS = (LAS float*)(lds + 32768);
    LAS float* US = (LAS float*)(lds + 65536);
    LAS bf16* XCB = (LAS bf16*)(lds + 98304);
    LAS float* SEGA = (LAS float*)(lds + 116736);
    LAS float* SEGB = (LAS float*)(lds + 118784);
    LAS float* CAR = (LAS float*)(lds + 120832);
    bf16* Z = (bf16*)(a.ws + WS_Z);
    const int tid = F.tid, lane = F.lane, wave = F.wave;
    const int tr = tid >> 3, cg = tid & 7, ch0 = hd * 64 + cg * 8;
    const int sc = tid & 63, seg = tid >> 6;
    const int tb = wave >> 1, cb = wave & 1, jl = cb * 32 + (lane & 31), hi = lane >> 5;
    __syncthreads();
    float cw[4][8], cbv[8];
#pragma unroll
    for (int k = 0; k < 4; ++k) { const f32x4 w0 = *(const GAS f32x4*)(a.in[I_CW] + k * DM + ch0), w1 = *(const GAS f32x4*)(a.in[I_CW] + k * DM + ch0 + 4);
        cw[k][0] = w0.x; cw[k][1] = w0.y; cw[k][2] = w0.z; cw[k][3] = w0.w; cw[k][4] = w1.x; cw[k][5] = w1.y; cw[k][6] = w1.z; cw[k][7] = w1.w; }
    { const f32x4 w0 = *(const GAS f32x4*)(a.in[I_CB] + ch0), w1 = *(const GAS f32x4*)(a.in[I_CB] + ch0 + 4);
      cbv[0] = w0.x; cbv[1] = w0.y; cbv[2] = w0.z; cbv[3] = w0.w; cbv[4] = w1.x; cbv[5] = w1.y; cbv[6] = w1.z; cbv[7] = w1.w; }
    bf16x8 Br[4], Bi[4];
    { const bf16* gt = (const bf16*)(a.ws + WS_GT) + (size_t)hd * 8192;
#pragma unroll
      for (int ks = 0; ks < 4; ++ks) { Br[ks] = *(const GAS bf16x8*)(gt + jl * 64 + ks * 16 + hi * 8); Bi[ks] = *(const GAS bf16x8*)(gt + (64 + jl) * 64 + ks * 16 + hi * 8); } }
    const float ba = a.in[I_BA][hd * 64 + jl], bx = a.in[I_BX][hd * 64 + jl];
    const float cA = -8.0f * log1pf(expf(-a.in[I_LAM][hd * 64 + jl])) * 1.4426950408889634f;
    if (tid < 64) CAR[tid] = h0 ? h0[hd * 64 + tid] : 0.f;
    const int ntiles = (T + 127) >> 7;
    for (int tile = 0; tile < ntiles; ++tile) {
        const int t0 = tile << 7, nrows = (T - t0) < 128 ? (T - t0) : 128, par = tile & 1;
        {
            float f[5][8];
#pragma unroll
            for (int r = 0; r < 5; ++r) { const int tt = t0 + 2 * tr - 3 + r;
                if (tt < 0) {
                    if (cprev) { const f32x4 p0 = *(const GAS f32x4*)(cprev + (tt + 3) * DM + ch0), p1 = *(const GAS f32x4*)(cprev + (tt + 3) * DM + ch0 + 4);
                        f[r][0] = p0.x; f[r][1] = p0.y; f[r][2] = p0.z; f[r][3] = p0.w; f[r][4] = p1.x; f[r][5] = p1.y; f[r][6] = p1.z; f[r][7] = p1.w; }
                    else {
#pragma unroll
                        for (int e = 0; e < 8; ++e) f[r][e] = 0.f; }
                } else if (tt < T) { const v4u w = *(const GAS v4u*)(Z + (size_t)(row0 + tt) * DIN + ch0);
                    f[r][0] = bflo(w.x); f[r][1] = bfhi(w.x); f[r][2] = bflo(w.y); f[r][3] = bfhi(w.y); f[r][4] = bflo(w.z); f[r][5] = bfhi(w.z); f[r][6] = bflo(w.w); f[r][7] = bfhi(w.w);
                } else {
#pragma unroll
                    for (int e = 0; e < 8; ++e) f[r][e] = 0.f; }
            }
#pragma unroll
            for (int rr = 0; rr < 2; ++rr) { const int tl = 2 * tr + rr, t = t0 + tl; float xc[8];
#pragma unroll
                for (int e = 0; e < 8; ++e) xc[e] = cbv[e] + cw[0][e] * f[rr][e] + cw[1][e] * f[rr + 1][e] + cw[2][e] * f[rr + 2][e] + cw[3][e] * f[rr + 3][e];
                *(LAS f32x4*)(XC + tl * 64 + cg * 8) = (f32x4){xc[0], xc[1], xc[2], xc[3]}; *(LAS f32x4*)(XC + tl * 64 + cg * 8 + 4) = (f32x4){xc[4], xc[5], xc[6], xc[7]};
                v4u pw; pw.x = pk2(xc[0], xc[1]); pw.y = pk2(xc[2], xc[3]); pw.z = pk2(xc[4], xc[5]); pw.w = pk2(xc[6], xc[7]);
                *(LAS v4u*)(XCB + tl * 72 + cg * 8) = pw;
                if (t >= T - 3 && t < T) { float* oc = out_conv + (size_t)(t - (T - 3)) * DM + ch0;
                    *(GAS f32x4*)oc = (f32x4){f[rr + 3][0], f[rr + 3][1], f[rr + 3][2], f[rr + 3][3]}; *(GAS f32x4*)(oc + 4) = (f32x4){f[rr + 3][4], f[rr + 3][5], f[rr + 3][6], f[rr + 3][7]}; }
            }
        }
        __syncthreads();
        if (tb * 32 < nrows) {
            f32x16 accr, acci;
#pragma unroll
            for (int i = 0; i < 16; ++i) { accr[i] = 0.f; acci[i] = 0.f; }
#pragma unroll
            for (int ks = 0; ks < 4; ++ks) { const bf16x8 A = *(const LAS bf16x8*)(XCB + (tb * 32 + (lane & 31)) * 72 + ks * 16 + hi * 8);
                accr = __builtin_amdgcn_mfma_f32_32x32x16_bf16(A, Br[ks], accr, 0, 0, 0);
                acci = __builtin_amdgcn_mfma_f32_32x32x16_bf16(A, Bi[ks], acci, 0, 0, 0); }
#pragma unroll
            for (int rg = 0; rg < 16; ++rg) { const int tl = tb * 32 + (rg & 3) + 8 * (rg >> 2) + 4 * hi;
                const float xcv = XC[tl * 64 + jl];
                const float r = pg8::sigmoid_f(accr[rg] + ba), ig = pg8::sigmoid_f(acci[rg] + bx);
                const float l2a = cA * r;
                const float av = __builtin_amdgcn_exp2f(l2a);
                const float y = l2a * 1.3862943611198906f;
                const float ser = -y * (1.0f + y * (0.5f + y * (0.16666667f + y * (0.041666668f + y * (0.0083333338f + y * 0.0013888889f)))));
                const float om = (y > -0.25f) ? ser : (1.0f - av * av);
                const float uv = sqrtf(om) * (ig * xcv);
                AS[tl * 64 + jl] = av; US[tl * 64 + jl] = uv; }
        }
        __syncthreads();
        if (seg * 16 < nrows) { float Ap = 1.f, Bp = 0.f;
#pragma unroll
            for (int s = 0; s < 16; ++s) { const float av = AS[(seg * 16 + s) * 64 + sc], uv = US[(seg * 16 + s) * 64 + sc]; Bp = av * Bp + uv; Ap *= av; }
            SEGA[seg * 64 + sc] = Ap; SEGB[seg * 64 + sc] = Bp; }
        __syncthreads();
        if (seg * 16 < nrows) { float h = CAR[par * 64 + sc];
            for (int sg = 0; sg < seg; ++sg) h = SEGA[sg * 64 + sc] * h + SEGB[sg * 64 + sc];
#pragma unroll
            for (int s = 0; s < 16; ++s) { const int tl = seg * 16 + s; h = AS[tl * 64 + sc] * h + US[tl * 64 + sc]; US[tl * 64 + sc] = h;
                if (t0 + tl == T - 1) out_h[hd * 64 + sc] = h; }
            if (seg == 7) CAR[(par ^ 1) * 64 + sc] = h; }
        __syncthreads();
#pragma unroll
        for (int rr = 0; rr < 2; ++rr) { const int tl = 2 * tr + rr;
            if (tl < nrows) { bf16* zp = Z + (size_t)(row0 + t0 + tl) * DIN + 1024 + ch0; const v4u w = *(const GAS v4u*)zp;
                const f32x4 h0v = *(const LAS f32x4*)(US + tl * 64 + cg * 8), h1v = *(const LAS f32x4*)(US + tl * 64 + cg * 8 + 4);
                v4u o; o.x = pk2(h0v.x * bflo(w.x), h0v.y * bfhi(w.x)); o.y = pk2(h0v.z * bflo(w.y), h0v.w * bfhi(w.y));
                o.z = pk2(h1v.x * bflo(w.z), h1v.y * bfhi(w.z)); o.w = pk2(h1v.z * bflo(w.w), h1v.w * bfhi(w.w));
                *(GAS v4u*)zp = o; } }
    }
}

__device__ __forceinline__ int vt_off(int d, int q) { return d * 256 + ((((q >> 3) ^ (d & 15) ^ ((d >> 4) & 7)) & 15) << 4) + (q & 7) * 2; }
__device__ __forceinline__ void p2b_item(Frame& F, const Args& a, int item) {
    LAS unsigned char* lds = F.lds;
    LAS unsigned char* VT = lds;
    LAS float* ST = (LAS float*)(lds + 32768);
    bf16* Z = (bf16*)(a.ws + WS_Z);
    const int tid = F.tid, lane = F.lane, wave = F.wave;
    const bool sample = item >= MP / 128;
    const int row0 = item * 128;
    const bf16* Wm = (const bf16*)(a.ws + (sample ? WS_WSS : WS_WSM));
    __syncthreads();
    for (int rr = 0; rr < 16; ++rr) { const int q = wave * 16 + rr; const bf16* zp = Z + (size_t)(row0 + q) * DIN + 3072;
        const v4u w0 = *(const GAS v4u*)(zp + lane * 8), w1 = *(const GAS v4u*)(zp + 512 + lane * 8);
        float v[16]; v[0] = bflo(w0.x); v[1] = bfhi(w0.x); v[2] = bflo(w0.y); v[3] = bfhi(w0.y); v[4] = bflo(w0.z); v[5] = bfhi(w0.z); v[6] = bflo(w0.w); v[7] = bfhi(w0.w);
        v[8] = bflo(w1.x); v[9] = bfhi(w1.x); v[10] = bflo(w1.y); v[11] = bfhi(w1.y); v[12] = bflo(w1.z); v[13] = bfhi(w1.z); v[14] = bflo(w1.w); v[15] = bfhi(w1.w);
        float s = 0.f;
#pragma unroll
        for (int e = 0; e < 16; ++e) s += v[e];
        const float mean = wave_sum(s) * (1.f / 1024.f); float s2 = 0.f;
#pragma unroll
        for (int e = 0; e < 16; ++e) { const float d = v[e] - mean; s2 += d * d; }
        const float rstd = 1.0f / sqrtf(wave_sum(s2) * (1.f / 1024.f) + EPS);
        if (lane == 0) { ST[q * 2] = mean; ST[q * 2 + 1] = rstd; } }
    __syncthreads();
    const int cchunk = tid & 15, qg = tid >> 4;
    const int db = wave & 3, pb0 = (wave >> 2) * 2, hi = lane >> 5;
    for (int g = 0; g < 8; ++g) {
        { const int d0 = cchunk * 8, col = g * 128 + d0;
          const f32x4 g0 = *(const GAS f32x4*)(a.in[I_LNG] + col), g1 = *(const GAS f32x4*)(a.in[I_LNG] + col + 4), b0 = *(const GAS f32x4*)(a.in[I_LNB] + col), b1 = *(const GAS f32x4*)(a.in[I_LNB] + col + 4);
          const float lg[8] = {g0.x, g0.y, g0.z, g0.w, g1.x, g1.y, g1.z, g1.w}, lb[8] = {b0.x, b0.y, b0.z, b0.w, b1.x, b1.y, b1.z, b1.w};
          float vn[4][8];
#pragma unroll
          for (int r = 0; r < 4; ++r) { const int q = qg * 4 + r; const v4u w = *(const GAS v4u*)(Z + (size_t)(row0 + q) * DIN + 3072 + col);
              const float mean = ST[q * 2], rstd = ST[q * 2 + 1];
              const float x[8] = {bflo(w.x), bfhi(w.x), bflo(w.y), bfhi(w.y), bflo(w.z), bfhi(w.z), bflo(w.w), bfhi(w.w)};
#pragma unroll
              for (int e = 0; e < 8; ++e) vn[r][e] = (x[e] - mean) * rstd * lg[e] + lb[e];
              if (sample) { float* ov = a.out + O_VS + (size_t)(row0 - MP + q) * DM + col;
                  *(GAS f32x4*)ov = (f32x4){vn[r][0], vn[r][1], vn[r][2], vn[r][3]}; *(GAS f32x4*)(ov + 4) = (f32x4){vn[r][4], vn[r][5], vn[r][6], vn[r][7]}; } }
#pragma unroll
          for (int e = 0; e < 8; ++e) { v2u o; o.x = pk2(vn[0][e], vn[1][e]); o.y = pk2(vn[2][e], vn[3][e]); *(LAS v2u*)(VT + vt_off(d0 + e, qg * 4)) = o; } }
        __syncthreads();
        { f32x16 acc[2];
#pragma unroll
          for (int i = 0; i < 16; ++i) { acc[0][i] = 0.f; acc[1][i] = 0.f; }
          const bf16* wg = Wm + (size_t)g * 16384;
          const int kmax = (!sample && pb0 == 0) ? 4 : 8;
          const int d = db * 32 + (lane & 31);
          for (int ks = 0; ks < kmax; ++ks) { const bf16x8 A = *(const LAS bf16x8*)(VT + vt_off(d, ks * 16 + hi * 8));
#pragma unroll
              for (int pi = 0; pi < 2; ++pi) { const bf16x8 B = *(const GAS bf16x8*)(wg + ((pb0 + pi) * 32 + (lane & 31)) * 128 + ks * 16 + hi * 8);
                  acc[pi] = __builtin_amdgcn_mfma_f32_32x32x16_bf16(A, B, acc[pi], 0, 0, 0); } }
#pragma unroll
          for (int pi = 0; pi < 2; ++pi) { const int p = (pb0 + pi) * 32 + (lane & 31); const float bs = a.in[I_BS][g * 128 + (sample ? (p & 31) : p)];
              bf16* zrow = Z + (size_t)(row0 + p) * DIN + 2048 + g * 128 + db * 32 + 4 * hi;
#pragma unroll
              for (int rq = 0; rq < 4; ++rq) { bf16* zp = zrow + 8 * rq; const v2u w = *(const GAS v2u*)zp;
                  v2u o; o.x = pk2((acc[pi][rq * 4 + 0] + bs) * bflo(w.x), (acc[pi][rq * 4 + 1] + bs) * bfhi(w.x)); o.y = pk2((acc[pi][rq * 4 + 2] + bs) * bflo(w.y), (acc[pi][rq * 4 + 3] + bs) * bfhi(w.y));
                  *(GAS v2u*)zp = o; } } }
        __syncthreads();
    }
}

__device__ __forceinline__ void p5_rows(Frame& F, const Args& a) {
    const int gw = F.vcu * NWAVES + F.wave, NGW = F.G * NWAVES, lane = F.lane;
    const bf16* MIX = (const bf16*)(a.ws + WS_MIX); bf16* HN = (bf16*)(a.ws + WS_XN);
    f32x4 g1[4], g2[4];
#pragma unroll
    for (int j = 0; j < 4; ++j) { g1[j] = ((const GAS f32x4*)a.in[I_GPOST])[lane + 64 * j]; g2[j] = ((const GAS f32x4*)a.in[I_GFFN])[lane + 64 * j]; }
    for (int m = gw; m < M; m += NGW) { const GAS f32x4* xr = (const GAS f32x4*)xrow_ptr(a, m) + lane; const GAS v2u* mr = (const GAS v2u*)(MIX + (size_t)m * DM) + lane;
        f32x4 x[4], mx[4]; float s = 0.f;
#pragma unroll
        for (int j = 0; j < 4; ++j) { x[j] = xr[64 * j]; const v2u w = mr[64 * j]; mx[j] = (f32x4){bflo(w.x), bfhi(w.x), bflo(w.y), bfhi(w.y)};
            s += (mx[j].x * mx[j].x + mx[j].y * mx[j].y) + (mx[j].z * mx[j].z + mx[j].w * mx[j].w); }
        const float r1 = 1.0f / sqrtf(wave_sum(s) * (1.f / DM) + EPS); float s2 = 0.f;
#pragma unroll
        for (int j = 0; j < 4; ++j) { x[j] = x[j] + mx[j] * r1 * g1[j]; s2 += (x[j].x * x[j].x + x[j].y * x[j].y) + (x[j].z * x[j].z + x[j].w * x[j].w); }
        const float r2 = 1.0f / sqrtf(wave_sum(s2) * (1.f / DM) + EPS);
        GAS v2u* o8 = (GAS v2u*)(HN + (size_t)m * DM) + lane;
#pragma unroll
        for (int j = 0; j < 4; ++j) { const f32x4 h = x[j] * r2 * g2[j]; v2u o; o.x = pk2(h.x, h.y); o.y = pk2(h.z, h.w); o8[64 * j] = o; } }
}
__device__ __forceinline__ void p8_rows(Frame& F, const Args& a) {
    const int gw = F.vcu * NWAVES + F.wave, NGW = F.G * NWAVES, lane = F.lane;
    const bf16* MIX = (const bf16*)(a.ws + WS_MIX); const bf16* FF = (const bf16*)(a.ws + WS_F);
    f32x4 g1[4], g3[4];
#pragma unroll
    for (int j = 0; j < 4; ++j) { g1[j] = ((const GAS f32x4*)a.in[I_GPOST])[lane + 64 * j]; g3[j] = ((const GAS f32x4*)a.in[I_GPF])[lane + 64 * j]; }
    for (int m = gw; m < M; m += NGW) { const GAS f32x4* xr = (const GAS f32x4*)xrow_ptr(a, m) + lane; const GAS v2u* mr = (const GAS v2u*)(MIX + (size_t)m * DM) + lane; const GAS v2u* fr = (const GAS v2u*)(FF + (size_t)m * DM) + lane;
        f32x4 x[4], mx[4], fx[4]; float s = 0.f, sf = 0.f;
#pragma unroll
        for (int j = 0; j < 4; ++j) { x[j] = xr[64 * j]; const v2u w = mr[64 * j]; mx[j] = (f32x4){bflo(w.x), bfhi(w.x), bflo(w.y), bfhi(w.y)}; const v2u wf = fr[64 * j]; fx[j] = (f32x4){bflo(wf.x), bfhi(wf.x), bflo(wf.y), bfhi(wf.y)};
            s += (mx[j].x * mx[j].x + mx[j].y * mx[j].y) + (mx[j].z * mx[j].z + mx[j].w * mx[j].w); sf += (fx[j].x * fx[j].x + fx[j].y * fx[j].y) + (fx[j].z * fx[j].z + fx[j].w * fx[j].w); }
        const float r1 = 1.0f / sqrtf(wave_sum(s) * (1.f / DM) + EPS), r3 = 1.0f / sqrtf(wave_sum(sf) * (1.f / DM) + EPS);
        GAS f32x4* o = (GAS f32x4*)(a.out + O_Y + (size_t)m * DM) + lane;
#pragma unroll
        for (int j = 0; j < 4; ++j) o[64 * j] = x[j] + mx[j] * r1 * g1[j] + fx[j] * r3 * g3[j]; }
}

template <int MODE, int NSTEPS>
__device__ __forceinline__ void small_gemm(Frame& F, const bf16* A, int lda, const bf16* Bt, int ldb, int K, int ntn, bf16* O, int ldo, const bf16* Zg) {
    LAS float* RED = (LAS float*)F.lds;
    const int tid = F.tid, lane = F.lane, wave = F.wave, hi = lane >> 5, l31 = lane & 31;
    const int KS = NSTEPS * 16; (void)K;
    const int ntasks = 8 * ntn;
    for (int task = blockIdx.x; task < ntasks; task += F.G) {
        const int mt = task & 7, nt = task >> 3;
        const int r0 = MP + mt * 64;
        int br0, br1;
        if (MODE == 3) { const int j0 = nt * 32; br0 = 256 * (j0 >> 7) + (j0 & 127); br1 = br0 + 128; } else { br0 = nt * 64; br1 = br0 + 32; }
        const bf16* pa0 = A + (size_t)(r0 + l31) * lda + wave * KS + hi * 8; const bf16* pa1 = pa0 + (size_t)32 * lda;
        const bf16* pb0 = Bt + (size_t)(br0 + l31) * ldb + wave * KS + hi * 8; const bf16* pb1 = Bt + (size_t)(br1 + l31) * ldb + wave * KS + hi * 8;
        f32x16 acc[2][2];
#pragma unroll
        for (int i = 0; i < 16; ++i) { acc[0][0][i] = 0.f; acc[0][1][i] = 0.f; acc[1][0][i] = 0.f; acc[1][1][i] = 0.f; }
#define SG_BATCH(NS, KO) do { bf16x8 a0[NS], a1[NS], b0[NS], b1[NS]; \
            _Pragma("unroll") for (int s = 0; s < (NS); ++s) { const int ko = (KO) + s * 16; \
                a0[s] = *(const GAS bf16x8*)(pa0 + ko); a1[s] = *(const GAS bf16x8*)(pa1 + ko); b0[s] = *(const GAS bf16x8*)(pb0 + ko); b1[s] = *(const GAS bf16x8*)(pb1 + ko); } \
            _Pragma("unroll") for (int s = 0; s < (NS); ++s) { \
                acc[0][0] = __builtin_amdgcn_mfma_f32_32x32x16_bf16(a0[s], b0[s], acc[0][0], 0, 0, 0); acc[0][1] = __builtin_amdgcn_mfma_f32_32x32x16_bf16(a0[s], b1[s], acc[0][1], 0, 0, 0); \
                acc[1][0] = __builtin_amdgcn_mfma_f32_32x32x16_bf16(a1[s], b0[s], acc[1][0], 0, 0, 0); acc[1][1] = __builtin_amdgcn_mfma_f32_32x32x16_bf16(a1[s], b1[s], acc[1][1], 0, 0, 0); } } while (0)
        if (NSTEPS == 8) { SG_BATCH(8, 0); }
        else if (NSTEPS == 16) { SG_BATCH(8, 0); SG_BATCH(8, 128); }
        else { SG_BATCH(8, 0); SG_BATCH(8, 128); SG_BATCH(6, 256); }
#undef SG_BATCH
        __syncthreads();
#pragma unroll
        for (int i = 0; i < 2; ++i)
#pragma unroll
            for (int j = 0; j < 2; ++j)
#pragma unroll
                for (int rg = 0; rg < 16; ++rg) RED[wave * 4096 + (i * 32 + (rg & 3) + 8 * (rg >> 2) + 4 * hi) * 64 + j * 32 + l31] = acc[i][j][rg];
        __syncthreads();
        if (MODE == 3) { const int row = tid >> 3, q = tid & 7; f32x4 g = (f32x4){0.f, 0.f, 0.f, 0.f}, u = g;
#pragma unroll
            for (int w = 0; w < 8; ++w) { g += *(const LAS f32x4*)(RED + w * 4096 + row * 64 + q * 4); u += *(const LAS f32x4*)(RED + w * 4096 + row * 64 + 32 + q * 4); }
            v2u o; o.x = pk2(pg8::silu_f(g.x) * u.x, pg8::silu_f(g.y) * u.y); o.y = pk2(pg8::silu_f(g.z) * u.z, pg8::silu_f(g.w) * u.w);
            *(GAS v2u*)(O + (size_t)(r0 + row) * ldo + nt * 32 + q * 4) = o;
        } else { const int row = tid >> 3, c8 = (tid & 7) * 8, col = nt * 64 + c8; float v[8];
            if (MODE == 1) { f32x4 a0 = (f32x4){0.f, 0.f, 0.f, 0.f}, a1 = a0, b0 = a0, b1 = a0;
#pragma unroll
                for (int w = 0; w < 4; ++w) { a0 += *(const LAS f32x4*)(RED + w * 4096 + row * 64 + c8); a1 += *(const LAS f32x4*)(RED + w * 4096 + row * 64 + c8 + 4);
                    b0 += *(const LAS f32x4*)(RED + (w + 4) * 4096 + row * 64 + c8); b1 += *(const LAS f32x4*)(RED + (w + 4) * 4096 + row * 64 + c8 + 4); }
                const v4u ga = *(const GAS v4u*)(Zg + (size_t)(r0 + row) * DIN + col), gb = *(const GAS v4u*)(Zg + (size_t)(r0 + row) * DIN + 1024 + col);
                v[0] = bflo(ga.x) * a0.x + bflo(gb.x) * b0.x; v[1] = bfhi(ga.x) * a0.y + bfhi(gb.x) * b0.y; v[2] = bflo(ga.y) * a0.z + bflo(gb.y) * b0.z; v[3] = bfhi(ga.y) * a0.w + bfhi(gb.y) * b0.w;
                v[4] = bflo(ga.z) * a1.x + bflo(gb.z) * b1.x; v[5] = bfhi(ga.z) * a1.y + bfhi(gb.z) * b1.y; v[6] = bflo(ga.w) * a1.z + bflo(gb.w) * b1.z; v[7] = bfhi(ga.w) * a1.w + bfhi(gb.w) * b1.w;
            } else { f32x4 s0 = (f32x4){0.f, 0.f, 0.f, 0.f}, s1 = s0;
#pragma unroll
                for (int w = 0; w < 8; ++w) { s0 += *(const LAS f32x4*)(RED + w * 4096 + row * 64 + c8); s1 += *(const LAS f32x4*)(RED + w * 4096 + row * 64 + c8 + 4); }
                v[0] = s0.x; v[1] = s0.y; v[2] = s0.z; v[3] = s0.w; v[4] = s1.x; v[5] = s1.y; v[6] = s1.z; v[7] = s1.w;
                if (MODE == 0) { const int pn = col >> 8;
                    if (pn >= 4 && pn < 16) {
#pragma unroll
                        for (int e = 0; e < 8; ++e) v[e] = pg8::gelu_tanh_f(v[e]); }
                    else if (pn >= 16) {
#pragma unroll
                        for (int e = 0; e < 8; ++e) v[e] = pg8::sigmoid_f(v[e]); } } }
            v4u o; o.x = pk2(v[0], v[1]); o.y = pk2(v[2], v[3]); o.z = pk2(v[4], v[5]); o.w = pk2(v[6], v[7]);
            *(GAS v4u*)(O + (size_t)(r0 + row) * ldo + col) = o; }
    }
    __syncthreads();
}

__global__ void __launch_bounds__(NWAVES * 64, 2) hawk_fwd(Args args) {
    extern __shared__ __attribute__((aligned(16))) unsigned char lds[];
    Frame F;
    F.lds = (LAS unsigned char*)lds;
    F.MISC = (volatile LAS unsigned*)(F.lds + MISC_OFF);
    F.tid = threadIdx.x; F.lane = F.tid & 63; F.wave = __builtin_amdgcn_readfirstlane(F.tid >> 6);
    F.G = gridDim.x; { const int bx = blockIdx.x; F.vcu = (F.G % 8 == 0) ? (bx % 8) * (F.G / 8) + bx / 8 : bx; }
    unsigned char* ws = args.ws;
    F.ctl = (gu32*)(ws + WS_CTL);
    for (int u = F.tid; u < (LDS_BYTES - LDSCTL_OFF) / 4; u += NWAVES * 64) ((LAS unsigned*)(F.lds + LDSCTL_OFF))[u] = 0u;
    __syncthreads();
    XcdBarrier bar; bar.bar = (unsigned*)(F.ctl + CW_BAR); bar.x = 0; bar.st = nullptr;
    if (N_LAUNCHES != PER_PHASE) bar = xcd_barrier_post((unsigned*)(F.ctl + CW_BAR), F.MISC + 8);
#define GRID_BAR() do { if (N_LAUNCHES != PER_PHASE) xcd_barrier(bar); } while (0)
    const int lo = args.ph_lo, hi = args.ph_hi;
#define IN(k) (lo <= (k) && (k) < hi)
#define BOTH(k) (IN(k) && IN((k) + 1))
    bf16* XN = (bf16*)(ws + WS_XN); bf16* Z = (bf16*)(ws + WS_Z);

#define PH0() do { p0_prologue(F, args); } while (0)
#define PH1() do { pg8::Gemm g{XN, (const bf16*)(ws + WS_W1), DM, DM, DM}; pg8::StaticOrder S; S.init(M, DIN, F.G, (int)blockIdx.x); pg8::EpiZ E{Z, DIN}; \
        pg8::gemm_phase<pg8::EpiZ, pg8::StaticOrder, PG8_ALIGN, PG8_SP2>(F.lds + RING_OFF, g, S, E); } while (0)
#define PH3() do { pg8::Gemm g{Z + 1024, (const bf16*)(ws + WS_W2), DIN, 2048, 2048}; pg8::StaticOrder S; S.init(MP, DM, F.G, (int)blockIdx.x); pg8::EpiGate E{Z + 4096, DIN, XN, DM}; \
        pg8::gemm_phase<pg8::EpiGate, pg8::StaticOrder, PG8_ALIGN, PG8_SP2>(F.lds + RING_OFF, g, S, E); \
        small_gemm<1, 16>(F, Z + 1024, DIN, (const bf16*)(ws + WS_W2), 2048, 2048, DM / 64, XN, DM, Z + 4096); } while (0)
#define PH4() do { pg8::Gemm g{XN, (const bf16*)(ws + WS_W3), DM, DM, DM}; pg8::StaticOrder S; S.init(MP, DM, F.G, (int)blockIdx.x); pg8::EpiBf16 E{(bf16*)(ws + WS_MIX), DM}; \
        pg8::gemm_phase<pg8::EpiBf16, pg8::StaticOrder, PG8_ALIGN, PG8_SP2>(F.lds + RING_OFF, g, S, E); \
        small_gemm<2, 8>(F, XN, DM, (const bf16*)(ws + WS_W3), DM, DM, DM / 64, (bf16*)(ws + WS_MIX), DM, nullptr); } while (0)
#define PH5() do { p5_rows(F, args); } while (0)
#define PH6() do { pg8::Gemm g{XN, (const bf16*)(ws + WS_W4), DM, DM, DM}; pg8::StaticOrder S; S.init(M, DFF2, F.G, (int)blockIdx.x); pg8::EpiSwiGLU E{(bf16*)(ws + WS_FIN), DFF}; \
        pg8::gemm_phase<pg8::EpiSwiGLU, pg8::StaticOrder, PG8_ALIGN, PG8_SP2>(F.lds + RING_OFF, g, S, E); } while (0)
#define PH7() do { pg8::Gemm g{(const bf16*)(ws + WS_FIN), (const bf16*)(ws + WS_W5), DFF, DFF, DFF}; pg8::StaticOrder S; S.init(MP, DM, F.G, (int)blockIdx.x); pg8::EpiBf16 E{(bf16*)(ws + WS_F), DM}; \
        pg8::gemm_phase<pg8::EpiBf16, pg8::StaticOrder, PG8_ALIGN, PG8_SP2>(F.lds + RING_OFF, g, S, E); \
        small_gemm<2, 22>(F, (const bf16*)(ws + WS_FIN), DFF, (const bf16*)(ws + WS_W5), DFF, DFF, DM / 64, (bf16*)(ws + WS_F), DM, nullptr); } while (0)
#define PH8() do { p8_rows(F, args); } while (0)
#define RUN(k, PH) do { if (IN(k)) { PH(); if (PROBE_DOUBLE == (k)) { GRID_BAR(); PH(); } if (BOTH(k)) GRID_BAR(); } } while (0)
    RUN(0, PH0);
    RUN(1, PH1);
    if (IN(2)) {
        for (int it = blockIdx.x; it < 2 * NB * 16; it += F.G) {
            if (it < NB * 16) { const int b = it >> 4, hd = it & 15;
                p2a_item(F, args, b * SEQ, SEQ, hd, nullptr, nullptr, args.out + O_HP + (size_t)b * DM, args.out + O_CP + (size_t)b * 3 * DM); }
            else { const int b = (it - NB * 16) >> 4, hd = it & 15;
                p2a_item(F, args, MP + b * DEC_T, DEC_T, hd, args.in[I_SH] + (size_t)b * DM, args.in[I_SC] + (size_t)b * 3 * DM, args.out + O_HS + (size_t)b * DM, args.out + O_CS + (size_t)b * 3 * DM); }
        }
        for (int it = blockIdx.x; it < M / 128; it += F.G) p2b_item(F, args, it);
        if (BOTH(2)) GRID_BAR();
    }
    RUN(3, PH3);
    RUN(4, PH4);
    RUN(5, PH5);
    RUN(6, PH6);
    RUN(7, PH7);
    RUN(8, PH8);
#undef IN
#undef BOTH
#undef GRID_BAR
}

extern "C" void kernel_launch(void* const* d_in, const int* in_sizes, int n_in, void* d_out, int out_size, void* d_ws, size_t ws_size, hipStream_t stream) {
    static int grid = 0;
    if (grid == 0) {
        if (n_in != N_IN || in_sizes[0] != MP * DM || (size_t)out_size != O_END || ws_size < WS_END) {
            fprintf(stderr, "kernel_launch: shape mismatch (n_in %d, in0 %d, out %d, ws %zu; need ws >= %zu); nothing launched\n", n_in, n_in > 0 ? in_sizes[0] : -1, out_size, ws_size, (size_t)WS_END); grid = -1; return; }
        int dev = 0, cus = 0, per_cu = 0;
        if (hipGetDevice(&dev) != hipSuccess || hipDeviceGetAttribute(&cus, hipDeviceAttributeMultiprocessorCount, dev) != hipSuccess) { fprintf(stderr, "kernel_launch: device query failed\n"); grid = -1; return; }
        if (hipFuncSetAttribute((const void*)hawk_fwd, hipFuncAttributeMaxDynamicSharedMemorySize, LDS_BYTES) != hipSuccess) { fprintf(stderr, "kernel_launch: hipFuncSetAttribute failed\n"); grid = -1; return; }
        if (hipOccupancyMaxActiveBlocksPerMultiprocessor(&per_cu, (const void*)hawk_fwd, NWAVES * 64, LDS_BYTES) != hipSuccess || per_cu < 1) {
            fprintf(stderr, "kernel_launch: occupancy query reports %d workgroups per CU; nothing launched\n", per_cu); (void)hipGetLastError(); grid = -1; return; }
        grid = cus;
    }
    if (grid < 0) return;
    if (hipMemsetAsync((char*)d_ws + WS_CTL, 0, CTL_ZERO_BYTES, stream) != hipSuccess) { fprintf(stderr, "kernel_launch: memset failed\n"); return; }
    Args a{};
    for (int i = 0; i < N_IN; ++i) a.in[i] = (const float*)d_in[i];
    a.out = (float*)d_out; a.ws = (unsigned char*)d_ws;
    for (int li = 0; li < N_LAUNCHES; ++li) {
        a.ph_lo = (N_LAUNCHES == PER_PHASE) ? li : 0; a.ph_hi = (N_LAUNCHES == PER_PHASE) ? li + 1 : PER_PHASE; a.li = li;
        hipLaunchKernelGGL(hawk_fwd, dim3(grid), dim3(NWAVES * 64), LDS_BYTES, stream, a);
        const hipError_t le = hipPeekAtLastError();
        if (le != hipSuccess) { fprintf(stderr, "kernel_launch: launch %d failed: %s\n", li, hipGetErrorName(le)); break; }
    }
}
```

```cpp
#include <hip/hip_runtime.h>
#include <cstdio>
#include <cstdint>

#ifndef MK_N_LAUNCHES
#define MK_N_LAUNCHES 1
#endif
#ifndef PROBE_TA
#define PROBE_TA -1
#define PROBE_TB -1
#endif
#define PROBE_MULT 4
#ifndef PROBE_DOUBLE
#define PROBE_DOUBLE -1
#endif

namespace pg8 {
#define PG8_LAS __attribute__((address_space(3)))
typedef unsigned short bf16_t;
typedef short bf16x8 __attribute__((ext_vector_type(8)));
typedef float f32x4 __attribute__((ext_vector_type(4)));
typedef unsigned u32x4 __attribute__((ext_vector_type(4)));
constexpr int BM = 256, BK = 64, HALF = 128, HTB = HALF * BK * 2  , STAGE_BYTES = 8 * HTB, NXCD = 8, WGM = 8;

__host__ __device__ __forceinline__ int lds_byte(int r, int c) { const int st = (r >> 4) * 2 + (c >> 5), rr = r & 15, cc = c & 31, ob = rr * 64 + cc * 2; return st * 1024 + (ob ^ (((ob >> 9) & 1) << 5)); }
__host__ __device__ __forceinline__ void stage_rc(int b, int& R, int& C) { const int st = b / 1024, sb = b % 1024, swz = sb ^ (((sb >> 9) & 1) << 5); R = (st >> 1) * 16 + swz / 64; C = (st & 1) * 32 + (swz % 64) / 2; }
__host__ __device__ __forceinline__ int perm32(int rho) { const int n = rho >> 4, i = rho & 15; return 8 * (i >> 2) + 4 * n + (i & 3); }

struct Unit { int pm, pn; };
struct Gemm { const bf16_t* A; const bf16_t* Bt; int lda, ldb, K; };

struct StaticOrder {
    int nM, nN, nwg, G, c;
    __host__ __device__ void init(int M, int N, int G_, int c_) { nM = M / BM; nN = N / BM; nwg = nM * nN; G = G_; c = c_; }
    __host__ __device__ bool next(int i, Unit& u) const {
        const long L = (long)i * G + c; if (L >= nwg) return false;
        int wgid = (int)L; { const int q = nwg / NXCD, r = nwg % NXCD, xcd = wgid % NXCD, off = wgid / NXCD; wgid = (xcd < r ? xcd * (q + 1) : r * (q + 1) + (xcd - r) * q) + off; }
        const int nig = WGM * nN, gid = wgid / nig, fm = gid * WGM, gsz = (nM - fm) < WGM ? (nM - fm) : WGM;
        u.pm = fm + ((wgid % nig) % gsz); u.pn = (wgid % nig) / gsz; return true;
    }
    __device__ __forceinline__ void a_ready(const Unit&) const {}
    __device__ __forceinline__ void done(const Unit&) const {}
};

__device__ __forceinline__ unsigned cvt_pk_bf16(float lo, float hi) { unsigned r; asm volatile("v_cvt_pk_bf16_f32 %0, %1, %2" : "=v"(r) : "v"(lo), "v"(hi)); return r; }
__device__ __forceinline__ float bf_lo(unsigned w) { return __uint_as_float(w << 16); }
__device__ __forceinline__ float bf_hi(unsigned w) { return __uint_as_float(w & 0xffff0000u); }
__device__ __forceinline__ float sigmoid_f(float x) { return __builtin_amdgcn_rcpf(1.0f + __builtin_amdgcn_exp2f(-1.4426950408889634f * x)); }
__device__ __forceinline__ float gelu_tanh_f(float x) { const float t = x * (-2.3022081986f + -0.1029432446f * x * x); return x * __builtin_amdgcn_rcpf(1.0f + __builtin_amdgcn_exp2f(t)); }
__device__ __forceinline__ float silu_f(float x) { return x * sigmoid_f(x); }

struct EpiZ {
    static constexpr bool PERM = true, AFTER_DRAIN = false, HAS_MID = false; static constexpr int TMID = -1;
    bf16_t* Z; int ldc;
    __device__ __forceinline__ void mid(f32x4 (&)[2][2][4][2], const Unit&, int, int, int, int) const {}
    __device__ __forceinline__ void operator()(const f32x4 (&acc)[2][2][4][2], const Unit& u, int wr, int wc, int fr, int fq) const {
        int row0 = u.pm * BM + wr * 64 + fr; const int col0 = u.pn * BM + wc * 32 + 8 * fq; asm volatile("" : "+v"(row0));
        const int mode = u.pn < 4 ? 0 : (u.pn < 16 ? 1 : 2);
#pragma unroll
        for (int ai = 0; ai < 2; ++ai)
#pragma unroll
            for (int m = 0; m < 4; ++m) { bf16_t* rowp = Z + (size_t)(row0 + ai * HALF + m * 16) * ldc + col0;
#pragma unroll
                for (int bj = 0; bj < 2; ++bj) { f32x4 v0 = acc[ai][bj][m][0], v1 = acc[ai][bj][m][1];
                    if (mode == 1) {
#pragma unroll
                        for (int j = 0; j < 4; ++j) { v0[j] = gelu_tanh_f(v0[j]); v1[j] = gelu_tanh_f(v1[j]); } }
                    else if (mode == 2) {
#pragma unroll
                        for (int j = 0; j < 4; ++j) { v0[j] = sigmoid_f(v0[j]); v1[j] = sigmoid_f(v1[j]); } }
                    u32x4 w; w.x = cvt_pk_bf16(v0[0], v0[1]); w.y = cvt_pk_bf16(v0[2], v0[3]); w.z = cvt_pk_bf16(v1[0], v1[1]); w.w = cvt_pk_bf16(v1[2], v1[3]);
                    *(u32x4*)(rowp + bj * HALF) = w; } }
    }
};
struct EpiBf16 {
    static constexpr bool PERM = true, AFTER_DRAIN = false, HAS_MID = false; static constexpr int TMID = -1;
    bf16_t* O; int ldc;
    __device__ __forceinline__ void mid(f32x4 (&)[2][2][4][2], const Unit&, int, int, int, int) const {}
    __device__ __forceinline__ void operator()(const f32x4 (&acc)[2][2][4][2], const Unit& u, int wr, int wc, int fr, int fq) const {
        int row0 = u.pm * BM + wr * 64 + fr; const int col0 = u.pn * BM + wc * 32 + 8 * fq; asm volatile("" : "+v"(row0));
#pragma unroll
        for (int ai = 0; ai < 2; ++ai)
#pragma unroll
            for (int m = 0; m < 4; ++m) { bf16_t* rowp = O + (size_t)(row0 + ai * HALF + m * 16) * ldc + col0;
#pragma unroll
                for (int bj = 0; bj < 2; ++bj) { const f32x4 v0 = acc[ai][bj][m][0], v1 = acc[ai][bj][m][1];
                    u32x4 w; w.x = cvt_pk_bf16(v0[0], v0[1]); w.y = cvt_pk_bf16(v0[2], v0[3]); w.z = cvt_pk_bf16(v1[0], v1[1]); w.w = cvt_pk_bf16(v1[2], v1[3]);
                    *(u32x4*)(rowp + bj * HALF) = w; } }
    }
};
struct EpiGate {
    static constexpr bool PERM = true, AFTER_DRAIN = false, HAS_MID = true; static constexpr int TMID = 16;
    const bf16_t* Zg; int ldz;
    bf16_t* O; int ldc;
    __device__ __forceinline__ void mid(f32x4 (&acc)[2][2][4][2], const Unit& u, int wr, int wc, int fr, int fq) const {
        int row0 = u.pm * BM + wr * 64 + fr; const int col0 = u.pn * BM + wc * 32 + 8 * fq; asm volatile("" : "+v"(row0));
#pragma unroll
        for (int ai = 0; ai < 2; ++ai)
#pragma unroll
            for (int m = 0; m < 4; ++m) { const bf16_t* rowp = Zg + (size_t)(row0 + ai * HALF + m * 16) * ldz + col0;
#pragma unroll
                for (int bj = 0; bj < 2; ++bj) { const u32x4 ga = *(const u32x4*)(rowp + bj * HALF), gb = *(const u32x4*)(rowp + 1024 + bj * HALF);
                    f32x4 r0, r1;
                    r0[0] = bf_lo(ga.x) * __builtin_amdgcn_rcpf(fmaxf(bf_lo(gb.x), 1e-30f)); r0[1] = bf_hi(ga.x) * __builtin_amdgcn_rcpf(fmaxf(bf_hi(gb.x), 1e-30f));
                    r0[2] = bf_lo(ga.y) * __builtin_amdgcn_rcpf(fmaxf(bf_lo(gb.y), 1e-30f)); r0[3] = bf_hi(ga.y) * __builtin_amdgcn_rcpf(fmaxf(bf_hi(gb.y), 1e-30f));
                    r1[0] = bf_lo(ga.z) * __builtin_amdgcn_rcpf(fmaxf(bf_lo(gb.z), 1e-30f)); r1[1] = bf_hi(ga.z) * __builtin_amdgcn_rcpf(fmaxf(bf_hi(gb.z), 1e-30f));
                    r1[2] = bf_lo(ga.w) * __builtin_amdgcn_rcpf(fmaxf(bf_lo(gb.w), 1e-30f)); r1[3] = bf_hi(ga.w) * __builtin_amdgcn_rcpf(fmaxf(bf_hi(gb.w), 1e-30f));
                    acc[ai][bj][m][0] *= r0; acc[ai][bj][m][1] *= r1; } }
    }
    __device__ __forceinline__ void operator()(const f32x4 (&acc)[2][2][4][2], const Unit& u, int wr, int wc, int fr, int fq) const {
        int row0 = u.pm * BM + wr * 64 + fr; const int col0 = u.pn * BM + wc * 32 + 8 * fq; asm volatile("" : "+v"(row0));
#pragma unroll
        for (int ai = 0; ai < 2; ++ai)
#pragma unroll
            for (int m = 0; m < 4; ++m) { const size_t r = (size_t)(row0 + ai * HALF + m * 16);
#pragma unroll
                for (int bj = 0; bj < 2; ++bj) { const u32x4 gb = *(const u32x4*)(Zg + r * ldz + col0 + 1024 + bj * HALF);
                    f32x4 v0 = acc[ai][bj][m][0], v1 = acc[ai][bj][m][1];
                    v0[0] *= fmaxf(bf_lo(gb.x), 1e-30f); v0[1] *= fmaxf(bf_hi(gb.x), 1e-30f); v0[2] *= fmaxf(bf_lo(gb.y), 1e-30f); v0[3] *= fmaxf(bf_hi(gb.y), 1e-30f);
                    v1[0] *= fmaxf(bf_lo(gb.z), 1e-30f); v1[1] *= fmaxf(bf_hi(gb.z), 1e-30f); v1[2] *= fmaxf(bf_lo(gb.w), 1e-30f); v1[3] *= fmaxf(bf_hi(gb.w), 1e-30f);
                    u32x4 w; w.x = cvt_pk_bf16(v0[0], v0[1]); w.y = cvt_pk_bf16(v0[2], v0[3]); w.z = cvt_pk_bf16(v1[0], v1[1]); w.w = cvt_pk_bf16(v1[2], v1[3]);
                    *(u32x4*)(O + r * ldc + col0 + bj * HALF) = w; } }
    }
};
struct EpiSwiGLU {
    static constexpr bool PERM = true, AFTER_DRAIN = false, HAS_MID = false; static constexpr int TMID = -1;
    bf16_t* O; int ldc;
    __device__ __forceinline__ void mid(f32x4 (&)[2][2][4][2], const Unit&, int, int, int, int) const {}
    __device__ __forceinline__ void operator()(const f32x4 (&acc)[2][2][4][2], const Unit& u, int wr, int wc, int fr, int fq) const {
        int row0 = u.pm * BM + wr * 64 + fr; const int col0 = u.pn * HALF + wc * 32 + 8 * fq; asm volatile("" : "+v"(row0));
#pragma unroll
        for (int ai = 0; ai < 2; ++ai)
#pragma unroll
            for (int m = 0; m < 4; ++m) { bf16_t* rowp = O + (size_t)(row0 + ai * HALF + m * 16) * ldc + col0;
                f32x4 v0, v1;
#pragma unroll
                for (int j = 0; j < 4; ++j) { v0[j] = silu_f(acc[ai][0][m][0][j]) * acc[ai][1][m][0][j]; v1[j] = silu_f(acc[ai][0][m][1][j]) * acc[ai][1][m][1][j]; }
                u32x4 w; w.x = cvt_pk_bf16(v0[0], v0[1]); w.y = cvt_pk_bf16(v0[2], v0[3]); w.z = cvt_pk_bf16(v1[0], v1[1]); w.w = cvt_pk_bf16(v1[2], v1[3]);
                *(u32x4*)rowp = w; }
    }
};

template <class Epi, class Sched, bool ALIGN_EPI = false, bool SP2 = false>
__device__ __forceinline__ void gemm_phase(PG8_LAS unsigned char* lds, const Gemm g, const Sched& S, const Epi& E) {
    const int tid = threadIdx.x, wid = __builtin_amdgcn_readfirstlane(tid >> 6), lane = tid & 63, wr = wid >> 2, wc = wid & 3, fr = lane & 15, fq = lane >> 4;
    const int K = g.K, nt = K / BK;
    unsigned voffA[2], voffB[2];
#pragma unroll
    for (int i = 0; i < 2; ++i) { int R, C; stage_rc(tid * 16 + i * 8192, R, C); const int Rb = Epi::PERM ? ((R & ~31) + perm32(R & 31)) : R;
        voffA[i] = (unsigned)(R * g.lda + C) * 2u; voffB[i] = (unsigned)(Rb * g.ldb + C) * 2u; }
    const size_t kstep = (size_t)(BK * 2);
    const size_t hstepA = (size_t)HALF * g.lda * 2, hstepB = (size_t)HALF * g.ldb * 2;
    const size_t tstepA = 2 * hstepA, tstepB = 2 * hstepB;
    const unsigned ldsw = (unsigned)wid * 1024u;
    const int aoff = lds_byte(wr * 64 + fr, fq * 8), boff = lds_byte(wc * 32 + fr, fq * 8);
#define PG8_SA(b, h) (((b) * 2 + (h)) * HTB)
#define PG8_SB(b, h) ((4 + (b) * 2 + (h)) * HTB)
#define PG8_STAGE(bufoff, gbase, voff) do { _Pragma("unroll") for (int _i = 0; _i < 2; ++_i) \
        __builtin_amdgcn_global_load_lds((const unsigned*)((const char*)(gbase) + (voff)[_i]), (PG8_LAS unsigned*)(lds + (bufoff) + ldsw + _i * 8192), 16, 0, 0); } while (0)
#define PG8_LDA(dst, b, h) do { _Pragma("unroll") for (int m = 0; m < 4; ++m) _Pragma("unroll") for (int k = 0; k < 2; ++k) dst[m][k] = *(const PG8_LAS bf16x8*)(lds + PG8_SA(b, h) + aoff + m * 2048 + k * 1024); } while (0)
#define PG8_LDB(dst, b, h) do { _Pragma("unroll") for (int n = 0; n < 2; ++n) _Pragma("unroll") for (int k = 0; k < 2; ++k) dst[n][k] = *(const PG8_LAS bf16x8*)(lds + PG8_SB(b, h) + boff + n * 2048 + k * 1024); } while (0)
#define PG8_MMA(ai, bj, At, Bt) do { __builtin_amdgcn_s_setprio(1); _Pragma("unroll") for (int m = 0; m < 4; ++m) _Pragma("unroll") for (int n = 0; n < 2; ++n) _Pragma("unroll") for (int k = 0; k < 2; ++k) \
        acc[ai][bj][m][n] = __builtin_amdgcn_mfma_f32_16x16x32_bf16(Bt[n][k], At[m][k], acc[ai][bj][m][n], 0, 0, 0); __builtin_amdgcn_s_setprio(0); } while (0)
#define PG8_WAIT_V(n) asm volatile("s_waitcnt vmcnt(" #n ")" ::: "memory")
#define PG8_WAIT_L(n) asm volatile("s_waitcnt lgkmcnt(" #n ")" ::: "memory")
#define PG8_BAR __builtin_amdgcn_s_barrier()
#define PG8_SCHED __builtin_amdgcn_sched_barrier(0)
    Unit cur, nxt; int ui = 0;
    if (!S.next(0, cur)) return;
    f32x4 acc[2][2][4][2];
#pragma unroll
    for (int a = 0; a < 2; ++a)
#pragma unroll
        for (int b = 0; b < 2; ++b)
#pragma unroll
            for (int m = 0; m < 4; ++m)
#pragma unroll
                for (int n = 0; n < 2; ++n) acc[a][b][m][n] = (f32x4){0.f, 0.f, 0.f, 0.f};
    bf16x8 At[4][2], B0[2][2], B1[2][2];
    const char* cA = (const char*)g.A + (size_t)cur.pm * tstepA; const char* cB = (const char*)g.Bt + (size_t)cur.pn * tstepB;
    S.a_ready(cur);
    if constexpr (SP2) {
        PG8_STAGE(PG8_SB(0, 0), cB, voffB); PG8_STAGE(PG8_SB(0, 1), cB + hstepB, voffB); PG8_STAGE(PG8_SA(0, 0), cA, voffA); PG8_STAGE(PG8_SA(0, 1), cA + hstepA, voffA);
        if (wr == 1) PG8_BAR;
        PG8_WAIT_V(2); PG8_BAR;
        PG8_STAGE(PG8_SB(1, 0), cB + kstep, voffB); PG8_STAGE(PG8_SA(1, 0), cA + kstep, voffA); PG8_STAGE(PG8_SB(1, 1), cB + hstepB + kstep, voffB);
        PG8_WAIT_V(6); PG8_BAR;
    } else {
        PG8_STAGE(PG8_SB(0, 0), cB, voffB); PG8_STAGE(PG8_SA(0, 0), cA, voffA); PG8_STAGE(PG8_SB(0, 1), cB + hstepB, voffB); PG8_STAGE(PG8_SA(0, 1), cA + hstepA, voffA);
        if (wr == 1) PG8_BAR;
        PG8_WAIT_V(4); PG8_BAR;
        PG8_STAGE(PG8_SB(1, 0), cB + kstep, voffB); PG8_STAGE(PG8_SA(1, 0), cA + kstep, voffA); PG8_STAGE(PG8_SB(1, 1), cB + hstepB + kstep, voffB);
        PG8_WAIT_V(6); PG8_BAR;
    }
    for (;;) {
        const bool has_next = S.next(ui + 1, nxt);
        const char* nA = has_next ? (const char*)g.A + (size_t)nxt.pm * tstepA : cA; const char* nB = has_next ? (const char*)g.Bt + (size_t)nxt.pn * tstepB : cB;
        for (int t = 0; t < nt; t += 2) {
            const bool last = (t == nt - 2);
            const char* a1 = cA + (size_t)(t + 1) * kstep;
            const char* a2 = last ? nA : cA + (size_t)(t + 2) * kstep; const char* b2 = last ? nB : cB + (size_t)(t + 2) * kstep;
            const char* a3 = a2 + kstep; const char* b3 = b2 + kstep;
            if (last && has_next) S.a_ready(nxt);
            if constexpr (Epi::HAS_MID) { if (t == Epi::TMID) E.mid(acc, cur, wr, wc, fr, fq); }
            if constexpr (SP2) {
            PG8_LDB(B0, 0, 0); PG8_LDB(B1, 0, 1); PG8_SCHED; PG8_LDA(At, 0, 0); PG8_STAGE(PG8_SA(1, 1), a1 + hstepA, voffA);
            PG8_WAIT_V(8); PG8_WAIT_L(0); PG8_BAR; PG8_MMA(0, 0, At, B0); PG8_MMA(0, 1, At, B1); PG8_BAR; PG8_SCHED;
            PG8_LDA(At, 0, 1); PG8_STAGE(PG8_SB(0, 0), b2, voffB); PG8_STAGE(PG8_SB(0, 1), b2 + hstepB, voffB); PG8_STAGE(PG8_SA(0, 0), a2, voffA);
            PG8_WAIT_V(8); PG8_WAIT_L(0); PG8_BAR; PG8_MMA(1, 0, At, B0); PG8_MMA(1, 1, At, B1); PG8_BAR; PG8_SCHED;
            PG8_LDB(B0, 1, 0); PG8_LDB(B1, 1, 1); PG8_SCHED; PG8_LDA(At, 1, 0); PG8_STAGE(PG8_SA(0, 1), a2 + hstepA, voffA);
            PG8_WAIT_V(8); PG8_WAIT_L(0); PG8_BAR; PG8_MMA(0, 0, At, B0); PG8_MMA(0, 1, At, B1); PG8_BAR; PG8_SCHED;
            PG8_LDA(At, 1, 1); PG8_STAGE(PG8_SB(1, 0), b3, voffB); PG8_STAGE(PG8_SB(1, 1), b3 + hstepB, voffB); PG8_STAGE(PG8_SA(1, 0), a3, voffA);
            PG8_WAIT_V(8); PG8_WAIT_L(0); PG8_BAR; PG8_MMA(1, 0, At, B0); PG8_MMA(1, 1, At, B1); PG8_BAR; PG8_SCHED;
            } else {
            PG8_LDB(B0, 0, 0); PG8_SCHED; PG8_LDA(At, 0, 0); PG8_STAGE(PG8_SA(1, 1), a1 + hstepA, voffA);
            PG8_WAIT_L(8); PG8_BAR; PG8_WAIT_L(0); PG8_MMA(0, 0, At, B0); PG8_BAR; PG8_SCHED;
            PG8_LDB(B1, 0, 1); PG8_STAGE(PG8_SB(0, 0), b2, voffB);
            PG8_BAR; PG8_WAIT_L(0); PG8_MMA(0, 1, At, B1); PG8_BAR;
            PG8_LDA(At, 0, 1); PG8_STAGE(PG8_SA(0, 0), a2, voffA);
            PG8_BAR; PG8_WAIT_L(0); PG8_MMA(1, 0, At, B0); PG8_BAR; PG8_SCHED;
            PG8_STAGE(PG8_SB(0, 1), b2 + hstepB, voffB);
            PG8_WAIT_V(6); PG8_BAR; PG8_MMA(1, 1, At, B1); PG8_BAR;
            PG8_LDB(B0, 1, 0); PG8_SCHED; PG8_LDA(At, 1, 0); PG8_STAGE(PG8_SA(0, 1), a2 + hstepA, voffA);
            PG8_WAIT_L(8); PG8_BAR; PG8_WAIT_L(0); PG8_MMA(0, 0, At, B0); PG8_BAR; PG8_SCHED;
            PG8_LDB(B1, 1, 1); PG8_STAGE(PG8_SB(1, 0), b3, voffB);
            PG8_BAR; PG8_WAIT_L(0); PG8_MMA(0, 1, At, B1); PG8_BAR;
            PG8_LDA(At, 1, 1); PG8_STAGE(PG8_SA(1, 0), a3, voffA);
            PG8_BAR; PG8_WAIT_L(0); PG8_MMA(1, 0, At, B0); PG8_BAR; PG8_SCHED;
            PG8_STAGE(PG8_SB(1, 1), b3 + hstepB, voffB);
            PG8_WAIT_V(6); PG8_BAR; PG8_MMA(1, 1, At, B1); PG8_BAR;
            }
        }
        if constexpr (ALIGN_EPI) { if (wr == 0) PG8_BAR; }
        E(acc, cur, wr, wc, fr, fq); S.done(cur);
        if (!has_next) break;
#pragma unroll
        for (int a = 0; a < 2; ++a)
#pragma unroll
            for (int b = 0; b < 2; ++b)
#pragma unroll
                for (int m = 0; m < 4; ++m)
#pragma unroll
                    for (int n = 0; n < 2; ++n) acc[a][b][m][n] = (f32x4){0.f, 0.f, 0.f, 0.f};
        cur = nxt; cA = nA; cB = nB; ++ui;
        if constexpr (ALIGN_EPI) { if (wr == 1) PG8_BAR; }
    }
    PG8_WAIT_V(0);
    if constexpr (!ALIGN_EPI) { if (wr == 0) PG8_BAR; }
    PG8_BAR;
#undef PG8_SA
#undef PG8_SB
#undef PG8_STAGE
#undef PG8_LDA
#undef PG8_LDB
#undef PG8_MMA
#undef PG8_WAIT_V
#undef PG8_WAIT_L
#undef PG8_BAR
#undef PG8_SCHED
}
}

#ifndef PG8_SP2
#define PG8_SP2 true
#endif
#ifndef PG8_ALIGN
#define PG8_ALIGN true
#endif

constexpr int NWAVES = 8;
constexpr int N_LAUNCHES = MK_N_LAUNCHES;
constexpr int PER_PHASE = 9;
constexpr int DM = 1024, SEQ = 2048, NB = 16, DEC_T = 32;
constexpr int MP = NB * SEQ, MS = NB * DEC_T, M = MP + MS;
constexpr int DIN = 6144, DFF = 2816, DFF2 = 5632;
constexpr float EPS = 1e-6f;
static_assert(M % 256 == 0, "M");
enum { I_XP = 0, I_XS, I_SH, I_SC, I_GPRE, I_WIN, I_CW, I_CB, I_WA, I_BA, I_WX, I_BX, I_LAM, I_WBRA, I_LNG, I_LNB, I_WS, I_BS, I_WBRB, I_WOUT, I_GPOST, I_GFFN, I_WFI, I_WFO, I_GPF, N_IN };
constexpr size_t O_Y = 0, O_HP = (size_t)M * DM, O_CP = O_HP + NB * DM, O_HS = O_CP + (size_t)NB * 3 * DM, O_CS = O_HS + NB * DM, O_VS = O_CS + (size_t)NB * 3 * DM, O_END = O_VS + (size_t)MS * DM;
static_assert(O_END == 34734080, "output size");

constexpr size_t MiB = 1u << 20;
constexpr size_t WS_CTL = 0, CTL_ZERO_BYTES = 1 * MiB;
constexpr size_t WS_W1 = 1 * MiB;
constexpr size_t WS_W2 = WS_W1 + (size_t)DIN * DM * 2;
constexpr size_t WS_W3 = WS_W2 + (size_t)DM * 2048 * 2;
constexpr size_t WS_W4 = WS_W3 + (size_t)DM * DM * 2;
constexpr size_t WS_W5 = WS_W4 + (size_t)DFF2 * DM * 2;
constexpr size_t WS_GT = WS_W5 + (size_t)DM * DFF * 2;
constexpr size_t WS_WSM = WS_GT + 16 * 128 * 64 * 2;
constexpr size_t WS_WSS = WS_WSM + 8 * 128 * 128 * 2;
constexpr size_t WS_WEND = WS_WSS + 8 * 128 * 128 * 2;
constexpr size_t WS_XN = 40 * MiB;
constexpr size_t WS_Z = 105 * MiB;
constexpr size_t WS_MIX = WS_Z;
constexpr size_t WS_FIN = WS_Z + 65 * MiB;
constexpr size_t WS_F = WS_FIN + 179 * MiB;
constexpr size_t WS_END = WS_Z + (size_t)M * DIN * 2;
static_assert(WS_WEND <= WS_XN && WS_XN + (size_t)M * DM * 2 <= WS_Z && WS_FIN + (size_t)M * DFF * 2 <= WS_F && WS_F + (size_t)M * DM * 2 <= WS_END && WS_END <= 512 * MiB, "d_ws map");
constexpr int CW_TMO = 0, CW_BAR = 4096;

constexpr int RING_OFF = 0, RING_BYTES = 131072;
constexpr int LDSCTL_OFF = 139264, MISC_OFF = LDSCTL_OFF + 320;
constexpr int LDS_BYTES = 147456;

#define GAS __attribute__((address_space(1)))
#define LAS __attribute__((address_space(3)))
typedef unsigned short bf16;
typedef unsigned v4u __attribute__((ext_vector_type(4)));
typedef unsigned v2u __attribute__((ext_vector_type(2)));
typedef float f32x4 __attribute__((ext_vector_type(4)));
typedef float f32x16 __attribute__((ext_vector_type(16)));
typedef short bf16x8 __attribute__((ext_vector_type(8)));
typedef GAS unsigned gu32;
#define RLX_AGENT __ATOMIC_RELAXED, __HIP_MEMORY_SCOPE_AGENT
#define LDS_WAIT() asm volatile("s_waitcnt lgkmcnt(0)" ::: "memory")
#define VM_WAIT() asm volatile("s_waitcnt vmcnt(0)" ::: "memory")
__device__ __forceinline__ unsigned f2bf(float f) { unsigned u = __builtin_bit_cast(unsigned, f); return (u + 0x7fffu + ((u >> 16) & 1u)) >> 16; }
__device__ __forceinline__ unsigned pk2(float lo, float hi) { return f2bf(lo) | (f2bf(hi) << 16); }
__device__ __forceinline__ float bflo(unsigned w) { return __uint_as_float(w << 16); }
__device__ __forceinline__ float bfhi(unsigned w) { return __uint_as_float(w & 0xffff0000u); }

#define XB_TMO      128
#define XB_XCNT(j)  (256  + 64 * (j))
#define XB_XSUB(j)  (1280 + 64 * (j))
#define XB_XGEN(j)  (2304 + 64 * (j))
#define XB_TOP      3328
#define XB_TOPGEN   3392
#define XCD_BAR_WORDS 3456
#define XB_SPIN_CAP (1u << 22)

__device__ __forceinline__ unsigned xb_ld(unsigned* p)              { return __hip_atomic_load(p, __ATOMIC_RELAXED, __HIP_MEMORY_SCOPE_AGENT); }
__device__ __forceinline__ unsigned xb_add(unsigned* p, unsigned v) { return __hip_atomic_fetch_add(p, v, __ATOMIC_RELAXED, __HIP_MEMORY_SCOPE_AGENT); }
__device__ __forceinline__ unsigned xb_xcc_id() { return (unsigned)__builtin_amdgcn_s_getreg((3 << 11) | 20) & 0xFu; }
#define XB_SPIN(cond, bar) do { unsigned _sp = 0; while (cond) { __builtin_amdgcn_s_sleep(1); \
    if ((++_sp & 255u) == 0u) { if (xb_ld(&(bar)[XB_TMO])) break; if (_sp > XB_SPIN_CAP) { atomicAdd(&(bar)[XB_TMO], 1u); break; } } } } while (0)

struct XcdBarrier { unsigned* bar; unsigned x; volatile LAS unsigned* st; };

__device__ __forceinline__ XcdBarrier xcd_barrier_post(unsigned* bar, volatile LAS unsigned* st) {
    XcdBarrier b; b.bar = bar; b.x = xb_xcc_id(); b.st = st;
    if (threadIdx.x == 0) (void)xb_add(&bar[XB_XCNT(b.x)], 1u);
    return b;
}
__device__ __forceinline__ void xcd_barrier_complete(unsigned* bar, unsigned x, unsigned& nloc, unsigned& nx) {
    const unsigned G = gridDim.x * gridDim.y * gridDim.z;
    unsigned sum, cnt, mine, sp = 0u;
    for (;;) {
        sum = 0u; cnt = 0u; mine = 0u;
#pragma unroll
        for (unsigned j = 0; j < 16; ++j) { const unsigned c = xb_ld(&bar[XB_XCNT(j)]); sum += c; cnt += (c > 0u) ? 1u : 0u; mine = (j == x) ? c : mine; }
        if (sum == G) break;
        __builtin_amdgcn_s_sleep(1);
        if ((++sp & 255u) == 0u) { if (xb_ld(&bar[XB_TMO])) break; if (sp > XB_SPIN_CAP) { atomicAdd(&bar[XB_TMO], 1u); break; } }
    }
    nloc = mine > 0u ? mine : 1u; nx = cnt > 0u ? cnt : 1u;
}
__device__ __forceinline__ void xcd_barrier(const XcdBarrier& b) {
    asm volatile("s_waitcnt vmcnt(0)" ::: "memory");
    __syncthreads();
    if (threadIdx.x == 0) {
        unsigned* bar = b.bar;
        __builtin_amdgcn_s_waitcnt(0);
        unsigned nloc = b.st[0], nx = b.st[1];
        if (nloc == 0u) { xcd_barrier_complete(bar, b.x, nloc, nx); b.st[0] = nloc; b.st[1] = nx; }
        const unsigned old = xb_add(&bar[XB_XSUB(b.x)], 1u);
        const unsigned gen = old / nloc;
        if (old + 1u == (gen + 1u) * nloc) {
            __builtin_amdgcn_fence(__ATOMIC_RELEASE, "agent");
            asm volatile("s_waitcnt vmcnt(0)" ::: "memory");
            const unsigned og = xb_add(&bar[XB_TOP], 1u);
            const unsigned tg = og / nx;
            if (og + 1u == (tg + 1u) * nx) xb_add(&bar[XB_TOPGEN], 1u);
            else XB_SPIN(xb_ld(&bar[XB_TOPGEN]) == tg, bar);
            __builtin_amdgcn_fence(__ATOMIC_ACQUIRE, "agent");
            xb_add(&bar[XB_XGEN(b.x)], 1u);
            asm volatile("s_waitcnt vmcnt(0)" ::: "memory");
        } else {
            XB_SPIN(xb_ld(&bar[XB_XGEN(b.x)]) == gen, bar);
            __builtin_amdgcn_fence(__ATOMIC_ACQUIRE, "agent");
            asm volatile("s_waitcnt vmcnt(0)" ::: "memory");
        }
    }
    __syncthreads();
}

struct Args { const float* in[N_IN]; float* out; unsigned char* ws; int ph_lo, ph_hi, li, pad; };
struct Frame {
    LAS unsigned char* lds;
    volatile LAS unsigned* MISC;
    gu32* ctl;
    int tid, lane, wave, vcu, G;
};
__device__ __forceinline__ float wave_sum(float v) {
#pragma unroll
    for (int o = 1; o < 64; o <<= 1) v += __shfl_xor(v, o);
    return v;
}
__device__ __forceinline__ const float* xrow_ptr(const Args& a, int m) { return m < MP ? a.in[I_XP] + (size_t)m * DM : a.in[I_XS] + (size_t)(m - MP) * DM; }

__device__ __forceinline__ void p0_transpose_item(const float* W, int N, bf16* WT, int ldk, int dcol0, int k0, int n0, int drow0, LAS float* scr, int lane) {
#pragma unroll 8
    for (int i = 0; i < 32; ++i) { const int kk = 2 * i + (lane >> 5); scr[kk * 33 + (lane & 31)] = W[(size_t)(k0 + kk) * N + n0 + (lane & 31)]; }
    LDS_WAIT(); asm volatile("" ::: "memory");
    const int c = lane & 7;
#pragma unroll
    for (int j = 0; j < 4; ++j) { const int n = (lane >> 3) + 8 * j; const LAS float* s = scr + (8 * c) * 33 + n;
        v4u o; o.x = pk2(s[0 * 33], s[1 * 33]); o.y = pk2(s[2 * 33], s[3 * 33]); o.z = pk2(s[4 * 33], s[5 * 33]); o.w = pk2(s[6 * 33], s[7 * 33]);
        *(GAS v4u*)(WT + (size_t)(drow0 + n) * ldk + dcol0 + k0 + 8 * c) = o; }
    LDS_WAIT(); asm volatile("" ::: "memory");
}

__device__ __forceinline__ void p0_prologue(Frame& F, const Args& a) {
    unsigned char* ws = a.ws;
    LAS float* scr = (LAS float*)(F.lds + RING_OFF + F.wave * 16384);
    const int gw = F.vcu * NWAVES + F.wave, NGW = F.G * NWAVES;
    constexpr int I1 = (DM / 64) * (DIN / 32), I2 = (DM / 64) * (DM / 32), I4 = (DM / 64) * (DFF2 / 32), I5 = (DFF / 64) * (DM / 32), IG = 64;
    constexpr int NITEMS = I1 + 3 * I2 + I4 + I5 + IG;
    for (int it = gw; it < NITEMS; it += NGW) {
        int r = it;
        if (r < I1) { const int nb = DIN / 32, kb = r / nb, n0 = 32 * (r % nb); p0_transpose_item(a.in[I_WIN], DIN, (bf16*)(ws + WS_W1), DM, 0, 64 * kb, n0, n0, scr, F.lane); continue; } r -= I1;
        if (r < I2) { const int nb = DM / 32, kb = r / nb, n0 = 32 * (r % nb); p0_transpose_item(a.in[I_WBRA], DM, (bf16*)(ws + WS_W2), 2048, 0, 64 * kb, n0, n0, scr, F.lane); continue; } r -= I2;
        if (r < I2) { const int nb = DM / 32, kb = r / nb, n0 = 32 * (r % nb); p0_transpose_item(a.in[I_WBRB], DM, (bf16*)(ws + WS_W2), 2048, 1024, 64 * kb, n0, n0, scr, F.lane); continue; } r -= I2;
        if (r < I2) { const int nb = DM / 32, kb = r / nb, n0 = 32 * (r % nb); p0_transpose_item(a.in[I_WOUT], DM, (bf16*)(ws + WS_W3), DM, 0, 64 * kb, n0, n0, scr, F.lane); continue; } r -= I2;
        if (r < I4) { const int nb = DFF2 / 32, kb = r / nb, n0 = 32 * (r % nb); const int s = n0 / DFF, j0 = n0 % DFF, drow0 = 256 * (j0 / 128) + 128 * s + (j0 % 128);
                      p0_transpose_item(a.in[I_WFI], DFF2, (bf16*)(ws + WS_W4), DM, 0, 64 * kb, n0, drow0, scr, F.lane); continue; } r -= I4;
        if (r < I5) { const int nb = DM / 32, kb = r / nb, n0 = 32 * (r % nb); p0_transpose_item(a.in[I_WFO], DM, (bf16*)(ws + WS_W5), DFF, 0, 64 * kb, n0, n0, scr, F.lane); continue; } r -= I5;
        { const int hd = r >> 2, which = (r >> 1) & 1, n0 = 32 * (r & 1);
          p0_transpose_item((which ? a.in[I_WX] : a.in[I_WA]) + (size_t)hd * 4096, 64, (bf16*)(ws + WS_GT) + (size_t)hd * 8192, 64, 0, 0, n0, which * 64 + n0, scr, F.lane); }
    }
    { const float* wsp = a.in[I_WS]; bf16* wsm = (bf16*)(ws + WS_WSM); bf16* wss = (bf16*)(ws + WS_WSS);
      for (int i = gw * 64 + F.lane; i < 8 * 128 * 128; i += NGW * 64) { const int g = i >> 14, p = (i >> 7) & 127, q = i & 127;
          wsm[i] = (bf16)(((q >> 6) <= (p >> 6)) ? f2bf(wsp[i]) : 0u);
          wss[i] = (bf16)(((q >> 5) == (p >> 5)) ? f2bf(wsp[(g << 14) + ((p & 31) << 7) + (q & 31)]) : 0u); } }
    { const GAS f32x4* gp = (const GAS f32x4*)a.in[I_GPRE] + F.lane; f32x4 gg[4];
#pragma unroll
      for (int j = 0; j < 4; ++j) gg[j] = gp[64 * j];
      bf16* XN = (bf16*)(ws + WS_XN);
      for (int m = gw; m < M; m += NGW) { const GAS f32x4* xr = (const GAS f32x4*)xrow_ptr(a, m) + F.lane; f32x4 v[4]; float s = 0.f;
#pragma unroll
          for (int j = 0; j < 4; ++j) { v[j] = xr[64 * j]; s += (v[j].x * v[j].x + v[j].y * v[j].y) + (v[j].z * v[j].z + v[j].w * v[j].w); }
          const float rstd = 1.0f / sqrtf(wave_sum(s) * (1.f / DM) + EPS);
          GAS v2u* o8 = (GAS v2u*)(XN + (size_t)m * DM) + F.lane;
#pragma unroll
          for (int j = 0; j < 4; ++j) { v2u o; o.x = pk2(v[j].x * rstd * gg[j].x, v[j].y * rstd * gg[j].y); o.y = pk2(v[j].z * rstd * gg[j].z, v[j].w * rstd * gg[j].w); o8[64 * j] = o; } } }
}

__device__ __forceinline__ void p2a_item(Frame& F, const Args& a, int row0, int T, int hd, const float* h0, const float* cprev, float* out_h, float* out_conv) {
    LAS unsigned char* lds = F.lds;
    LAS float* XC = (LAS float*)(lds);
    LAS float* AS = (LAS float*)(lds + 32768);
    LAS float* US = (LAS float*)(lds + 65536);
    LAS bf16* XCB = (LAS bf16*)(lds + 98304);
    LAS float* SEGA = (LAS float*)(lds + 116736);
    LAS float* SEGB = (LAS float*)(lds + 118784);
    LAS float* CAR = (LAS float*)(lds + 120832);
    bf16* Z = (bf16*)(a.ws + WS_Z);
    const int tid = F.tid, lane = F.lane, wave = F.wave;
    const int tr = tid >> 3, cg = tid & 7, ch0 = hd * 64 + cg * 8;
    const int sc = tid & 63, seg = tid >> 6;
    const int tb = wave >> 1, cb = wave & 1, jl = cb * 32 + (lane & 31), hi = lane >> 5;
    __syncthreads();
    float cw[4][8], cbv[8];
#pragma unroll
    for (int k = 0; k < 4; ++k) { const f32x4 w0 = *(const GAS f32x4*)(a.in[I_CW] + k * DM + ch0), w1 = *(const GAS f32x4*)(a.in[I_CW] + k * DM + ch0 + 4);
        cw[k][0] = w0.x; cw[k][1] = w0.y; cw[k][2] = w0.z; cw[k][3] = w0.w; cw[k][4] = w1.x; cw[k][5] = w1.y; cw[k][6] = w1.z; cw[k][7] = w1.w; }
    { const f32x4 w0 = *(const GAS f32x4*)(a.in[I_CB] + ch0), w1 = *(const GAS f32x4*)(a.in[I_CB] + ch0 + 4);
      cbv[0] = w0.x; cbv[1] = w0.y; cbv[2] = w0.z; cbv[3] = w0.w; cbv[4] = w1.x; cbv[5] = w1.y; cbv[6] = w1.z; cbv[7] = w1.w; }
    bf16x8 Br[4], Bi[4];
    { const bf16* gt = (const bf16*)(a.ws + WS_GT) + (size_t)hd * 8192;
#pragma unroll
      for (int ks = 0; ks < 4; ++ks) { Br[ks] = *(const GAS bf16x8*)(gt + jl * 64 + ks * 16 + hi * 8); Bi[ks] = *(const GAS bf16x8*)(gt + (64 + jl) * 64 + ks * 16 + hi * 8); } }
    const float ba = a.in[I_BA][hd * 64 + jl], bx = a.in[I_BX][hd * 64 + jl];
    const float cA = -8.0f * log1pf(expf(-a.in[I_LAM][hd * 64 + jl])) * 1.4426950408889634f;
    if (tid < 64) CAR[tid] = h0 ? h0[hd * 64 + tid] : 0.f;
    const int ntiles = (T + 127) >> 7;
    v4u xr[5], gg[2];
#define P2A_ISSUE(t0n) do { _Pragma("unroll") for (int r = 0; r < 5; ++r) { int tt = (t0n) + 2 * tr - 3 + r; tt = tt < 0 ? 0 : (tt > T - 1 ? T - 1 : tt); \
        xr[r] = *(const GAS v4u*)(Z + (size_t)(row0 + tt) * DIN + ch0); } } while (0)
    P2A_ISSUE(0);
    for (int tile = 0; tile < ntiles; ++tile) {
        const int t0 = tile << 7, nrows = (T - t0) < 128 ? (T - t0) : 128, par = tile & 1;
        {
            float f[5][8];
#pragma unroll
            for (int r = 0; r < 5; ++r) { const int tt = t0 + 2 * tr - 3 + r; const v4u w = xr[r];
                f[r][0] = bflo(w.x); f[r][1] = bfhi(w.x); f[r][2] = bflo(w.y); f[r][3] = bfhi(w.y); f[r][4] = bflo(w.z); f[r][5] = bfhi(w.z); f[r][6] = bflo(w.w); f[r][7] = bfhi(w.w);
                if (tt < 0) {
                    if (cprev) { const f32x4 p0 = *(const GAS f32x4*)(cprev + (tt + 3) * DM + ch0), p1 = *(const GAS f32x4*)(cprev + (tt + 3) * DM + ch0 + 4);
                        f[r][0] = p0.x; f[r][1] = p0.y; f[r][2] = p0.z; f[r][3] = p0.w; f[r][4] = p1.x; f[r][5] = p1.y; f[r][6] = p1.z; f[r][7] = p1.w; }
                    else {
#pragma unroll
                        for (int e = 0; e < 8; ++e) f[r][e] = 0.f; }
                } else if (tt >= T) {
#pragma unroll
                    for (int e = 0; e < 8; ++e) f[r][e] = 0.f; }
            }
            if (tile + 1 < ntiles) P2A_ISSUE(t0 + 128);
#pragma unroll
            for (int rr = 0; rr < 2; ++rr) { int tl = 2 * tr + rr; tl = tl < nrows ? tl : nrows - 1; gg[rr] = *(const GAS v4u*)(Z + (size_t)(row0 + t0 + tl) * DIN + 1024 + ch0); }
#pragma unroll
            for (int rr = 0; rr < 2; ++rr) { const int tl = 2 * tr + rr, t = t0 + tl; float xc[8];
#pragma unroll
                for (int e = 0; e < 8; ++e) xc[e] = cbv[e] + cw[0][e] * f[rr][e] + cw[1][e] * f[rr + 1][e] + cw[2][e] * f[rr + 2][e] + cw[3][e] * f[rr + 3][e];
                *(LAS f32x4*)(XC + tl * 64 + cg * 8) = (f32x4){xc[0], xc[1], xc[2], xc[3]}; *(LAS f32x4*)(XC + tl * 64 + cg * 8 + 4) = (f32x4){xc[4], xc[5], xc[6], xc[7]};
                v4u pw; pw.x = pk2(xc[0], xc[1]); pw.y = pk2(xc[2], xc[3]); pw.z = pk2(xc[4], xc[5]); pw.w = pk2(xc[6], xc[7]);
                *(LAS v4u*)(XCB + tl * 72 + cg * 8) = pw;
                if (t >= T - 3 && t < T) { float* oc = out_conv + (size_t)(t - (T - 3)) * DM + ch0;
                    *(GAS f32x4*)oc = (f32x4){f[rr + 3][0], f[rr + 3][1], f[rr + 3][2], f[rr + 3][3]}; *(GAS f32x4*)(oc + 4) = (f32x4){f[rr + 3][4], f[rr + 3][5], f[rr + 3][6], f[rr + 3][7]}; }
            }
        }
        __syncthreads();
        if (tb * 32 < nrows) {
            f32x16 accr, acci;
#pragma unroll
            for (int i = 0; i < 16; ++i) { accr[i] = 0.f; acci[i] = 0.f; }
#pragma unroll
            for (int ks = 0; ks < 4; ++ks) { const bf16x8 A = *(const LAS bf16x8*)(XCB + (tb * 32 + (lane & 31)) * 72 + ks * 16 + hi * 8);
                accr = __builtin_amdgcn_mfma_f32_32x32x16_bf16(A, Br[ks], accr, 0, 0, 0);
                acci = __builtin_amdgcn_mfma_f32_32x32x16_bf16(A, Bi[ks], acci, 0, 0, 0); }
#pragma unroll
            for (int rg = 0; rg < 16; ++rg) { const int tl = tb * 32 + (rg & 3) + 8 * (rg >> 2) + 4 * hi;
                const float xcv = XC[tl * 64 + jl];
                const float r = pg8::sigmoid_f(accr[rg] + ba), ig = pg8::sigmoid_f(acci[rg] + bx);
                const float l2a = cA * r;
                const float av = __builtin_amdgcn_exp2f(l2a);
                const float y = l2a * 1.3862943611198906f;
                const float ser = -y * (1.0f + y * (0.5f + y * (0.16666667f + y * (0.041666668f + y * (0.0083333338f + y * 0.0013888889f)))));
                const float om = (y > -0.25f) ? ser : (1.0f - av * av);
                const float uv = sqrtf(om) * (ig * xcv);
                AS[tl * 64 + jl] = av; US[tl * 64 + jl] = uv; }
        }
        __syncthreads();
        if (seg * 16 < nrows) { float Ap = 1.f, Bp = 0.f;
#pragma unroll
            for (int s = 0; s < 16; ++s) { const float av = AS[(seg * 16 + s) * 64 + sc], uv = US[(seg * 16 + s) * 64 + sc]; Bp = av * Bp + uv; Ap *= av; }
            SEGA[seg * 64 + sc] = Ap; SEGB[seg * 64 + sc] = Bp; }
        __syncthreads();
        if (seg * 16 < nrows) { float h = CAR[par * 64 + sc];
            for (int sg = 0; sg < seg; ++sg) h = SEGA[sg * 64 + sc] * h + SEGB[sg * 64 + sc];
#pragma unroll
            for (int s = 0; s < 16; ++s) { const int tl = seg * 16 + s; h = AS[tl * 64 + sc] * h + US[tl * 64 + sc]; US[tl * 64 + sc] = h;
                if (t0 + tl == T - 1) out_h[hd * 64 + sc] = h; }
            if (seg == 7) CAR[(par ^ 1) * 64 + sc] = h; }
        __syncthreads();
#pragma unroll
        for (int rr = 0; rr < 2; ++rr) { const int tl = 2 * tr + rr;
            if (tl < nrows) { bf16* zp = Z + (size_t)(row0 + t0 + tl) * DIN + 1024 + ch0; const v4u w = gg[rr];
                const f32x4 h0v = *(const LAS f32x4*)(US + tl * 64 + cg * 8), h1v = *(const LAS f32x4*)(US + tl * 64 + cg * 8 + 4);
                v4u o; o.x = pk2(h0v.x * bflo(w.x), h0v.y * bfhi(w.x)); o.y = pk2(h0v.z * bflo(w.y), h0v.w * bfhi(w.y));
                o.z = pk2(h1v.x * bflo(w.z), h1v.y * bfhi(w.z)); o.w = pk2(h1v.z * bflo(w.w), h1v.w * bfhi(w.w));
                *(GAS v4u*)zp = o; } }
    }
#undef P2A_ISSUE
}

__device__ __forceinline__ int vt_off(int d, int q) { return d * 256 + ((((q >> 3) ^ (d & 15) ^ ((d >> 4) & 7)) & 15) << 4) + (q & 7) * 2; }
__device__ __forceinline__ void p2b_item(Frame& F, const Args& a, int item, int g_lo, int g_hi) {
    LAS unsigned char* lds = F.lds;
    LAS unsigned char* VT = lds;
    LAS unsigned char* WM = lds + 32768;
    LAS float* SG = (LAS float*)(lds + 65536);
    LAS float* ST = (LAS float*)(lds + 65536 + 67584);
    bf16* Z = (bf16*)(a.ws + WS_Z);
    const int tid = F.tid, lane = F.lane, wave = F.wave;
    const bool sample = item >= MP / 128;
    const int row0 = item * 128;
    const bf16* Wm = (const bf16*)(a.ws + (sample ? WS_WSS : WS_WSM));
    const int cchunk = tid & 15, qg = tid >> 4;
    const int db = wave & 3, pb0 = (wave >> 2) * 2, hi = lane >> 5, l31 = lane & 31;
    v4u gvr[4], wmr[4];
#define P2B_ISSUE(g) do { _Pragma("unroll") for (int r = 0; r < 4; ++r) { gvr[r] = *(const GAS v4u*)(Z + (size_t)(row0 + qg * 4 + r) * DIN + 3072 + (g) * 128 + cchunk * 8); \
        wmr[r] = *(const GAS v4u*)(Wm + (size_t)(g) * 16384 + (size_t)(tid + 512 * r) * 8); } } while (0)
    P2B_ISSUE(g_lo);
    __syncthreads();
    for (int r4 = 0; r4 < 4; ++r4) { v4u w0[4], w1[4];
#pragma unroll
        for (int r = 0; r < 4; ++r) { const bf16* zp = Z + (size_t)(row0 + wave * 16 + r4 * 4 + r) * DIN + 3072; w0[r] = *(const GAS v4u*)(zp + lane * 8); w1[r] = *(const GAS v4u*)(zp + 512 + lane * 8); }
#pragma unroll
        for (int r = 0; r < 4; ++r) { float v[16]; v[0] = bflo(w0[r].x); v[1] = bfhi(w0[r].x); v[2] = bflo(w0[r].y); v[3] = bfhi(w0[r].y); v[4] = bflo(w0[r].z); v[5] = bfhi(w0[r].z); v[6] = bflo(w0[r].w); v[7] = bfhi(w0[r].w);
            v[8] = bflo(w1[r].x); v[9] = bfhi(w1[r].x); v[10] = bflo(w1[r].y); v[11] = bfhi(w1[r].y); v[12] = bflo(w1[r].z); v[13] = bfhi(w1[r].z); v[14] = bflo(w1[r].w); v[15] = bfhi(w1[r].w);
            float s = 0.f;
#pragma unroll
            for (int e = 0; e < 16; ++e) s += v[e];
            const float mean = wave_sum(s) * (1.f / 1024.f); float s2 = 0.f;
#pragma unroll
            for (int e = 0; e < 16; ++e) { const float d = v[e] - mean; s2 += d * d; }
            const float rstd = 1.0f / sqrtf(wave_sum(s2) * (1.f / 1024.f) + EPS);
            if (lane == 0) { const int q = wave * 16 + r4 * 4 + r; ST[q * 2] = mean; ST[q * 2 + 1] = rstd; } } }
    __syncthreads();
    for (int g = g_lo; g < g_hi; ++g) {
        { const int d0 = cchunk * 8, col = g * 128 + d0;
          const f32x4 g0 = *(const GAS f32x4*)(a.in[I_LNG] + col), g1 = *(const GAS f32x4*)(a.in[I_LNG] + col + 4), b0 = *(const GAS f32x4*)(a.in[I_LNB] + col), b1 = *(const GAS f32x4*)(a.in[I_LNB] + col + 4);
          const float lg[8] = {g0.x, g0.y, g0.z, g0.w, g1.x, g1.y, g1.z, g1.w}, lb[8] = {b0.x, b0.y, b0.z, b0.w, b1.x, b1.y, b1.z, b1.w};
          float vn[4][8];
#pragma unroll
          for (int r = 0; r < 4; ++r) { const int q = qg * 4 + r; const v4u w = gvr[r];
              const float mean = ST[q * 2], rstd = ST[q * 2 + 1];
              const float x[8] = {bflo(w.x), bfhi(w.x), bflo(w.y), bfhi(w.y), bflo(w.z), bfhi(w.z), bflo(w.w), bfhi(w.w)};
#pragma unroll
              for (int e = 0; e < 8; ++e) vn[r][e] = (x[e] - mean) * rstd * lg[e] + lb[e];
              if (sample) { float* ov = a.out + O_VS + (size_t)(row0 - MP + q) * DM + col;
                  *(GAS f32x4*)ov = (f32x4){vn[r][0], vn[r][1], vn[r][2], vn[r][3]}; *(GAS f32x4*)(ov + 4) = (f32x4){vn[r][4], vn[r][5], vn[r][6], vn[r][7]}; } }
#pragma unroll
          for (int e = 0; e < 8; ++e) { v2u o; o.x = pk2(vn[0][e], vn[1][e]); o.y = pk2(vn[2][e], vn[3][e]); *(LAS v2u*)(VT + vt_off(d0 + e, qg * 4)) = o; }
#pragma unroll
          for (int r = 0; r < 4; ++r) { const int ch = tid + 512 * r; *(LAS v4u*)(WM + vt_off(ch >> 4, (ch & 15) * 8)) = wmr[r]; } }
        v4u gur[4];
#pragma unroll
        for (int r = 0; r < 4; ++r) { const int ch = tid + 512 * r; gur[r] = *(const GAS v4u*)(Z + (size_t)(row0 + (ch >> 4)) * DIN + 2048 + g * 128 + (ch & 15) * 8); }
        if (g + 1 < g_hi) P2B_ISSUE(g + 1);
        __syncthreads();
        { f32x16 acc[2];
#pragma unroll
          for (int i = 0; i < 16; ++i) { acc[0][i] = 0.f; acc[1][i] = 0.f; }
          const int kmax = (!sample && pb0 == 0) ? 4 : 8;
          const int d = db * 32 + l31;
          for (int ks = 0; ks < kmax; ++ks) { const bf16x8 A = *(const LAS bf16x8*)(VT + vt_off(d, ks * 16 + hi * 8));
#pragma unroll
              for (int pi = 0; pi < 2; ++pi) { const bf16x8 B = *(const LAS bf16x8*)(WM + vt_off((pb0 + pi) * 32 + l31, ks * 16 + hi * 8));
                  acc[pi] = __builtin_amdgcn_mfma_f32_32x32x16_bf16(A, B, acc[pi], 0, 0, 0); } }
#pragma unroll
          for (int pi = 0; pi < 2; ++pi) { const int p = (pb0 + pi) * 32 + l31; const float bs = a.in[I_BS][g * 128 + (sample ? (p & 31) : p)];
#pragma unroll
              for (int rq = 0; rq < 4; ++rq) *(LAS f32x4*)(SG + p * 132 + db * 32 + 8 * rq + 4 * hi) = (f32x4){acc[pi][rq * 4 + 0] + bs, acc[pi][rq * 4 + 1] + bs, acc[pi][rq * 4 + 2] + bs, acc[pi][rq * 4 + 3] + bs}; } }
        __syncthreads();
#pragma unroll
        for (int r = 0; r < 4; ++r) { const int ch = tid + 512 * r, p = ch >> 4, c8 = (ch & 15) * 8;
            const f32x4 s0 = *(const LAS f32x4*)(SG + p * 132 + c8), s1 = *(const LAS f32x4*)(SG + p * 132 + c8 + 4); const v4u w = gur[r];
            v4u o; o.x = pk2(s0.x * bflo(w.x), s0.y * bfhi(w.x)); o.y = pk2(s0.z * bflo(w.y), s0.w * bfhi(w.y)); o.z = pk2(s1.x * bflo(w.z), s1.y * bfhi(w.z)); o.w = pk2(s1.z * bflo(w.w), s1.w * bfhi(w.w));
            *(GAS v4u*)(Z + (size_t)(row0 + p) * DIN + 2048 + g * 128 + c8) = o; }
    }
#undef P2B_ISSUE
}

__device__ __forceinline__ void p5_rows(Frame& F, const Args& a) {
    const int gw = F.vcu * NWAVES + F.wave, NGW = F.G * NWAVES, lane = F.lane;
    const bf16* MIX = (const bf16*)(a.ws + WS_MIX); bf16* HN = (bf16*)(a.ws + WS_XN);
    f32x4 g1[4], g2[4];
#pragma unroll
    for (int j = 0; j < 4; ++j) { g1[j] = ((const GAS f32x4*)a.in[I_GPOST])[lane + 64 * j]; g2[j] = ((const GAS f32x4*)a.in[I_GFFN])[lane + 64 * j]; }
    for (int m = gw; m < M; m += NGW) { const GAS f32x4* xr = (const GAS f32x4*)xrow_ptr(a, m) + lane; const GAS v2u* mr = (const GAS v2u*)(MIX + (size_t)m * DM) + lane;
        f32x4 x[4], mx[4]; float s = 0.f;
#pragma unroll
        for (int j = 0; j < 4; ++j) { x[j] = xr[64 * j]; const v2u w = mr[64 * j]; mx[j] = (f32x4){bflo(w.x), bfhi(w.x), bflo(w.y), bfhi(w.y)};
            s += (mx[j].x * mx[j].x + mx[j].y * mx[j].y) + (mx[j].z * mx[j].z + mx[j].w * mx[j].w); }
        const float r1 = 1.0f / sqrtf(wave_sum(s) * (1.f / DM) + EPS); float s2 = 0.f;
#pragma unroll
        for (int j = 0; j < 4; ++j) { x[j] = x[j] + mx[j] * r1 * g1[j]; s2 += (x[j].x * x[j].x + x[j].y * x[j].y) + (x[j].z * x[j].z + x[j].w * x[j].w); }
        const float r2 = 1.0f / sqrtf(wave_sum(s2) * (1.f / DM) + EPS);
        GAS v2u* o8 = (GAS v2u*)(HN + (size_t)m * DM) + lane;
#pragma unroll
        for (int j = 0; j < 4; ++j) { const f32x4 h = x[j] * r2 * g2[j]; v2u o; o.x = pk2(h.x, h.y); o.y = pk2(h.z, h.w); o8[64 * j] = o; } }
}
__device__ __forceinline__ void p8_rows(Frame& F, const Args& a) {
    const int gw = F.vcu * NWAVES + F.wave, NGW = F.G * NWAVES, lane = F.lane;
    const bf16* MIX = (const bf16*)(a.ws + WS_MIX); const bf16* FF = (const bf16*)(a.ws + WS_F);
    f32x4 g1[4], g3[4];
#pragma unroll
    for (int j = 0; j < 4; ++j) { g1[j] = ((const GAS f32x4*)a.in[I_GPOST])[lane + 64 * j]; g3[j] = ((const GAS f32x4*)a.in[I_GPF])[lane + 64 * j]; }
    for (int m = gw; m < M; m += NGW) { const GAS f32x4* xr = (const GAS f32x4*)xrow_ptr(a, m) + lane; const GAS v2u* mr = (const GAS v2u*)(MIX + (size_t)m * DM) + lane; const GAS v2u* fr = (const GAS v2u*)(FF + (size_t)m * DM) + lane;
        f32x4 x[4], mx[4], fx[4]; float s = 0.f, sf = 0.f;
#pragma unroll
        for (int j = 0; j < 4; ++j) { x[j] = xr[64 * j]; const v2u w = mr[64 * j]; mx[j] = (f32x4){bflo(w.x), bfhi(w.x), bflo(w.y), bfhi(w.y)}; const v2u wf = fr[64 * j]; fx[j] = (f32x4){bflo(wf.x), bfhi(wf.x), bflo(wf.y), bfhi(wf.y)};
            s += (mx[j].x * mx[j].x + mx[j].y * mx[j].y) + (mx[j].z * mx[j].z + mx[j].w * mx[j].w); sf += (fx[j].x * fx[j].x + fx[j].y * fx[j].y) + (fx[j].z * fx[j].z + fx[j].w * fx[j].w); }
        const float r1 = 1.0f / sqrtf(wave_sum(s) * (1.f / DM) + EPS), r3 = 1.0f / sqrtf(wave_sum(sf) * (1.f / DM) + EPS);
        GAS f32x4* o = (GAS f32x4*)(a.out + O_Y + (size_t)m * DM) + lane;
#pragma unroll
        for (int j = 0; j < 4; ++j) o[64 * j] = x[j] + mx[j] * r1 * g1[j] + fx[j] * r3 * g3[j]; }
}

template <int MODE, int NSTEPS>
__device__ __forceinline__ void small_gemm(Frame& F, const bf16* A, int lda, const bf16* Bt, int ldb, int K, int ntn, bf16* O, int ldo, const bf16* Zg) {
    LAS float* RED = (LAS float*)F.lds;
    const int tid = F.tid, lane = F.lane, wave = F.wave, hi = lane >> 5, l31 = lane & 31;
    const int KS = NSTEPS * 16; (void)K;
    const int ntasks = 8 * ntn;
    for (int task = blockIdx.x; task < ntasks; task += F.G) {
        const int mt = task & 7, nt = task >> 3;
        const int r0 = MP + mt * 64;
        int br0, br1;
        if (MODE == 3) { const int j0 = nt * 32; br0 = 256 * (j0 >> 7) + (j0 & 127); br1 = br0 + 128; } else { br0 = nt * 64; br1 = br0 + 32; }
        const bf16* pa0 = A + (size_t)(r0 + l31) * lda + wave * KS + hi * 8; const bf16* pa1 = pa0 + (size_t)32 * lda;
        const bf16* pb0 = Bt + (size_t)(br0 + l31) * ldb + wave * KS + hi * 8; const bf16* pb1 = Bt + (size_t)(br1 + l31) * ldb + wave * KS + hi * 8;
        f32x16 acc[2][2];
#pragma unroll
        for (int i = 0; i < 16; ++i) { acc[0][0][i] = 0.f; acc[0][1][i] = 0.f; acc[1][0][i] = 0.f; acc[1][1][i] = 0.f; }
#define SG_BATCH(NS, KO) do { bf16x8 a0[NS], a1[NS], b0[NS], b1[NS]; \
            _Pragma("unroll") for (int s = 0; s < (NS); ++s) { const int ko = (KO) + s * 16; \
                a0[s] = *(const GAS bf16x8*)(pa0 + ko); a1[s] = *(const GAS bf16x8*)(pa1 + ko); b0[s] = *(const GAS bf16x8*)(pb0 + ko); b1[s] = *(const GAS bf16x8*)(pb1 + ko); } \
            _Pragma("unroll") for (int s = 0; s < (NS); ++s) { \
                acc[0][0] = __builtin_amdgcn_mfma_f32_32x32x16_bf16(a0[s], b0[s], acc[0][0], 0, 0, 0); acc[0][1] = __builtin_amdgcn_mfma_f32_32x32x16_bf16(a0[s], b1[s], acc[0][1], 0, 0, 0); \
                acc[1][0] = __builtin_amdgcn_mfma_f32_32x32x16_bf16(a1[s], b0[s], acc[1][0], 0, 0, 0); acc[1][1] = __builtin_amdgcn_mfma_f32_32x32x16_bf16(a1[s], b1[s], acc[1][1], 0, 0, 0); } } while (0)
        if (NSTEPS == 8) { SG_BATCH(8, 0); }
        else if (NSTEPS == 16) { SG_BATCH(8, 0); SG_BATCH(8, 128); }
        else { SG_BATCH(8, 0); SG_BATCH(8, 128); SG_BATCH(6, 256); }
#undef SG_BATCH
        __syncthreads();
#pragma unroll
        for (int i = 0; i < 2; ++i)
#pragma unroll
            for (int j = 0; j < 2; ++j)
#pragma unroll
                for (int rg = 0; rg < 16; ++rg) RED[wave * 4096 + (i * 32 + (rg & 3) + 8 * (rg >> 2) + 4 * hi) * 64 + j * 32 + l31] = acc[i][j][rg];
        __syncthreads();
        if (MODE == 3) { const int row = tid >> 3, q = tid & 7; f32x4 g = (f32x4){0.f, 0.f, 0.f, 0.f}, u = g;
#pragma unroll
            for (int w = 0; w < 8; ++w) { g += *(const LAS f32x4*)(RED + w * 4096 + row * 64 + q * 4); u += *(const LAS f32x4*)(RED + w * 4096 + row * 64 + 32 + q * 4); }
            v2u o; o.x = pk2(pg8::silu_f(g.x) * u.x, pg8::silu_f(g.y) * u.y); o.y = pk2(pg8::silu_f(g.z) * u.z, pg8::silu_f(g.w) * u.w);
            *(GAS v2u*)(O + (size_t)(r0 + row) * ldo + nt * 32 + q * 4) = o;
        } else { const int row = tid >> 3, c8 = (tid & 7) * 8, col = nt * 64 + c8; float v[8];
            if (MODE == 1) { f32x4 a0 = (f32x4){0.f, 0.f, 0.f, 0.f}, a1 = a0, b0 = a0, b1 = a0;
#pragma unroll
                for (int w = 0; w < 4; ++w) { a0 += *(const LAS f32x4*)(RED + w * 4096 + row * 64 + c8); a1 += *(const LAS f32x4*)(RED + w * 4096 + row * 64 + c8 + 4);
                    b0 += *(const LAS f32x4*)(RED + (w + 4) * 4096 + row * 64 + c8); b1 += *(const LAS f32x4*)(RED + (w + 4) * 4096 + row * 64 + c8 + 4); }
                const v4u ga = *(const GAS v4u*)(Zg + (size_t)(r0 + row) * DIN + col), gb = *(const GAS v4u*)(Zg + (size_t)(r0 + row) * DIN + 1024 + col);
                v[0] = bflo(ga.x) * a0.x + bflo(gb.x) * b0.x; v[1] = bfhi(ga.x) * a0.y + bfhi(gb.x) * b0.y; v[2] = bflo(ga.y) * a0.z + bflo(gb.y) * b0.z; v[3] = bfhi(ga.y) * a0.w + bfhi(gb.y) * b0.w;
                v[4] = bflo(ga.z) * a1.x + bflo(gb.z) * b1.x; v[5] = bfhi(ga.z) * a1.y + bfhi(gb.z) * b1.y; v[6] = bflo(ga.w) * a1.z + bflo(gb.w) * b1.z; v[7] = bfhi(ga.w) * a1.w + bfhi(gb.w) * b1.w;
            } else { f32x4 s0 = (f32x4){0.f, 0.f, 0.f, 0.f}, s1 = s0;
#pragma unroll
                for (int w = 0; w < 8; ++w) { s0 += *(const LAS f32x4*)(RED + w * 4096 + row * 64 + c8); s1 += *(const LAS f32x4*)(RED + w * 4096 + row * 64 + c8 + 4); }
                v[0] = s0.x; v[1] = s0.y; v[2] = s0.z; v[3] = s0.w; v[4] = s1.x; v[5] = s1.y; v[6] = s1.z; v[7] = s1.w;
                if (MODE == 0) { const int pn = col >> 8;
                    if (pn >= 4 && pn < 16) {
#pragma unroll
                        for (int e = 0; e < 8; ++e) v[e] = pg8::gelu_tanh_f(v[e]); }
                    else if (pn >= 16) {
#pragma unroll
                        for (int e = 0; e < 8; ++e) v[e] = pg8::sigmoid_f(v[e]); } } }
            v4u o; o.x = pk2(v[0], v[1]); o.y = pk2(v[2], v[3]); o.z = pk2(v[4], v[5]); o.w = pk2(v[6], v[7]);
            *(GAS v4u*)(O + (size_t)(r0 + row) * ldo + col) = o; }
    }
    __syncthreads();
}

__global__ void __launch_bounds__(NWAVES * 64, 2) hawk_fwd(Args args) {
    extern __shared__ __attribute__((aligned(16))) unsigned char lds[];
    Frame F;
    F.lds = (LAS unsigned char*)lds;
    F.MISC = (volatile LAS unsigned*)(F.lds + MISC_OFF);
    F.tid = threadIdx.x; F.lane = F.tid & 63; F.wave = __builtin_amdgcn_readfirstlane(F.tid >> 6);
    F.G = gridDim.x; { const int bx = blockIdx.x; F.vcu = (F.G % 8 == 0) ? (bx % 8) * (F.G / 8) + bx / 8 : bx; }
    unsigned char* ws = args.ws;
    F.ctl = (gu32*)(ws + WS_CTL);
    for (int u = F.tid; u < (LDS_BYTES - LDSCTL_OFF) / 4; u += NWAVES * 64) ((LAS unsigned*)(F.lds + LDSCTL_OFF))[u] = 0u;
    __syncthreads();
    XcdBarrier bar; bar.bar = (unsigned*)(F.ctl + CW_BAR); bar.x = 0; bar.st = nullptr;
    if (N_LAUNCHES != PER_PHASE) bar = xcd_barrier_post((unsigned*)(F.ctl + CW_BAR), F.MISC + 8);
#define GRID_BAR() do { if (N_LAUNCHES != PER_PHASE) xcd_barrier(bar); } while (0)
    volatile LAS unsigned long long* tsb = (volatile LAS unsigned long long*)(F.lds + LDSCTL_OFF + 1024);
#define TS(i) do { if (PROBE_TA >= 0 && blockIdx.x == 0 && F.tid == 0) tsb[i] = __builtin_amdgcn_s_memrealtime(); } while (0)
    TS(63);
    const int lo = args.ph_lo, hi = args.ph_hi;
#define IN(k) (lo <= (k) && (k) < hi)
#define BOTH(k) (IN(k) && IN((k) + 1))
    bf16* XN = (bf16*)(ws + WS_XN); bf16* Z = (bf16*)(ws + WS_Z);

#define PH0() do { p0_prologue(F, args); } while (0)
#define PH1() do { pg8::Gemm g{XN, (const bf16*)(ws + WS_W1), DM, DM, DM}; pg8::StaticOrder S; S.init(M, DIN, F.G, (int)blockIdx.x); pg8::EpiZ E{Z, DIN}; \
        pg8::gemm_phase<pg8::EpiZ, pg8::StaticOrder, PG8_ALIGN, PG8_SP2>(F.lds + RING_OFF, g, S, E); } while (0)
#define PH3() do { pg8::Gemm g{Z + 1024, (const bf16*)(ws + WS_W2), DIN, 2048, 2048}; pg8::StaticOrder S; S.init(MP, DM, F.G, (int)blockIdx.x); pg8::EpiGate E{Z + 4096, DIN, XN, DM}; \
        pg8::gemm_phase<pg8::EpiGate, pg8::StaticOrder, PG8_ALIGN, PG8_SP2>(F.lds + RING_OFF, g, S, E); \
        small_gemm<1, 16>(F, Z + 1024, DIN, (const bf16*)(ws + WS_W2), 2048, 2048, DM / 64, XN, DM, Z + 4096); } while (0)
#define PH4() do { pg8::Gemm g{XN, (const bf16*)(ws + WS_W3), DM, DM, DM}; pg8::StaticOrder S; S.init(MP, DM, F.G, (int)blockIdx.x); pg8::EpiBf16 E{(bf16*)(ws + WS_MIX), DM}; \
        pg8::gemm_phase<pg8::EpiBf16, pg8::StaticOrder, PG8_ALIGN, PG8_SP2>(F.lds + RING_OFF, g, S, E); \
        small_gemm<2, 8>(F, XN, DM, (const bf16*)(ws + WS_W3), DM, DM, DM / 64, (bf16*)(ws + WS_MIX), DM, nullptr); } while (0)
#define PH5() do { p5_rows(F, args); } while (0)
#define PH6() do { pg8::Gemm g{XN, (const bf16*)(ws + WS_W4), DM, DM, DM}; pg8::StaticOrder S; S.init(M, DFF2, F.G, (int)blockIdx.x); pg8::EpiSwiGLU E{(bf16*)(ws + WS_FIN), DFF}; \
        pg8::gemm_phase<pg8::EpiSwiGLU, pg8::StaticOrder, PG8_ALIGN, PG8_SP2>(F.lds + RING_OFF, g, S, E); } while (0)
#define PH7() do { pg8::Gemm g{(const bf16*)(ws + WS_FIN), (const bf16*)(ws + WS_W5), DFF, DFF, DFF}; pg8::StaticOrder S; S.init(MP, DM, F.G, (int)blockIdx.x); pg8::EpiBf16 E{(bf16*)(ws + WS_F), DM}; \
        pg8::gemm_phase<pg8::EpiBf16, pg8::StaticOrder, PG8_ALIGN, PG8_SP2>(F.lds + RING_OFF, g, S, E); \
        small_gemm<2, 22>(F, (const bf16*)(ws + WS_FIN), DFF, (const bf16*)(ws + WS_W5), DFF, DFF, DM / 64, (bf16*)(ws + WS_F), DM, nullptr); } while (0)
#define PH8() do { p8_rows(F, args); } while (0)
#define RUN(k, PH) do { if (IN(k)) { PH(); if (PROBE_DOUBLE == (k)) { GRID_BAR(); PH(); } TS(2 * (k)); if (BOTH(k)) GRID_BAR(); TS(2 * (k) + 1); } } while (0)
    RUN(0, PH0);
    RUN(1, PH1);
    if (IN(2)) {
        for (int it = blockIdx.x; it < 2 * NB * 16; it += F.G) {
            if (it < NB * 16) { const int b = it >> 4, hd = it & 15;
                p2a_item(F, args, b * SEQ, SEQ, hd, nullptr, nullptr, args.out + O_HP + (size_t)b * DM, args.out + O_CP + (size_t)b * 3 * DM); }
            else { const int b = (it - NB * 16) >> 4, hd = it & 15;
                p2a_item(F, args, MP + b * DEC_T, DEC_T, hd, args.in[I_SH] + (size_t)b * DM, args.in[I_SC] + (size_t)b * 3 * DM, args.out + O_HS + (size_t)b * DM, args.out + O_CS + (size_t)b * 3 * DM); }
        }
        TS(40);
        for (int it = blockIdx.x; it < MP / 128; it += F.G) p2b_item(F, args, it, 0, 8);
        for (int it = blockIdx.x; it < 32; it += F.G) p2b_item(F, args, MP / 128 + (it >> 3), it & 7, (it & 7) + 1);
        TS(4);
        if (BOTH(2)) GRID_BAR();
        TS(5);
    }
    RUN(3, PH3);
    RUN(4, PH4);
    RUN(5, PH5);
    RUN(6, PH6);
    RUN(7, PH7);
    RUN(8, PH8);
    if (PROBE_TA >= 0 && blockIdx.x == 0 && F.tid == 0) { const unsigned long long d = (tsb[PROBE_TB] - tsb[PROBE_TA]) * PROBE_MULT, t0 = __builtin_amdgcn_s_memrealtime();
        while (__builtin_amdgcn_s_memrealtime() - t0 < d) __builtin_amdgcn_s_sleep(16); }
#undef IN
#undef BOTH
#undef GRID_BAR
}

extern "C" void kernel_launch(void* const* d_in, const int* in_sizes, int n_in, void* d_out, int out_size, void* d_ws, size_t ws_size, hipStream_t stream) {
    static int grid = 0;
    if (grid == 0) {
        if (n_in != N_IN || in_sizes[0] != MP * DM || (size_t)out_size != O_END || ws_size < WS_END) {
            fprintf(stderr, "kernel_launch: shape mismatch (n_in %d, in0 %d, out %d, ws %zu; need ws >= %zu); nothing launched\n", n_in, n_in > 0 ? in_sizes[0] : -1, out_size, ws_size, (size_t)WS_END); grid = -1; return; }
        int dev = 0, cus = 0, per_cu = 0;
        if (hipGetDevice(&dev) != hipSuccess || hipDeviceGetAttribute(&cus, hipDeviceAttributeMultiprocessorCount, dev) != hipSuccess) { fprintf(stderr, "kernel_launch: device query failed\n"); grid = -1; return; }
        if (hipFuncSetAttribute((const void*)hawk_fwd, hipFuncAttributeMaxDynamicSharedMemorySize, LDS_BYTES) != hipSuccess) { fprintf(stderr, "kernel_launch: hipFuncSetAttribute failed\n"); grid = -1; return; }
        if (hipOccupancyMaxActiveBlocksPerMultiprocessor(&per_cu, (const void*)hawk_fwd, NWAVES * 64, LDS_BYTES) != hipSuccess || per_cu < 1) {
            fprintf(stderr, "kernel_launch: occupancy query reports %d workgroups per CU; nothing launched\n", per_cu); (void)hipGetLastError(); grid = -1; return; }
        grid = cus;
    }
    if (grid < 0) return;
    if (hipMemsetAsync((char*)d_ws + WS_CTL, 0, CTL_ZERO_BYTES, stream) != hipSuccess) { fprintf(stderr, "kernel_launch: memset failed\n"); return; }
    Args a{};
    for (int i = 0; i < N_IN; ++i) a.in[i] = (const float*)d_in[i];
    a.out = (float*)d_out; a.ws = (unsigned char*)d_ws;
    for (int li = 0; li < N_LAUNCHES; ++li) {
        a.ph_lo = (N_LAUNCHES == PER_PHASE) ? li : 0; a.ph_hi = (N_LAUNCHES == PER_PHASE) ? li + 1 : PER_PHASE; a.li = li;
        hipLaunchKernelGGL(hawk_fwd, dim3(grid), dim3(NWAVES * 64), LDS_BYTES, stream, a);
        const hipError_t le = hipPeekAtLastError();
        if (le != hipSuccess) { fprintf(stderr, "kernel_launch: launch %d failed: %s\n", li, hipGetErrorName(le)); break; }
    }
}
```

```cpp
#include <hip/hip_runtime.h>
#include <cstdio>
#include <cstdint>

#ifndef MK_N_LAUNCHES
#define MK_N_LAUNCHES 1
#endif
#ifndef PROBE_TA
#define PROBE_TA -1
#define PROBE_TB -1
#endif
#define PROBE_MULT 4
#ifndef PROBE_DOUBLE
#define PROBE_DOUBLE -1
#endif

namespace pg8 {
#define PG8_LAS __attribute__((address_space(3)))
typedef unsigned short bf16_t;
typedef short bf16x8 __attribute__((ext_vector_type(8)));
typedef float f32x4 __attribute__((ext_vector_type(4)));
typedef unsigned u32x4 __attribute__((ext_vector_type(4)));
constexpr int BM = 256, BK = 64, HALF = 128, HTB = HALF * BK * 2  , STAGE_BYTES = 8 * HTB, NXCD = 8, WGM = 8;

__host__ __device__ __forceinline__ int lds_byte(int r, int c) { const int st = (r >> 4) * 2 + (c >> 5), rr = r & 15, cc = c & 31, ob = rr * 64 + cc * 2; return st * 1024 + (ob ^ (((ob >> 9) & 1) << 5)); }
__host__ __device__ __forceinline__ void stage_rc(int b, int& R, int& C) { const int st = b / 1024, sb = b % 1024, swz = sb ^ (((sb >> 9) & 1) << 5); R = (st >> 1) * 16 + swz / 64; C = (st & 1) * 32 + (swz % 64) / 2; }
__host__ __device__ __forceinline__ int perm32(int rho) { const int n = rho >> 4, i = rho & 15; return 8 * (i >> 2) + 4 * n + (i & 3); }

struct Unit { int pm, pn; };
struct Gemm { const bf16_t* A; const bf16_t* Bt; int lda, ldb, K; };

struct StaticOrder {
    int nM, nN, nwg, G, c;
    __host__ __device__ void init(int M, int N, int G_, int c_) { nM = M / BM; nN = N / BM; nwg = nM * nN; G = G_; c = c_; }
    __host__ __device__ bool next(int i, Unit& u) const {
        const long L = (long)i * G + c; if (L >= nwg) return false;
        int wgid = (int)L; { const int q = nwg / NXCD, r = nwg % NXCD, xcd = wgid % NXCD, off = wgid / NXCD; wgid = (xcd < r ? xcd * (q + 1) : r * (q + 1) + (xcd - r) * q) + off; }
        const int nig = WGM * nN, gid = wgid / nig, fm = gid * WGM, gsz = (nM - fm) < WGM ? (nM - fm) : WGM;
        u.pm = fm + ((wgid % nig) % gsz); u.pn = (wgid % nig) / gsz; return true;
    }
    __device__ __forceinline__ void a_ready(const Unit&) const {}
    __device__ __forceinline__ void done(const Unit&) const {}
};

__device__ __forceinline__ unsigned cvt_pk_bf16(float lo, float hi) { unsigned r; asm volatile("v_cvt_pk_bf16_f32 %0, %1, %2" : "=v"(r) : "v"(lo), "v"(hi)); return r; }
__device__ __forceinline__ float bf_lo(unsigned w) { return __uint_as_float(w << 16); }
__device__ __forceinline__ float bf_hi(unsigned w) { return __uint_as_float(w & 0xffff0000u); }
__device__ __forceinline__ float sigmoid_f(float x) { return __builtin_amdgcn_rcpf(1.0f + __builtin_amdgcn_exp2f(-1.4426950408889634f * x)); }
__device__ __forceinline__ float gelu_tanh_f(float x) { const float t = x * (-2.3022081986f + -0.1029432446f * x * x); return x * __builtin_amdgcn_rcpf(1.0f + __builtin_amdgcn_exp2f(t)); }
__device__ __forceinline__ float silu_f(float x) { return x * sigmoid_f(x); }

struct EpiZ {
    static constexpr bool PERM = true, AFTER_DRAIN = false, HAS_MID = false; static constexpr int TMID = -1;
    bf16_t* Z; int ldc; float* stat;
    __device__ __forceinline__ void mid(f32x4 (&)[2][2][4][2], const Unit&, int, int, int, int) const {}
    __device__ __forceinline__ void operator()(const f32x4 (&acc)[2][2][4][2], const Unit& u, int wr, int wc, int fr, int fq) const {
        int row0 = u.pm * BM + wr * 64 + fr; const int col0 = u.pn * BM + wc * 32 + 8 * fq; asm volatile("" : "+v"(row0));
        const int mode = u.pn < 4 ? 0 : (u.pn < 16 ? 1 : 2);
        const bool vstat = (u.pn >= 12 && u.pn < 16);
#pragma unroll
        for (int ai = 0; ai < 2; ++ai)
#pragma unroll
            for (int m = 0; m < 4; ++m) { bf16_t* rowp = Z + (size_t)(row0 + ai * HALF + m * 16) * ldc + col0; float ssum = 0.f, ssq = 0.f;
#pragma unroll
                for (int bj = 0; bj < 2; ++bj) { f32x4 v0 = acc[ai][bj][m][0], v1 = acc[ai][bj][m][1];
                    if (mode == 1) {
#pragma unroll
                        for (int j = 0; j < 4; ++j) { v0[j] = gelu_tanh_f(v0[j]); v1[j] = gelu_tanh_f(v1[j]); } }
                    else if (mode == 2) {
#pragma unroll
                        for (int j = 0; j < 4; ++j) { v0[j] = sigmoid_f(v0[j]); v1[j] = sigmoid_f(v1[j]); } }
                    if (vstat) {
#pragma unroll
                        for (int j = 0; j < 4; ++j) { ssum += v0[j] + v1[j]; ssq += v0[j] * v0[j] + v1[j] * v1[j]; } }
                    u32x4 w; w.x = cvt_pk_bf16(v0[0], v0[1]); w.y = cvt_pk_bf16(v0[2], v0[3]); w.z = cvt_pk_bf16(v1[0], v1[1]); w.w = cvt_pk_bf16(v1[2], v1[3]);
                    *(u32x4*)(rowp + bj * HALF) = w; }
                if (vstat) { ssum += __shfl_xor(ssum, 16); ssq += __shfl_xor(ssq, 16); ssum += __shfl_xor(ssum, 32); ssq += __shfl_xor(ssq, 32);
                    if (fq == 0) { typedef float f32x2 __attribute__((ext_vector_type(2))); *(f32x2*)(stat + ((size_t)(row0 + ai * HALF + m * 16) * 16 + (u.pn - 12) * 4 + wc) * 2) = (f32x2){ssum, ssq}; } } }
    }
};
struct EpiBf16 {
    static constexpr bool PERM = true, AFTER_DRAIN = false, HAS_MID = false; static constexpr int TMID = -1;
    bf16_t* O; int ldc;
    __device__ __forceinline__ void mid(f32x4 (&)[2][2][4][2], const Unit&, int, int, int, int) const {}
    __device__ __forceinline__ void operator()(const f32x4 (&acc)[2][2][4][2], const Unit& u, int wr, int wc, int fr, int fq) const {
        int row0 = u.pm * BM + wr * 64 + fr; const int col0 = u.pn * BM + wc * 32 + 8 * fq; asm volatile("" : "+v"(row0));
#pragma unroll
        for (int ai = 0; ai < 2; ++ai)
#pragma unroll
            for (int m = 0; m < 4; ++m) { bf16_t* rowp = O + (size_t)(row0 + ai * HALF + m * 16) * ldc + col0;
#pragma unroll
                for (int bj = 0; bj < 2; ++bj) { const f32x4 v0 = acc[ai][bj][m][0], v1 = acc[ai][bj][m][1];
                    u32x4 w; w.x = cvt_pk_bf16(v0[0], v0[1]); w.y = cvt_pk_bf16(v0[2], v0[3]); w.z = cvt_pk_bf16(v1[0], v1[1]); w.w = cvt_pk_bf16(v1[2], v1[3]);
                    *(u32x4*)(rowp + bj * HALF) = w; } }
    }
};
struct EpiGate {
    static constexpr bool PERM = true, AFTER_DRAIN = false, HAS_MID = true; static constexpr int TMID = 16;
    const bf16_t* Zg; int ldz;
    bf16_t* O; int ldc;
    __device__ __forceinline__ void mid(f32x4 (&acc)[2][2][4][2], const Unit& u, int wr, int wc, int fr, int fq) const {
        int row0 = u.pm * BM + wr * 64 + fr; const int col0 = u.pn * BM + wc * 32 + 8 * fq; asm volatile("" : "+v"(row0));
#pragma unroll
        for (int ai = 0; ai < 2; ++ai)
#pragma unroll
            for (int m = 0; m < 4; ++m) { const bf16_t* rowp = Zg + (size_t)(row0 + ai * HALF + m * 16) * ldz + col0;
#pragma unroll
                for (int bj = 0; bj < 2; ++bj) { const u32x4 ga = *(const u32x4*)(rowp + bj * HALF), gb = *(const u32x4*)(rowp + 1024 + bj * HALF);
                    f32x4 r0, r1;
                    r0[0] = bf_lo(ga.x) * __builtin_amdgcn_rcpf(fmaxf(bf_lo(gb.x), 1e-30f)); r0[1] = bf_hi(ga.x) * __builtin_amdgcn_rcpf(fmaxf(bf_hi(gb.x), 1e-30f));
                    r0[2] = bf_lo(ga.y) * __builtin_amdgcn_rcpf(fmaxf(bf_lo(gb.y), 1e-30f)); r0[3] = bf_hi(ga.y) * __builtin_amdgcn_rcpf(fmaxf(bf_hi(gb.y), 1e-30f));
                    r1[0] = bf_lo(ga.z) * __builtin_amdgcn_rcpf(fmaxf(bf_lo(gb.z), 1e-30f)); r1[1] = bf_hi(ga.z) * __builtin_amdgcn_rcpf(fmaxf(bf_hi(gb.z), 1e-30f));
                    r1[2] = bf_lo(ga.w) * __builtin_amdgcn_rcpf(fmaxf(bf_lo(gb.w), 1e-30f)); r1[3] = bf_hi(ga.w) * __builtin_amdgcn_rcpf(fmaxf(bf_hi(gb.w), 1e-30f));
                    acc[ai][bj][m][0] *= r0; acc[ai][bj][m][1] *= r1; } }
    }
    __device__ __forceinline__ void operator()(const f32x4 (&acc)[2][2][4][2], const Unit& u, int wr, int wc, int fr, int fq) const {
        int row0 = u.pm * BM + wr * 64 + fr; const int col0 = u.pn * BM + wc * 32 + 8 * fq; asm volatile("" : "+v"(row0));
#pragma unroll
        for (int ai = 0; ai < 2; ++ai)
#pragma unroll
            for (int m = 0; m < 4; ++m) { const size_t r = (size_t)(row0 + ai * HALF + m * 16);
#pragma unroll
                for (int bj = 0; bj < 2; ++bj) { const u32x4 gb = *(const u32x4*)(Zg + r * ldz + col0 + 1024 + bj * HALF);
                    f32x4 v0 = acc[ai][bj][m][0], v1 = acc[ai][bj][m][1];
                    v0[0] *= fmaxf(bf_lo(gb.x), 1e-30f); v0[1] *= fmaxf(bf_hi(gb.x), 1e-30f); v0[2] *= fmaxf(bf_lo(gb.y), 1e-30f); v0[3] *= fmaxf(bf_hi(gb.y), 1e-30f);
                    v1[0] *= fmaxf(bf_lo(gb.z), 1e-30f); v1[1] *= fmaxf(bf_hi(gb.z), 1e-30f); v1[2] *= fmaxf(bf_lo(gb.w), 1e-30f); v1[3] *= fmaxf(bf_hi(gb.w), 1e-30f);
                    u32x4 w; w.x = cvt_pk_bf16(v0[0], v0[1]); w.y = cvt_pk_bf16(v0[2], v0[3]); w.z = cvt_pk_bf16(v1[0], v1[1]); w.w = cvt_pk_bf16(v1[2], v1[3]);
                    *(u32x4*)(O + r * ldc + col0 + bj * HALF) = w; } }
    }
};
struct EpiSwiGLU {
    static constexpr bool PERM = true, AFTER_DRAIN = false, HAS_MID = false; static constexpr int TMID = -1;
    bf16_t* O; int ldc;
    __device__ __forceinline__ void mid(f32x4 (&)[2][2][4][2], const Unit&, int, int, int, int) const {}
    __device__ __forceinline__ void operator()(const f32x4 (&acc)[2][2][4][2], const Unit& u, int wr, int wc, int fr, int fq) const {
        int row0 = u.pm * BM + wr * 64 + fr; const int col0 = u.pn * HALF + wc * 32 + 8 * fq; asm volatile("" : "+v"(row0));
#pragma unroll
        for (int ai = 0; ai < 2; ++ai)
#pragma unroll
            for (int m = 0; m < 4; ++m) { bf16_t* rowp = O + (size_t)(row0 + ai * HALF + m * 16) * ldc + col0;
                f32x4 v0, v1;
#pragma unroll
                for (int j = 0; j < 4; ++j) { v0[j] = silu_f(acc[ai][0][m][0][j]) * acc[ai][1][m][0][j]; v1[j] = silu_f(acc[ai][0][m][1][j]) * acc[ai][1][m][1][j]; }
                u32x4 w; w.x = cvt_pk_bf16(v0[0], v0[1]); w.y = cvt_pk_bf16(v0[2], v0[3]); w.z = cvt_pk_bf16(v1[0], v1[1]); w.w = cvt_pk_bf16(v1[2], v1[3]);
                *(u32x4*)rowp = w; }
    }
};

template <class Epi, class Sched, bool ALIGN_EPI = false, bool SP2 = false>
__device__ __forceinline__ void gemm_phase(PG8_LAS unsigned char* lds, const Gemm g, const Sched& S, const Epi& E) {
    const int tid = threadIdx.x, wid = __builtin_amdgcn_readfirstlane(tid >> 6), lane = tid & 63, wr = wid >> 2, wc = wid & 3, fr = lane & 15, fq = lane >> 4;
    const int K = g.K, nt = K / BK;
    unsigned voffA[2], voffB[2];
#pragma unroll
    for (int i = 0; i < 2; ++i) { int R, C; stage_rc(tid * 16 + i * 8192, R, C); const int Rb = Epi::PERM ? ((R & ~31) + perm32(R & 31)) : R;
        voffA[i] = (unsigned)(R * g.lda + C) * 2u; voffB[i] = (unsigned)(Rb * g.ldb + C) * 2u; }
    const size_t kstep = (size_t)(BK * 2);
    const size_t hstepA = (size_t)HALF * g.lda * 2, hstepB = (size_t)HALF * g.ldb * 2;
    const size_t tstepA = 2 * hstepA, tstepB = 2 * hstepB;
    const unsigned ldsw = (unsigned)wid * 1024u;
    const int aoff = lds_byte(wr * 64 + fr, fq * 8), boff = lds_byte(wc * 32 + fr, fq * 8);
#define PG8_SA(b, h) (((b) * 2 + (h)) * HTB)
#define PG8_SB(b, h) ((4 + (b) * 2 + (h)) * HTB)
#define PG8_STAGE(bufoff, gbase, voff) do { _Pragma("unroll") for (int _i = 0; _i < 2; ++_i) \
        __builtin_amdgcn_global_load_lds((const unsigned*)((const char*)(gbase) + (voff)[_i]), (PG8_LAS unsigned*)(lds + (bufoff) + ldsw + _i * 8192), 16, 0, 0); } while (0)
#define PG8_LDA(dst, b, h) do { _Pragma("unroll") for (int m = 0; m < 4; ++m) _Pragma("unroll") for (int k = 0; k < 2; ++k) dst[m][k] = *(const PG8_LAS bf16x8*)(lds + PG8_SA(b, h) + aoff + m * 2048 + k * 1024); } while (0)
#define PG8_LDB(dst, b, h) do { _Pragma("unroll") for (int n = 0; n < 2; ++n) _Pragma("unroll") for (int k = 0; k < 2; ++k) dst[n][k] = *(const PG8_LAS bf16x8*)(lds + PG8_SB(b, h) + boff + n * 2048 + k * 1024); } while (0)
#define PG8_MMA(ai, bj, At, Bt) do { __builtin_amdgcn_s_setprio(1); _Pragma("unroll") for (int m = 0; m < 4; ++m) _Pragma("unroll") for (int n = 0; n < 2; ++n) _Pragma("unroll") for (int k = 0; k < 2; ++k) \
        acc[ai][bj][m][n] = __builtin_amdgcn_mfma_f32_16x16x32_bf16(Bt[n][k], At[m][k], acc[ai][bj][m][n], 0, 0, 0); __builtin_amdgcn_s_setprio(0); } while (0)
#define PG8_WAIT_V(n) asm volatile("s_waitcnt vmcnt(" #n ")" ::: "memory")
#define PG8_WAIT_L(n) asm volatile("s_waitcnt lgkmcnt(" #n ")" ::: "memory")
#define PG8_BAR __builtin_amdgcn_s_barrier()
#define PG8_SCHED __builtin_amdgcn_sched_barrier(0)
    Unit cur, nxt; int ui = 0;
    if (!S.next(0, cur)) return;
    f32x4 acc[2][2][4][2];
#pragma unroll
    for (int a = 0; a < 2; ++a)
#pragma unroll
        for (int b = 0; b < 2; ++b)
#pragma unroll
            for (int m = 0; m < 4; ++m)
#pragma unroll
                for (int n = 0; n < 2; ++n) acc[a][b][m][n] = (f32x4){0.f, 0.f, 0.f, 0.f};
    bf16x8 At[4][2], B0[2][2], B1[2][2];
    const char* cA = (const char*)g.A + (size_t)cur.pm * tstepA; const char* cB = (const char*)g.Bt + (size_t)cur.pn * tstepB;
    S.a_ready(cur);
    if constexpr (SP2) {
        PG8_STAGE(PG8_SB(0, 0), cB, voffB); PG8_STAGE(PG8_SB(0, 1), cB + hstepB, voffB); PG8_STAGE(PG8_SA(0, 0), cA, voffA); PG8_STAGE(PG8_SA(0, 1), cA + hstepA, voffA);
        if (wr == 1) PG8_BAR;
        PG8_WAIT_V(2); PG8_BAR;
        PG8_STAGE(PG8_SB(1, 0), cB + kstep, voffB); PG8_STAGE(PG8_SA(1, 0), cA + kstep, voffA); PG8_STAGE(PG8_SB(1, 1), cB + hstepB + kstep, voffB);
        PG8_WAIT_V(6); PG8_BAR;
    } else {
        PG8_STAGE(PG8_SB(0, 0), cB, voffB); PG8_STAGE(PG8_SA(0, 0), cA, voffA); PG8_STAGE(PG8_SB(0, 1), cB + hstepB, voffB); PG8_STAGE(PG8_SA(0, 1), cA + hstepA, voffA);
        if (wr == 1) PG8_BAR;
        PG8_WAIT_V(4); PG8_BAR;
        PG8_STAGE(PG8_SB(1, 0), cB + kstep, voffB); PG8_STAGE(PG8_SA(1, 0), cA + kstep, voffA); PG8_STAGE(PG8_SB(1, 1), cB + hstepB + kstep, voffB);
        PG8_WAIT_V(6); PG8_BAR;
    }
    for (;;) {
        const bool has_next = S.next(ui + 1, nxt);
        const char* nA = has_next ? (const char*)g.A + (size_t)nxt.pm * tstepA : cA; const char* nB = has_next ? (const char*)g.Bt + (size_t)nxt.pn * tstepB : cB;
        for (int t = 0; t < nt; t += 2) {
            const bool last = (t == nt - 2);
            const char* a1 = cA + (size_t)(t + 1) * kstep;
            const char* a2 = last ? nA : cA + (size_t)(t + 2) * kstep; const char* b2 = last ? nB : cB + (size_t)(t + 2) * kstep;
            const char* a3 = a2 + kstep; const char* b3 = b2 + kstep;
            if (last && has_next) S.a_ready(nxt);
            if constexpr (Epi::HAS_MID) { if (t == Epi::TMID) E.mid(acc, cur, wr, wc, fr, fq); }
            if constexpr (SP2) {
            PG8_LDB(B0, 0, 0); PG8_LDB(B1, 0, 1); PG8_SCHED; PG8_LDA(At, 0, 0); PG8_STAGE(PG8_SA(1, 1), a1 + hstepA, voffA);
            PG8_WAIT_V(8); PG8_WAIT_L(0); PG8_BAR; PG8_MMA(0, 0, At, B0); PG8_MMA(0, 1, At, B1); PG8_BAR; PG8_SCHED;
            PG8_LDA(At, 0, 1); PG8_STAGE(PG8_SB(0, 0), b2, voffB); PG8_STAGE(PG8_SB(0, 1), b2 + hstepB, voffB); PG8_STAGE(PG8_SA(0, 0), a2, voffA);
            PG8_WAIT_V(8); PG8_WAIT_L(0); PG8_BAR; PG8_MMA(1, 0, At, B0); PG8_MMA(1, 1, At, B1); PG8_BAR; PG8_SCHED;
            PG8_LDB(B0, 1, 0); PG8_LDB(B1, 1, 1); PG8_SCHED; PG8_LDA(At, 1, 0); PG8_STAGE(PG8_SA(0, 1), a2 + hstepA, voffA);
            PG8_WAIT_V(8); PG8_WAIT_L(0); PG8_BAR; PG8_MMA(0, 0, At, B0); PG8_MMA(0, 1, At, B1); PG8_BAR; PG8_SCHED;
            PG8_LDA(At, 1, 1); PG8_STAGE(PG8_SB(1, 0), b3, voffB); PG8_STAGE(PG8_SB(1, 1), b3 + hstepB, voffB); PG8_STAGE(PG8_SA(1, 0), a3, voffA);
            PG8_WAIT_V(8); PG8_WAIT_L(0); PG8_BAR; PG8_MMA(1, 0, At, B0); PG8_MMA(1, 1, At, B1); PG8_BAR; PG8_SCHED;
            } else {
            PG8_LDB(B0, 0, 0); PG8_SCHED; PG8_LDA(At, 0, 0); PG8_STAGE(PG8_SA(1, 1), a1 + hstepA, voffA);
            PG8_WAIT_L(8); PG8_BAR; PG8_WAIT_L(0); PG8_MMA(0, 0, At, B0); PG8_BAR; PG8_SCHED;
            PG8_LDB(B1, 0, 1); PG8_STAGE(PG8_SB(0, 0), b2, voffB);
            PG8_BAR; PG8_WAIT_L(0); PG8_MMA(0, 1, At, B1); PG8_BAR;
            PG8_LDA(At, 0, 1); PG8_STAGE(PG8_SA(0, 0), a2, voffA);
            PG8_BAR; PG8_WAIT_L(0); PG8_MMA(1, 0, At, B0); PG8_BAR; PG8_SCHED;
            PG8_STAGE(PG8_SB(0, 1), b2 + hstepB, voffB);
            PG8_WAIT_V(6); PG8_BAR; PG8_MMA(1, 1, At, B1); PG8_BAR;
            PG8_LDB(B0, 1, 0); PG8_SCHED; PG8_LDA(At, 1, 0); PG8_STAGE(PG8_SA(0, 1), a2 + hstepA, voffA);
            PG8_WAIT_L(8); PG8_BAR; PG8_WAIT_L(0); PG8_MMA(0, 0, At, B0); PG8_BAR; PG8_SCHED;
            PG8_LDB(B1, 1, 1); PG8_STAGE(PG8_SB(1, 0), b3, voffB);
            PG8_BAR; PG8_WAIT_L(0); PG8_MMA(0, 1, At, B1); PG8_BAR;
            PG8_LDA(At, 1, 1); PG8_STAGE(PG8_SA(1, 0), a3, voffA);
            PG8_BAR; PG8_WAIT_L(0); PG8_MMA(1, 0, At, B0); PG8_BAR; PG8_SCHED;
            PG8_STAGE(PG8_SB(1, 1), b3 + hstepB, voffB);
            PG8_WAIT_V(6); PG8_BAR; PG8_MMA(1, 1, At, B1); PG8_BAR;
            }
        }
        if constexpr (ALIGN_EPI) { if (wr == 0) PG8_BAR; }
        E(acc, cur, wr, wc, fr, fq); S.done(cur);
        if (!has_next) break;
#pragma unroll
        for (int a = 0; a < 2; ++a)
#pragma unroll
            for (int b = 0; b < 2; ++b)
#pragma unroll
                for (int m = 0; m < 4; ++m)
#pragma unroll
                    for (int n = 0; n < 2; ++n) acc[a][b][m][n] = (f32x4){0.f, 0.f, 0.f, 0.f};
        cur = nxt; cA = nA; cB = nB; ++ui;
        if constexpr (ALIGN_EPI) { if (wr == 1) PG8_BAR; }
    }
    PG8_WAIT_V(0);
    if constexpr (!ALIGN_EPI) { if (wr == 0) PG8_BAR; }
    PG8_BAR;
#undef PG8_SA
#undef PG8_SB
#undef PG8_STAGE
#undef PG8_LDA
#undef PG8_LDB
#undef PG8_MMA
#undef PG8_WAIT_V
#undef PG8_WAIT_L
#undef PG8_BAR
#undef PG8_SCHED
}
}

#ifndef PG8_SP2
#define PG8_SP2 true
#endif
#ifndef PG8_ALIGN
#define PG8_ALIGN true
#endif

constexpr int NWAVES = 8;
constexpr int N_LAUNCHES = MK_N_LAUNCHES;
constexpr int PER_PHASE = 9;
constexpr int DM = 1024, SEQ = 2048, NB = 16, DEC_T = 32;
constexpr int MP = NB * SEQ, MS = NB * DEC_T, M = MP + MS;
constexpr int DIN = 6144, DFF = 2816, DFF2 = 5632;
constexpr int LDX = 1088, LDZ = 6208, LDW2 = 2112;
constexpr float EPS = 1e-6f;
static_assert(M % 256 == 0, "M");
enum { I_XP = 0, I_XS, I_SH, I_SC, I_GPRE, I_WIN, I_CW, I_CB, I_WA, I_BA, I_WX, I_BX, I_LAM, I_WBRA, I_LNG, I_LNB, I_WS, I_BS, I_WBRB, I_WOUT, I_GPOST, I_GFFN, I_WFI, I_WFO, I_GPF, N_IN };
constexpr size_t O_Y = 0, O_HP = (size_t)M * DM, O_CP = O_HP + NB * DM, O_HS = O_CP + (size_t)NB * 3 * DM, O_CS = O_HS + NB * DM, O_VS = O_CS + (size_t)NB * 3 * DM, O_END = O_VS + (size_t)MS * DM;
static_assert(O_END == 34734080, "output size");

constexpr size_t MiB = 1u << 20;
constexpr size_t WS_CTL = 0, CTL_ZERO_BYTES = 1 * MiB;
constexpr size_t WS_W1 = 1 * MiB;
constexpr size_t WS_W2 = WS_W1 + (size_t)DIN * LDX * 2;
constexpr size_t WS_W3 = WS_W2 + (size_t)DM * LDW2 * 2;
constexpr size_t WS_W4 = WS_W3 + (size_t)DM * LDX * 2;
constexpr size_t WS_W5 = WS_W4 + (size_t)DFF2 * LDX * 2;
constexpr size_t WS_GT = WS_W5 + (size_t)DM * DFF * 2;
constexpr size_t WS_WSM = WS_GT + 16 * 128 * 64 * 2;
constexpr size_t WS_WSS = WS_WSM + 8 * 128 * 128 * 2;
constexpr size_t WS_WEND = WS_WSS + 8 * 128 * 128 * 2;
constexpr size_t WS_XN = 39 * MiB;
constexpr size_t WS_Z = 109 * MiB;
constexpr size_t WS_MIX = WS_Z;
constexpr size_t WS_FIN = WS_Z + 70 * MiB;
constexpr size_t WS_F = WS_FIN + 179 * MiB;
constexpr size_t WS_STAT = 504 * MiB;
constexpr size_t WS_END = WS_STAT + (size_t)M * 16 * 2 * 4;
static_assert(WS_WEND <= WS_XN && WS_XN + (size_t)M * LDX * 2 <= WS_Z && WS_MIX + (size_t)M * LDX * 2 <= WS_FIN && WS_FIN + (size_t)M * DFF * 2 <= WS_F && WS_F + (size_t)M * LDX * 2 <= WS_Z + (size_t)M * LDZ * 2 && WS_Z + (size_t)M * LDZ * 2 <= WS_STAT && WS_END <= 512 * MiB, "d_ws map");
constexpr int CW_TMO = 0, CW_BAR = 4096;

constexpr int RING_OFF = 0, RING_BYTES = 131072;
constexpr int LDSCTL_OFF = 139264, MISC_OFF = LDSCTL_OFF + 320;
constexpr int LDS_BYTES = 147456;

#define GAS __attribute__((address_space(1)))
#define LAS __attribute__((address_space(3)))
typedef unsigned short bf16;
typedef unsigned v4u __attribute__((ext_vector_type(4)));
typedef unsigned v2u __attribute__((ext_vector_type(2)));
typedef float f32x4 __attribute__((ext_vector_type(4)));
typedef float f32x16 __attribute__((ext_vector_type(16)));
typedef short bf16x8 __attribute__((ext_vector_type(8)));
typedef GAS unsigned gu32;
#define RLX_AGENT __ATOMIC_RELAXED, __HIP_MEMORY_SCOPE_AGENT
#define LDS_WAIT() asm volatile("s_waitcnt lgkmcnt(0)" ::: "memory")
#define VM_WAIT() asm volatile("s_waitcnt vmcnt(0)" ::: "memory")
__device__ __forceinline__ unsigned f2bf(float f) { unsigned u = __builtin_bit_cast(unsigned, f); return (u + 0x7fffu + ((u >> 16) & 1u)) >> 16; }
__device__ __forceinline__ unsigned pk2(float lo, float hi) { unsigned r; asm volatile("v_cvt_pk_bf16_f32 %0, %1, %2" : "=v"(r) : "v"(lo), "v"(hi)); return r; }
__device__ __forceinline__ float bflo(unsigned w) { return __uint_as_float(w << 16); }
__device__ __forceinline__ float bfhi(unsigned w) { return __uint_as_float(w & 0xffff0000u); }

#define XB_TMO      128
#define XB_XCNT(j)  (256  + 64 * (j))
#define XB_XSUB(j)  (1280 + 64 * (j))
#define XB_XGEN(j)  (2304 + 64 * (j))
#define XB_TOP      3328
#define XB_TOPGEN   3392
#define XCD_BAR_WORDS 3456
#define XB_SPIN_CAP (1u << 22)

__device__ __forceinline__ unsigned xb_ld(unsigned* p)              { return __hip_atomic_load(p, __ATOMIC_RELAXED, __HIP_MEMORY_SCOPE_AGENT); }
__device__ __forceinline__ unsigned xb_add(unsigned* p, unsigned v) { return __hip_atomic_fetch_add(p, v, __ATOMIC_RELAXED, __HIP_MEMORY_SCOPE_AGENT); }
__device__ __forceinline__ unsigned xb_xcc_id() { return (unsigned)__builtin_amdgcn_s_getreg((3 << 11) | 20) & 0xFu; }
#define XB_SPIN(cond, bar) do { unsigned _sp = 0; while (cond) { __builtin_amdgcn_s_sleep(1); \
    if ((++_sp & 255u) == 0u) { if (xb_ld(&(bar)[XB_TMO])) break; if (_sp > XB_SPIN_CAP) { atomicAdd(&(bar)[XB_TMO], 1u); break; } } } } while (0)

struct XcdBarrier { unsigned* bar; unsigned x; volatile LAS unsigned* st; };

__device__ __forceinline__ XcdBarrier xcd_barrier_post(unsigned* bar, volatile LAS unsigned* st) {
    XcdBarrier b; b.bar = bar; b.x = xb_xcc_id(); b.st = st;
    if (threadIdx.x == 0) (void)xb_add(&bar[XB_XCNT(b.x)], 1u);
    return b;
}
__device__ __forceinline__ void xcd_barrier_complete(unsigned* bar, unsigned x, unsigned& nloc, unsigned& nx) {
    const unsigned G = gridDim.x * gridDim.y * gridDim.z;
    unsigned sum, cnt, mine, sp = 0u;
    for (;;) {
        sum = 0u; cnt = 0u; mine = 0u;
#pragma unroll
        for (unsigned j = 0; j < 16; ++j) { const unsigned c = xb_ld(&bar[XB_XCNT(j)]); sum += c; cnt += (c > 0u) ? 1u : 0u; mine = (j == x) ? c : mine; }
        if (sum == G) break;
        __builtin_amdgcn_s_sleep(1);
        if ((++sp & 255u) == 0u) { if (xb_ld(&bar[XB_TMO])) break; if (sp > XB_SPIN_CAP) { atomicAdd(&bar[XB_TMO], 1u); break; } }
    }
    nloc = mine > 0u ? mine : 1u; nx = cnt > 0u ? cnt : 1u;
}
__device__ __forceinline__ void xcd_barrier(const XcdBarrier& b) {
    asm volatile("s_waitcnt vmcnt(0)" ::: "memory");
    __syncthreads();
    if (threadIdx.x == 0) {
        unsigned* bar = b.bar;
        __builtin_amdgcn_s_waitcnt(0);
        unsigned nloc = b.st[0], nx = b.st[1];
        if (nloc == 0u) { xcd_barrier_complete(bar, b.x, nloc, nx); b.st[0] = nloc; b.st[1] = nx; }
        const unsigned old = xb_add(&bar[XB_XSUB(b.x)], 1u);
        const unsigned gen = old / nloc;
        if (old + 1u == (gen + 1u) * nloc) {
            __builtin_amdgcn_fence(__ATOMIC_RELEASE, "agent");
            asm volatile("s_waitcnt vmcnt(0)" ::: "memory");
            const unsigned og = xb_add(&bar[XB_TOP], 1u);
            const unsigned tg = og / nx;
            if (og + 1u == (tg + 1u) * nx) xb_add(&bar[XB_TOPGEN], 1u);
            else XB_SPIN(xb_ld(&bar[XB_TOPGEN]) == tg, bar);
            __builtin_amdgcn_fence(__ATOMIC_ACQUIRE, "agent");
            xb_add(&bar[XB_XGEN(b.x)], 1u);
            asm volatile("s_waitcnt vmcnt(0)" ::: "memory");
        } else {
            XB_SPIN(xb_ld(&bar[XB_XGEN(b.x)]) == gen, bar);
            __builtin_amdgcn_fence(__ATOMIC_ACQUIRE, "agent");
            asm volatile("s_waitcnt vmcnt(0)" ::: "memory");
        }
    }
    __syncthreads();
}

struct Args { const float* in[N_IN]; float* out; unsigned char* ws; int ph_lo, ph_hi, li, pad; };
struct Frame {
    LAS unsigned char* lds;
    volatile LAS unsigned* MISC;
    gu32* ctl;
    int tid, lane, wave, vcu, G;
};
__device__ __forceinline__ float wave_sum(float v) {
#pragma unroll
    for (int o = 1; o < 64; o <<= 1) v += __shfl_xor(v, o);
    return v;
}
__device__ __forceinline__ const float* xrow_ptr(const Args& a, int m) { return m < MP ? a.in[I_XP] + (size_t)m * DM : a.in[I_XS] + (size_t)(m - MP) * DM; }

__device__ __forceinline__ void p0_transpose_item(const float* W, int N, bf16* WT, int ldk, int dcol0, int k0, int n0, int drow0, LAS float* scr, int lane) {
#pragma unroll 8
    for (int i = 0; i < 32; ++i) { const int kk = 2 * i + (lane >> 5); scr[kk * 33 + (lane & 31)] = W[(size_t)(k0 + kk) * N + n0 + (lane & 31)]; }
    LDS_WAIT(); asm volatile("" ::: "memory");
    const int c = lane & 7;
#pragma unroll
    for (int j = 0; j < 4; ++j) { const int n = (lane >> 3) + 8 * j; const LAS float* s = scr + (8 * c) * 33 + n;
        v4u o; o.x = pk2(s[0 * 33], s[1 * 33]); o.y = pk2(s[2 * 33], s[3 * 33]); o.z = pk2(s[4 * 33], s[5 * 33]); o.w = pk2(s[6 * 33], s[7 * 33]);
        *(GAS v4u*)(WT + (size_t)(drow0 + n) * ldk + dcol0 + k0 + 8 * c) = o; }
    LDS_WAIT(); asm volatile("" ::: "memory");
}

__device__ __forceinline__ void p0_prologue(Frame& F, const Args& a) {
    unsigned char* ws = a.ws;
    LAS float* scr = (LAS float*)(F.lds + RING_OFF + F.wave * 16384);
    const int gw = F.vcu * NWAVES + F.wave, NGW = F.G * NWAVES;
    constexpr int I1 = (DM / 64) * (DIN / 32), I2 = (DM / 64) * (DM / 32), I4 = (DM / 64) * (DFF2 / 32), I5 = (DFF / 64) * (DM / 32), IG = 64;
    constexpr int NITEMS = I1 + 3 * I2 + I4 + I5 + IG;
    for (int it = gw; it < NITEMS; it += NGW) {
        int r = it;
        if (r < I1) { const int nb = DIN / 32, kb = r / nb, n0 = 32 * (r % nb); p0_transpose_item(a.in[I_WIN], DIN, (bf16*)(ws + WS_W1), LDX, 0, 64 * kb, n0, n0, scr, F.lane); continue; } r -= I1;
        if (r < I2) { const int nb = DM / 32, kb = r / nb, n0 = 32 * (r % nb); p0_transpose_item(a.in[I_WBRA], DM, (bf16*)(ws + WS_W2), LDW2, 0, 64 * kb, n0, n0, scr, F.lane); continue; } r -= I2;
        if (r < I2) { const int nb = DM / 32, kb = r / nb, n0 = 32 * (r % nb); p0_transpose_item(a.in[I_WBRB], DM, (bf16*)(ws + WS_W2), LDW2, 1024, 64 * kb, n0, n0, scr, F.lane); continue; } r -= I2;
        if (r < I2) { const int nb = DM / 32, kb = r / nb, n0 = 32 * (r % nb); p0_transpose_item(a.in[I_WOUT], DM, (bf16*)(ws + WS_W3), LDX, 0, 64 * kb, n0, n0, scr, F.lane); continue; } r -= I2;
        if (r < I4) { const int nb = DFF2 / 32, kb = r / nb, n0 = 32 * (r % nb); const int s = n0 / DFF, j0 = n0 % DFF, drow0 = 256 * (j0 / 128) + 128 * s + (j0 % 128);
                      p0_transpose_item(a.in[I_WFI], DFF2, (bf16*)(ws + WS_W4), LDX, 0, 64 * kb, n0, drow0, scr, F.lane); continue; } r -= I4;
        if (r < I5) { const int nb = DM / 32, kb = r / nb, n0 = 32 * (r % nb); p0_transpose_item(a.in[I_WFO], DM, (bf16*)(ws + WS_W5), DFF, 0, 64 * kb, n0, n0, scr, F.lane); continue; } r -= I5;
        { const int hd = r >> 2, which = (r >> 1) & 1, n0 = 32 * (r & 1);
          p0_transpose_item((which ? a.in[I_WX] : a.in[I_WA]) + (size_t)hd * 4096, 64, (bf16*)(ws + WS_GT) + (size_t)hd * 8192, 64, 0, 0, n0, which * 64 + n0, scr, F.lane); }
    }
    { const float* wsp = a.in[I_WS]; bf16* wsm = (bf16*)(ws + WS_WSM); bf16* wss = (bf16*)(ws + WS_WSS);
      for (int i = gw * 64 + F.lane; i < 8 * 128 * 128; i += NGW * 64) { const int g = i >> 14, p = (i >> 7) & 127, q = i & 127;
          wsm[i] = (bf16)(((q >> 6) <= (p >> 6)) ? f2bf(wsp[i]) : 0u);
          wss[i] = (bf16)(((q >> 5) == (p >> 5)) ? f2bf(wsp[(g << 14) + ((p & 31) << 7) + (q & 31)]) : 0u); } }
    { const GAS f32x4* gp = (const GAS f32x4*)a.in[I_GPRE] + F.lane; f32x4 gg[4];
#pragma unroll
      for (int j = 0; j < 4; ++j) gg[j] = gp[64 * j];
      bf16* XN = (bf16*)(ws + WS_XN);
      for (int m0 = gw * 4; m0 < M; m0 += NGW * 4) { f32x4 v[4][4];
#pragma unroll
          for (int r = 0; r < 4; ++r) { const GAS f32x4* xr = (const GAS f32x4*)xrow_ptr(a, m0 + r) + F.lane;
#pragma unroll
              for (int j = 0; j < 4; ++j) v[r][j] = xr[64 * j]; }
#pragma unroll
          for (int r = 0; r < 4; ++r) { float s = 0.f;
#pragma unroll
              for (int j = 0; j < 4; ++j) s += (v[r][j].x * v[r][j].x + v[r][j].y * v[r][j].y) + (v[r][j].z * v[r][j].z + v[r][j].w * v[r][j].w);
              const float rstd = __builtin_amdgcn_rsqf(wave_sum(s) * (1.f / DM) + EPS);
              GAS v2u* o8 = (GAS v2u*)(XN + (size_t)(m0 + r) * LDX) + F.lane;
#pragma unroll
              for (int j = 0; j < 4; ++j) { v2u o; o.x = pk2(v[r][j].x * rstd * gg[j].x, v[r][j].y * rstd * gg[j].y); o.y = pk2(v[r][j].z * rstd * gg[j].z, v[r][j].w * rstd * gg[j].w); o8[64 * j] = o; } } } }
}

__device__ __forceinline__ void p2a_item(Frame& F, const Args& a, int row0, int T, int hd, const float* h0, const float* cprev, float* out_h, float* out_conv) {
    LAS unsigned char* lds = F.lds;
    LAS float* XC = (LAS float*)(lds);
    LAS float* AS = (LAS float*)(lds + 32768);
    LAS float* US = (LAS float*)(lds + 65536);
    LAS bf16* XCB = (LAS bf16*)(lds + 98304);
    LAS float* SEGA = (LAS float*)(lds + 116736);
    LAS float* SEGB = (LAS float*)(lds + 118784);
    LAS float* CAR = (LAS float*)(lds + 120832);
    bf16* Z = (bf16*)(a.ws + WS_Z);
    const int tid = F.tid, lane = F.lane, wave = F.wave;
    const int tr = tid >> 3, cg = tid & 7, ch0 = hd * 64 + cg * 8;
    const int tb = wave >> 1, cb = wave & 1, jl = cb * 32 + (lane & 31), hi = lane >> 5;
    __syncthreads();
    typedef float f32x2c __attribute__((ext_vector_type(2)));
    f32x2c cw2[4][4], cbv2[4];
#pragma unroll
    for (int k = 0; k < 4; ++k) { const f32x4 w0 = *(const GAS f32x4*)(a.in[I_CW] + k * DM + ch0), w1 = *(const GAS f32x4*)(a.in[I_CW] + k * DM + ch0 + 4);
        cw2[k][0] = (f32x2c){w0.x, w0.y}; cw2[k][1] = (f32x2c){w0.z, w0.w}; cw2[k][2] = (f32x2c){w1.x, w1.y}; cw2[k][3] = (f32x2c){w1.z, w1.w}; }
    { const f32x4 w0 = *(const GAS f32x4*)(a.in[I_CB] + ch0), w1 = *(const GAS f32x4*)(a.in[I_CB] + ch0 + 4);
      cbv2[0] = (f32x2c){w0.x, w0.y}; cbv2[1] = (f32x2c){w0.z, w0.w}; cbv2[2] = (f32x2c){w1.x, w1.y}; cbv2[3] = (f32x2c){w1.z, w1.w}; }
    bf16x8 Br[4], Bi[4];
    { const bf16* gt = (const bf16*)(a.ws + WS_GT) + (size_t)hd * 8192;
#pragma unroll
      for (int ks = 0; ks < 4; ++ks) { Br[ks] = *(const GAS bf16x8*)(gt + jl * 64 + ks * 16 + hi * 8); Bi[ks] = *(const GAS bf16x8*)(gt + (64 + jl) * 64 + ks * 16 + hi * 8); } }
    float nba = -1.4426950408889634f * a.in[I_BA][hd * 64 + jl], nbx = -1.4426950408889634f * a.in[I_BX][hd * 64 + jl];
    float cA = -8.0f * log1pf(expf(-a.in[I_LAM][hd * 64 + jl])) * 1.4426950408889634f;
    asm volatile("" : "+v"(cA), "+v"(nba), "+v"(nbx));
    if (tid < 64) CAR[tid] = h0 ? h0[hd * 64 + tid] : 0.f;
    const int ntiles = (T + 127) >> 7;
    typedef float f32x2 __attribute__((ext_vector_type(2)));
    v4u xr[5], gg[2];
    const unsigned zbase = (unsigned)row0 * LDZ + ch0;
#define P2A_ISSUE(t0n) do { _Pragma("unroll") for (int r = 0; r < 5; ++r) { int tt = (t0n) + 2 * tr - 3 + r; tt = tt < 0 ? 0 : (tt > T - 1 ? T - 1 : tt); \
        xr[r] = *(const GAS v4u*)(Z + (zbase + (unsigned)tt * LDZ)); } } while (0)
    P2A_ISSUE(0);
    const int pc = tid & 31, sg8 = tid >> 5;
    for (int tile = 0; tile < ntiles; ++tile) {
        const int t0 = tile << 7, nrows = (T - t0) < 128 ? (T - t0) : 128, par = tile & 1;
        {
            f32x2 f[5][4];
#pragma unroll
            for (int r = 0; r < 5; ++r) { const v4u w = xr[r];
                f[r][0] = (f32x2){bflo(w.x), bfhi(w.x)}; f[r][1] = (f32x2){bflo(w.y), bfhi(w.y)}; f[r][2] = (f32x2){bflo(w.z), bfhi(w.z)}; f[r][3] = (f32x2){bflo(w.w), bfhi(w.w)}; }
            if (tile == 0 || nrows < 128) {
#pragma unroll
                for (int r = 0; r < 5; ++r) { const int tt = t0 + 2 * tr - 3 + r;
                    if (tt < 0) {
                        if (cprev) { const f32x4 p0 = *(const GAS f32x4*)(cprev + (tt + 3) * DM + ch0), p1 = *(const GAS f32x4*)(cprev + (tt + 3) * DM + ch0 + 4);
                            f[r][0] = (f32x2){p0.x, p0.y}; f[r][1] = (f32x2){p0.z, p0.w}; f[r][2] = (f32x2){p1.x, p1.y}; f[r][3] = (f32x2){p1.z, p1.w}; }
                        else {
#pragma unroll
                            for (int e = 0; e < 4; ++e) f[r][e] = (f32x2){0.f, 0.f}; }
                    } else if (tt >= T) {
#pragma unroll
                        for (int e = 0; e < 4; ++e) f[r][e] = (f32x2){0.f, 0.f}; } } }
            if (tile + 1 < ntiles) P2A_ISSUE(t0 + 128);
#pragma unroll
            for (int rr = 0; rr < 2; ++rr) { int tl = 2 * tr + rr; tl = tl < nrows ? tl : nrows - 1; gg[rr] = *(const GAS v4u*)(Z + (zbase + (unsigned)(t0 + tl) * LDZ + 1024u)); }
#pragma unroll
            for (int rr = 0; rr < 2; ++rr) { const int tl = 2 * tr + rr, t = t0 + tl; f32x2 xc[4];
#pragma unroll
                for (int e = 0; e < 4; ++e) xc[e] = cbv2[e] + cw2[0][e] * f[rr][e] + cw2[1][e] * f[rr + 1][e] + cw2[2][e] * f[rr + 2][e] + cw2[3][e] * f[rr + 3][e];
                *(LAS f32x4*)(XC + tl * 64 + cg * 8) = (f32x4){xc[0].x, xc[0].y, xc[1].x, xc[1].y}; *(LAS f32x4*)(XC + tl * 64 + cg * 8 + 4) = (f32x4){xc[2].x, xc[2].y, xc[3].x, xc[3].y};
                v4u pw; pw.x = pk2(xc[0].x, xc[0].y); pw.y = pk2(xc[1].x, xc[1].y); pw.z = pk2(xc[2].x, xc[2].y); pw.w = pk2(xc[3].x, xc[3].y);
                *(LAS v4u*)(XCB + tl * 72 + cg * 8) = pw;
                if (tile == ntiles - 1 && t >= T - 3 && t < T) { float* oc = out_conv + (size_t)(t - (T - 3)) * DM + ch0;
                    *(GAS f32x4*)oc = (f32x4){f[rr + 3][0].x, f[rr + 3][0].y, f[rr + 3][1].x, f[rr + 3][1].y}; *(GAS f32x4*)(oc + 4) = (f32x4){f[rr + 3][2].x, f[rr + 3][2].y, f[rr + 3][3].x, f[rr + 3][3].y}; }
            }
        }
        __syncthreads();
        if (tb * 32 < nrows) {
            f32x16 accr, acci;
#pragma unroll
            for (int i = 0; i < 16; ++i) { accr[i] = 0.f; acci[i] = 0.f; }
#pragma unroll
            for (int ks = 0; ks < 4; ++ks) { const bf16x8 A = *(const LAS bf16x8*)(XCB + (tb * 32 + (lane & 31)) * 72 + ks * 16 + hi * 8);
                accr = __builtin_amdgcn_mfma_f32_32x32x16_bf16(A, Br[ks], accr, 0, 0, 0);
                acci = __builtin_amdgcn_mfma_f32_32x32x16_bf16(A, Bi[ks], acci, 0, 0, 0); }
#pragma unroll
            for (int rg = 0; rg < 16; rg += 2) { const int tl = tb * 32 + (rg & 3) + 8 * (rg >> 2) + 4 * hi;
                const f32x2 xcv = (f32x2){XC[tl * 64 + jl], XC[tl * 64 + 64 + jl]};
                f32x2 er = (f32x2){accr[rg], accr[rg + 1]} * -1.4426950408889634f + nba, ei = (f32x2){acci[rg], acci[rg + 1]} * -1.4426950408889634f + nbx;
                er = (f32x2){__builtin_amdgcn_exp2f(er.x), __builtin_amdgcn_exp2f(er.y)} + 1.0f; ei = (f32x2){__builtin_amdgcn_exp2f(ei.x), __builtin_amdgcn_exp2f(ei.y)} + 1.0f;
                const f32x2 r = (f32x2){__builtin_amdgcn_rcpf(er.x), __builtin_amdgcn_rcpf(er.y)}, ig = (f32x2){__builtin_amdgcn_rcpf(ei.x), __builtin_amdgcn_rcpf(ei.y)};
                const f32x2 l2a = r * cA;
                const f32x2 av = (f32x2){__builtin_amdgcn_exp2f(l2a.x), __builtin_amdgcn_exp2f(l2a.y)};
                const f32x2 y = l2a * 1.3862943611198906f;
                const f32x2 ser = -y * (1.0f + y * (0.5f + y * 0.16666667f)), dir = 1.0f - av * av;
                const f32x2 om = (f32x2){(y.x > -0.02f) ? ser.x : dir.x, (y.y > -0.02f) ? ser.y : dir.y};
                const f32x2 uv = (f32x2){__builtin_amdgcn_sqrtf(om.x), __builtin_amdgcn_sqrtf(om.y)} * (ig * xcv);
                AS[tl * 64 + jl] = av.x; AS[tl * 64 + 64 + jl] = av.y; US[tl * 64 + jl] = uv.x; US[tl * 64 + 64 + jl] = uv.y; }
        }
        __syncthreads();
        if (tid < 256 && sg8 * 16 < nrows) { f32x2 Ap = (f32x2){1.f, 1.f}, Bp = (f32x2){0.f, 0.f};
#pragma unroll
            for (int s2 = 0; s2 < 16; ++s2) { const f32x2 av = *(const LAS f32x2*)(AS + (sg8 * 16 + s2) * 64 + 2 * pc), uv = *(const LAS f32x2*)(US + (sg8 * 16 + s2) * 64 + 2 * pc); Bp = av * Bp + uv; Ap *= av; }
            *(LAS f32x2*)(SEGA + sg8 * 64 + 2 * pc) = Ap; *(LAS f32x2*)(SEGB + sg8 * 64 + 2 * pc) = Bp; }
        __syncthreads();
        if (tid < 256 && sg8 * 16 < nrows) { f32x2 h = *(const LAS f32x2*)(CAR + par * 64 + 2 * pc);
            for (int sg = 0; sg < sg8; ++sg) h = *(const LAS f32x2*)(SEGA + sg * 64 + 2 * pc) * h + *(const LAS f32x2*)(SEGB + sg * 64 + 2 * pc);
#pragma unroll
            for (int s2 = 0; s2 < 16; ++s2) { const int tl = sg8 * 16 + s2; h = *(const LAS f32x2*)(AS + tl * 64 + 2 * pc) * h + *(const LAS f32x2*)(US + tl * 64 + 2 * pc); *(LAS f32x2*)(US + tl * 64 + 2 * pc) = h; }
            if (t0 + sg8 * 16 + 15 == T - 1) *(f32x2*)(out_h + hd * 64 + 2 * pc) = h;
            if (sg8 == 7) *(LAS f32x2*)(CAR + (par ^ 1) * 64 + 2 * pc) = h; }
        __syncthreads();
#pragma unroll
        for (int rr = 0; rr < 2; ++rr) { const int tl = 2 * tr + rr;
            if (tl < nrows) { const v4u w = gg[rr];
                const f32x4 h0v = *(const LAS f32x4*)(US + tl * 64 + cg * 8), h1v = *(const LAS f32x4*)(US + tl * 64 + cg * 8 + 4);
                const f32x2 y0 = (f32x2){h0v.x, h0v.y} * (f32x2){bflo(w.x), bfhi(w.x)}, y1 = (f32x2){h0v.z, h0v.w} * (f32x2){bflo(w.y), bfhi(w.y)};
                const f32x2 y2 = (f32x2){h1v.x, h1v.y} * (f32x2){bflo(w.z), bfhi(w.z)}, y3 = (f32x2){h1v.z, h1v.w} * (f32x2){bflo(w.w), bfhi(w.w)};
                v4u o; o.x = pk2(y0.x, y0.y); o.y = pk2(y1.x, y1.y); o.z = pk2(y2.x, y2.y); o.w = pk2(y3.x, y3.y);
                *(GAS v4u*)(Z + (zbase + (unsigned)(t0 + tl) * LDZ + 1024u)) = o; } }
    }
#undef P2A_ISSUE
}

__device__ __forceinline__ int vt_off(int d, int q) { return d * 256 + ((((q >> 3) ^ (d & 15) ^ ((d >> 4) & 7)) & 15) << 4) + (q & 7) * 2; }
__device__ __forceinline__ void p2b_item(Frame& F, const Args& a, int item, int g_lo, int g_hi) {
    LAS unsigned char* lds = F.lds;
    LAS unsigned char* VT = lds;
    LAS unsigned char* WM = lds + 32768;
    LAS float* SG = (LAS float*)(lds + 65536);
    LAS float* ST = (LAS float*)(lds + 65536 + 67584);
    bf16* Z = (bf16*)(a.ws + WS_Z);
    const int tid = F.tid, lane = F.lane, wave = F.wave;
    const bool sample = item >= MP / 128;
    const int row0 = item * 128;
    const bf16* Wm = (const bf16*)(a.ws + (sample ? WS_WSS : WS_WSM));
    const int cchunk = tid & 15, qg = tid >> 4;
    const int db = wave & 3, pb0 = (wave >> 2) * 2, hi = lane >> 5, l31 = lane & 31;
    v4u gvr[4], wmr[4]; f32x4 lgr[2], lbr[2]; float bsr[2];
#define P2B_ISSUE(g) do { lgr[0] = *(const GAS f32x4*)(a.in[I_LNG] + (g) * 128 + cchunk * 8); lgr[1] = *(const GAS f32x4*)(a.in[I_LNG] + (g) * 128 + cchunk * 8 + 4); \
        lbr[0] = *(const GAS f32x4*)(a.in[I_LNB] + (g) * 128 + cchunk * 8); lbr[1] = *(const GAS f32x4*)(a.in[I_LNB] + (g) * 128 + cchunk * 8 + 4); \
        bsr[0] = a.in[I_BS][(g) * 128 + (sample ? l31 : pb0 * 32 + l31)]; bsr[1] = a.in[I_BS][(g) * 128 + (sample ? l31 : (pb0 + 1) * 32 + l31)]; \
        _Pragma("unroll") for (int r = 0; r < 4; ++r) { gvr[r] = *(const GAS v4u*)(Z + (size_t)(row0 + qg * 4 + r) * LDZ + 3072 + (g) * 128 + cchunk * 8); \
        wmr[r] = *(const GAS v4u*)(Wm + (size_t)(g) * 16384 + (size_t)(tid + 512 * r) * 8); } } while (0)
    P2B_ISSUE(g_lo);
    __syncthreads();
    if (tid < 128) { const GAS f32x4* sp = (const GAS f32x4*)((const float*)(a.ws + WS_STAT) + (size_t)(row0 + tid) * 32); f32x4 w[8];
#pragma unroll
        for (int i = 0; i < 8; ++i) w[i] = sp[i];
        float s = 0.f, ss = 0.f;
#pragma unroll
        for (int i = 0; i < 8; ++i) { s += w[i].x; ss += w[i].y; s += w[i].z; ss += w[i].w; }
        const float mean = s * (1.f / 1024.f), var = fmaxf(ss * (1.f / 1024.f) - mean * mean, 0.f);
        ST[tid * 2] = mean; ST[tid * 2 + 1] = __builtin_amdgcn_rsqf(var + EPS); }
    __syncthreads();
    for (int g = g_lo; g < g_hi; ++g) {
        { const int d0 = cchunk * 8, col = g * 128 + d0;
          const f32x4 g0 = lgr[0], g1 = lgr[1], b0 = lbr[0], b1 = lbr[1];
          const float lg[8] = {g0.x, g0.y, g0.z, g0.w, g1.x, g1.y, g1.z, g1.w}, lb[8] = {b0.x, b0.y, b0.z, b0.w, b1.x, b1.y, b1.z, b1.w};
          float vn[4][8];
#pragma unroll
          for (int r = 0; r < 4; ++r) { const int q = qg * 4 + r; const v4u w = gvr[r];
              const float mean = ST[q * 2], rstd = ST[q * 2 + 1];
              const float x[8] = {bflo(w.x), bfhi(w.x), bflo(w.y), bfhi(w.y), bflo(w.z), bfhi(w.z), bflo(w.w), bfhi(w.w)};
#pragma unroll
              for (int e = 0; e < 8; ++e) vn[r][e] = (x[e] - mean) * rstd * lg[e] + lb[e];
              if (sample) { float* ov = a.out + O_VS + (size_t)(row0 - MP + q) * DM + col;
                  *(GAS f32x4*)ov = (f32x4){vn[r][0], vn[r][1], vn[r][2], vn[r][3]}; *(GAS f32x4*)(ov + 4) = (f32x4){vn[r][4], vn[r][5], vn[r][6], vn[r][7]}; } }
#pragma unroll
          for (int e = 0; e < 8; ++e) { v2u o; o.x = pk2(vn[0][e], vn[1][e]); o.y = pk2(vn[2][e], vn[3][e]); *(LAS v2u*)(VT + vt_off(d0 + e, qg * 4)) = o; }
#pragma unroll
          for (int r = 0; r < 4; ++r) { const int ch = tid + 512 * r; *(LAS v4u*)(WM + vt_off(ch >> 4, (ch & 15) * 8)) = wmr[r]; } }
        const float bs0 = bsr[0], bs1 = bsr[1];
        v4u gur[4];
#pragma unroll
        for (int r = 0; r < 4; ++r) { const int ch = tid + 512 * r; gur[r] = *(const GAS v4u*)(Z + (size_t)(row0 + (ch >> 4)) * LDZ + 2048 + g * 128 + (ch & 15) * 8); }
        if (g + 1 < g_hi) P2B_ISSUE(g + 1);
        __syncthreads();
        { f32x16 acc[2];
#pragma unroll
          for (int i = 0; i < 16; ++i) { acc[0][i] = 0.f; acc[1][i] = 0.f; }
          const int kmax = (!sample && pb0 == 0) ? 4 : 8;
          const int d = db * 32 + l31;
#pragma unroll
          for (int ks = 0; ks < 8; ++ks) { if (ks < kmax) { const bf16x8 A = *(const LAS bf16x8*)(VT + vt_off(d, ks * 16 + hi * 8));
#pragma unroll
              for (int pi = 0; pi < 2; ++pi) { const bf16x8 B = *(const LAS bf16x8*)(WM + vt_off((pb0 + pi) * 32 + l31, ks * 16 + hi * 8));
                  acc[pi] = __builtin_amdgcn_mfma_f32_32x32x16_bf16(A, B, acc[pi], 0, 0, 0); } } }
#pragma unroll
          for (int pi = 0; pi < 2; ++pi) { const int p = (pb0 + pi) * 32 + l31; const float bs = pi ? bs1 : bs0;
#pragma unroll
              for (int rq = 0; rq < 4; ++rq) *(LAS f32x4*)(SG + p * 132 + db * 32 + 8 * rq + 4 * hi) = (f32x4){acc[pi][rq * 4 + 0] + bs, acc[pi][rq * 4 + 1] + bs, acc[pi][rq * 4 + 2] + bs, acc[pi][rq * 4 + 3] + bs}; } }
        __syncthreads();
#pragma unroll
        for (int r = 0; r < 4; ++r) { const int ch = tid + 512 * r, p = ch >> 4, c8 = (ch & 15) * 8;
            const f32x4 s0 = *(const LAS f32x4*)(SG + p * 132 + c8), s1 = *(const LAS f32x4*)(SG + p * 132 + c8 + 4); const v4u w = gur[r];
            v4u o; o.x = pk2(s0.x * bflo(w.x), s0.y * bfhi(w.x)); o.y = pk2(s0.z * bflo(w.y), s0.w * bfhi(w.y)); o.z = pk2(s1.x * bflo(w.z), s1.y * bfhi(w.z)); o.w = pk2(s1.z * bflo(w.w), s1.w * bfhi(w.w));
            *(GAS v4u*)(Z + (size_t)(row0 + p) * LDZ + 2048 + g * 128 + c8) = o; }
    }
#undef P2B_ISSUE
}

__device__ __forceinline__ void p5_rows(Frame& F, const Args& a) {
    const int gw = F.vcu * NWAVES + F.wave, NGW = F.G * NWAVES, lane = F.lane;
    const bf16* MIX = (const bf16*)(a.ws + WS_MIX); bf16* HN = (bf16*)(a.ws + WS_XN);
    f32x4 g1[4], g2[4];
#pragma unroll
    for (int j = 0; j < 4; ++j) { g1[j] = ((const GAS f32x4*)a.in[I_GPOST])[lane + 64 * j]; g2[j] = ((const GAS f32x4*)a.in[I_GFFN])[lane + 64 * j]; }
    for (int m = gw; m < M; m += NGW) { const GAS f32x4* xr = (const GAS f32x4*)xrow_ptr(a, m) + lane; const GAS v2u* mr = (const GAS v2u*)(MIX + (size_t)m * LDX) + lane;
        f32x4 x[4], mx[4]; float s = 0.f;
#pragma unroll
        for (int j = 0; j < 4; ++j) { x[j] = xr[64 * j]; const v2u w = mr[64 * j]; mx[j] = (f32x4){bflo(w.x), bfhi(w.x), bflo(w.y), bfhi(w.y)};
            s += (mx[j].x * mx[j].x + mx[j].y * mx[j].y) + (mx[j].z * mx[j].z + mx[j].w * mx[j].w); }
        const float r1 = __builtin_amdgcn_rsqf(wave_sum(s) * (1.f / DM) + EPS); float s2 = 0.f;
#pragma unroll
        for (int j = 0; j < 4; ++j) { x[j] = x[j] + mx[j] * r1 * g1[j]; s2 += (x[j].x * x[j].x + x[j].y * x[j].y) + (x[j].z * x[j].z + x[j].w * x[j].w); }
        const float r2 = __builtin_amdgcn_rsqf(wave_sum(s2) * (1.f / DM) + EPS);
        GAS v2u* o8 = (GAS v2u*)(HN + (size_t)m * LDX) + lane;
#pragma unroll
        for (int j = 0; j < 4; ++j) { const f32x4 h = x[j] * r2 * g2[j]; v2u o; o.x = pk2(h.x, h.y); o.y = pk2(h.z, h.w); o8[64 * j] = o; } }
}
__device__ __forceinline__ void p8_rows(Frame& F, const Args& a) {
    const int gw = F.vcu * NWAVES + F.wave, NGW = F.G * NWAVES, lane = F.lane;
    const bf16* MIX = (const bf16*)(a.ws + WS_MIX); const bf16* FF = (const bf16*)(a.ws + WS_F);
    f32x4 g1[4], g3[4];
#pragma unroll
    for (int j = 0; j < 4; ++j) { g1[j] = ((const GAS f32x4*)a.in[I_GPOST])[lane + 64 * j]; g3[j] = ((const GAS f32x4*)a.in[I_GPF])[lane + 64 * j]; }
    for (int m = gw; m < M; m += NGW) { const GAS f32x4* xr = (const GAS f32x4*)xrow_ptr(a, m) + lane; const GAS v2u* mr = (const GAS v2u*)(MIX + (size_t)m * LDX) + lane; const GAS v2u* fr = (const GAS v2u*)(FF + (size_t)m * LDX) + lane;
        f32x4 x[4], mx[4], fx[4]; float s = 0.f, sf = 0.f;
#pragma unroll
        for (int j = 0; j < 4; ++j) { x[j] = xr[64 * j]; const v2u w = mr[64 * j]; mx[j] = (f32x4){bflo(w.x), bfhi(w.x), bflo(w.y), bfhi(w.y)}; const v2u wf = fr[64 * j]; fx[j] = (f32x4){bflo(wf.x), bfhi(wf.x), bflo(wf.y), bfhi(wf.y)};
            s += (mx[j].x * mx[j].x + mx[j].y * mx[j].y) + (mx[j].z * mx[j].z + mx[j].w * mx[j].w); sf += (fx[j].x * fx[j].x + fx[j].y * fx[j].y) + (fx[j].z * fx[j].z + fx[j].w * fx[j].w); }
        const float r1 = __builtin_amdgcn_rsqf(wave_sum(s) * (1.f / DM) + EPS), r3 = __builtin_amdgcn_rsqf(wave_sum(sf) * (1.f / DM) + EPS);
        GAS f32x4* o = (GAS f32x4*)(a.out + O_Y + (size_t)m * DM) + lane;
#pragma unroll
        for (int j = 0; j < 4; ++j) o[64 * j] = x[j] + mx[j] * r1 * g1[j] + fx[j] * r3 * g3[j]; }
}

typedef float f32x4s __attribute__((ext_vector_type(4)));
template <int MODE, int NSTEPS>
__device__ __forceinline__ void small_gemm(Frame& F, const bf16* A, int lda, const bf16* Bt, int ldb, bf16* O, int ldo, const bf16* Zg) {
    LAS float* RED = (LAS float*)F.lds;
    const int tid = F.tid, lane = F.lane, wave = F.wave, kc = lane >> 4, l15 = lane & 15;
    constexpr int KS = NSTEPS * 32;
    for (int task = blockIdx.x; task < 256; task += F.G) {
        const int mt = task & 7, nt = task >> 3;
        const int r0 = MP + mt * 64, c0 = nt * 32;
        const bf16* pa = A + (size_t)(r0 + l15) * lda + wave * KS + kc * 8;
        const bf16* pb = Bt + (size_t)(c0 + l15) * ldb + wave * KS + kc * 8;
        f32x4s acc[4][2];
#pragma unroll
        for (int i = 0; i < 4; ++i) { acc[i][0] = (f32x4s){0.f, 0.f, 0.f, 0.f}; acc[i][1] = (f32x4s){0.f, 0.f, 0.f, 0.f}; }
        bf16x8 fa[2][4][4], fb[2][4][2];
#define SG_LOAD(buf, s0, ns) do { _Pragma("unroll") for (int s = 0; s < (ns); ++s) { \
            _Pragma("unroll") for (int i = 0; i < 4; ++i) fa[buf][s][i] = *(const GAS bf16x8*)(pa + (size_t)(16 * i) * lda + ((s0) + s) * 32); \
            _Pragma("unroll") for (int j = 0; j < 2; ++j) fb[buf][s][j] = *(const GAS bf16x8*)(pb + (size_t)(16 * j) * ldb + ((s0) + s) * 32); } } while (0)
#define SG_MMA(buf, ns) do { _Pragma("unroll") for (int s = 0; s < (ns); ++s) _Pragma("unroll") for (int i = 0; i < 4; ++i) _Pragma("unroll") for (int j = 0; j < 2; ++j) \
            acc[i][j] = __builtin_amdgcn_mfma_f32_16x16x32_bf16(fa[buf][s][i], fb[buf][s][j], acc[i][j], 0, 0, 0); } while (0)
        if (NSTEPS == 4) { SG_LOAD(0, 0, 4); SG_MMA(0, 4); }
        else if (NSTEPS == 8) { SG_LOAD(0, 0, 4); SG_LOAD(1, 4, 4); SG_MMA(0, 4); SG_MMA(1, 4); }
        else { SG_LOAD(0, 0, 4); SG_LOAD(1, 4, 4); SG_MMA(0, 4); SG_LOAD(0, 8, 3); SG_MMA(1, 4); SG_MMA(0, 3); }
#undef SG_LOAD
#undef SG_MMA
        __syncthreads();
#pragma unroll
        for (int i = 0; i < 4; ++i)
#pragma unroll
            for (int j = 0; j < 2; ++j)
#pragma unroll
                for (int rg = 0; rg < 4; ++rg) RED[wave * 2304 + (16 * i + 4 * kc + rg) * 36 + 16 * j + l15] = acc[i][j][rg];
        __syncthreads();
        { const int row = tid >> 3, c4 = (tid & 7) * 4, col = c0 + c4; f32x4 v;
            if (MODE == 1) { f32x4 oa = (f32x4){0.f, 0.f, 0.f, 0.f}, ob = oa;
#pragma unroll
                for (int w = 0; w < 4; ++w) { oa += *(const LAS f32x4*)(RED + w * 2304 + row * 36 + c4); ob += *(const LAS f32x4*)(RED + (w + 4) * 2304 + row * 36 + c4); }
                const v2u ga = *(const GAS v2u*)(Zg + (size_t)(r0 + row) * LDZ + col), gb = *(const GAS v2u*)(Zg + (size_t)(r0 + row) * LDZ + 1024 + col);
                v.x = bflo(ga.x) * oa.x + bflo(gb.x) * ob.x; v.y = bfhi(ga.x) * oa.y + bfhi(gb.x) * ob.y; v.z = bflo(ga.y) * oa.z + bflo(gb.y) * ob.z; v.w = bfhi(ga.y) * oa.w + bfhi(gb.y) * ob.w;
            } else { v = (f32x4){0.f, 0.f, 0.f, 0.f};
#pragma unroll
                for (int w = 0; w < 8; ++w) v += *(const LAS f32x4*)(RED + w * 2304 + row * 36 + c4); }
            v2u o; o.x = pk2(v.x, v.y); o.y = pk2(v.z, v.w);
            *(GAS v2u*)(O + (size_t)(r0 + row) * ldo + col) = o; }
    }
    __syncthreads();
}

__global__ void __launch_bounds__(NWAVES * 64, 2) hawk_fwd(Args args) {
    extern __shared__ __attribute__((aligned(16))) unsigned char lds[];
    Frame F;
    F.lds = (LAS unsigned char*)lds;
    F.MISC = (volatile LAS unsigned*)(F.lds + MISC_OFF);
    F.tid = threadIdx.x; F.lane = F.tid & 63; F.wave = __builtin_amdgcn_readfirstlane(F.tid >> 6);
    F.G = gridDim.x; { const int bx = blockIdx.x; F.vcu = (F.G % 8 == 0) ? (bx % 8) * (F.G / 8) + bx / 8 : bx; }
    unsigned char* ws = args.ws;
    F.ctl = (gu32*)(ws + WS_CTL);
    for (int u = F.tid; u < (LDS_BYTES - LDSCTL_OFF) / 4; u += NWAVES * 64) ((LAS unsigned*)(F.lds + LDSCTL_OFF))[u] = 0u;
    __syncthreads();
    XcdBarrier bar; bar.bar = (unsigned*)(F.ctl + CW_BAR); bar.x = 0; bar.st = nullptr;
    if (N_LAUNCHES != PER_PHASE) bar = xcd_barrier_post((unsigned*)(F.ctl + CW_BAR), F.MISC + 8);
#define GRID_BAR() do { if (N_LAUNCHES != PER_PHASE) xcd_barrier(bar); } while (0)
    volatile LAS unsigned long long* tsb = (volatile LAS unsigned long long*)(F.lds + LDSCTL_OFF + 1024);
#define TS(i) do { if (PROBE_TA >= 0 && blockIdx.x == 0 && F.tid == 0) tsb[i] = __builtin_amdgcn_s_memrealtime(); } while (0)
    TS(63);
    const int lo = args.ph_lo, hi = args.ph_hi;
#define IN(k) (lo <= (k) && (k) < hi)
#define BOTH(k) (IN(k) && IN((k) + 1))
    bf16* XN = (bf16*)(ws + WS_XN); bf16* Z = (bf16*)(ws + WS_Z);

#define PH0() do { p0_prologue(F, args); } while (0)
#define PH1() do { pg8::Gemm g{XN, (const bf16*)(ws + WS_W1), LDX, LDX, DM}; pg8::StaticOrder S; S.init(M, DIN, F.G, (int)blockIdx.x); pg8::EpiZ E{Z, LDZ, (float*)(ws + WS_STAT)}; \
        pg8::gemm_phase<pg8::EpiZ, pg8::StaticOrder, PG8_ALIGN, PG8_SP2>(F.lds + RING_OFF, g, S, E); } while (0)
#define PH3() do { pg8::Gemm g{Z + 1024, (const bf16*)(ws + WS_W2), LDZ, LDW2, 2048}; pg8::StaticOrder S; S.init(MP, DM, F.G, (int)blockIdx.x); pg8::EpiGate E{Z + 4096, LDZ, XN, LDX}; \
        pg8::gemm_phase<pg8::EpiGate, pg8::StaticOrder, PG8_ALIGN, PG8_SP2>(F.lds + RING_OFF, g, S, E); \
        small_gemm<1, 8>(F, Z + 1024, LDZ, (const bf16*)(ws + WS_W2), LDW2, XN, LDX, Z + 4096); } while (0)
#define PH4() do { pg8::Gemm g{XN, (const bf16*)(ws + WS_W3), LDX, LDX, DM}; pg8::StaticOrder S; S.init(MP, DM, F.G, (int)blockIdx.x); pg8::EpiBf16 E{(bf16*)(ws + WS_MIX), LDX}; \
        pg8::gemm_phase<pg8::EpiBf16, pg8::StaticOrder, PG8_ALIGN, PG8_SP2>(F.lds + RING_OFF, g, S, E); \
        small_gemm<2, 4>(F, XN, LDX, (const bf16*)(ws + WS_W3), LDX, (bf16*)(ws + WS_MIX), LDX, nullptr); } while (0)
#define PH5() do { p5_rows(F, args); } while (0)
#define PH6() do { pg8::Gemm g{XN, (const bf16*)(ws + WS_W4), LDX, LDX, DM}; pg8::StaticOrder S; S.init(M, DFF2, F.G, (int)blockIdx.x); pg8::EpiSwiGLU E{(bf16*)(ws + WS_FIN), DFF}; \
        pg8::gemm_phase<pg8::EpiSwiGLU, pg8::StaticOrder, PG8_ALIGN, PG8_SP2>(F.lds + RING_OFF, g, S, E); } while (0)
#define PH7() do { pg8::Gemm g{(const bf16*)(ws + WS_FIN), (const bf16*)(ws + WS_W5), DFF, DFF, DFF}; pg8::StaticOrder S; S.init(MP, DM, F.G, (int)blockIdx.x); pg8::EpiBf16 E{(bf16*)(ws + WS_F), LDX}; \
        pg8::gemm_phase<pg8::EpiBf16, pg8::StaticOrder, PG8_ALIGN, PG8_SP2>(F.lds + RING_OFF, g, S, E); \
        small_gemm<2, 11>(F, (const bf16*)(ws + WS_FIN), DFF, (const bf16*)(ws + WS_W5), DFF, (bf16*)(ws + WS_F), LDX, nullptr); } while (0)
#define PH8() do { p8_rows(F, args); } while (0)
#define RUN(k, PH) do { if (IN(k)) { PH(); if (PROBE_DOUBLE == (k)) { GRID_BAR(); PH(); } TS(2 * (k)); if (BOTH(k)) GRID_BAR(); TS(2 * (k) + 1); } } while (0)
    RUN(0, PH0);
    RUN(1, PH1);
    if (IN(2)) {
        for (int it = blockIdx.x; it < 2 * NB * 16; it += F.G) {
            if (it < NB * 16) { const int b = it >> 4, hd = it & 15;
                p2a_item(F, args, b * SEQ, SEQ, hd, nullptr, nullptr, args.out + O_HP + (size_t)b * DM, args.out + O_CP + (size_t)b * 3 * DM); }
            else { const int b = (it - NB * 16) >> 4, hd = it & 15;
                p2a_item(F, args, MP + b * DEC_T, DEC_T, hd, args.in[I_SH] + (size_t)b * DM, args.in[I_SC] + (size_t)b * 3 * DM, args.out + O_HS + (size_t)b * DM, args.out + O_CS + (size_t)b * 3 * DM); }
        }
        TS(40);
        for (int it = blockIdx.x; it < MP / 128; it += F.G) p2b_item(F, args, it, 0, 8);
        for (int it = blockIdx.x; it < 32; it += F.G) p2b_item(F, args, MP / 128 + (it >> 3), it & 7, (it & 7) + 1);
        TS(4);
        if (BOTH(2)) GRID_BAR();
        TS(5);
    }
    RUN(3, PH3);
    RUN(4, PH4);
    RUN(5, PH5);
    RUN(6, PH6);
    RUN(7, PH7);
    RUN(8, PH8);
    if (PROBE_TA >= 0 && blockIdx.x == 0 && F.tid == 0) { const unsigned long long d = (tsb[PROBE_TB] - tsb[PROBE_TA]) * PROBE_MULT, t0 = __builtin_amdgcn_s_memrealtime();
        while (__builtin_amdgcn_s_memrealtime() - t0 < d) __builtin_amdgcn_s_sleep(16); }
#undef IN
#undef BOTH
#undef GRID_BAR
}

extern "C" void kernel_launch(void* const* d_in, const int* in_sizes, int n_in, void* d_out, int out_size, void* d_ws, size_t ws_size, hipStream_t stream) {
    static int grid = 0;
    if (grid == 0) {
        if (n_in != N_IN || in_sizes[0] != MP * DM || (size_t)out_size != O_END || ws_size < WS_END) {
            fprintf(stderr, "kernel_launch: shape mismatch (n_in %d, in0 %d, out %d, ws %zu; need ws >= %zu); nothing launched\n", n_in, n_in > 0 ? in_sizes[0] : -1, out_size, ws_size, (size_t)WS_END); grid = -1; return; }
        int dev = 0, cus = 0, per_cu = 0;
        if (hipGetDevice(&dev) != hipSuccess || hipDeviceGetAttribute(&cus, hipDeviceAttributeMultiprocessorCount, dev) != hipSuccess) { fprintf(stderr, "kernel_launch: device query failed\n"); grid = -1; return; }
        if (hipFuncSetAttribute((const void*)hawk_fwd, hipFuncAttributeMaxDynamicSharedMemorySize, LDS_BYTES) != hipSuccess) { fprintf(stderr, "kernel_launch: hipFuncSetAttribute failed\n"); grid = -1; return; }
        if (hipOccupancyMaxActiveBlocksPerMultiprocessor(&per_cu, (const void*)hawk_fwd, NWAVES * 64, LDS_BYTES) != hipSuccess || per_cu < 1) {
            fprintf(stderr, "kernel_launch: occupancy query reports %d workgroups per CU; nothing launched\n", per_cu); (void)hipGetLastError(); grid = -1; return; }
        grid = cus;
    }
    if (grid < 0) return;
    if (hipMemsetAsync((char*)d_ws + WS_CTL, 0, CTL_ZERO_BYTES, stream) != hipSuccess) { fprintf(stderr, "kernel_launch: memset failed\n"); return; }
    Args a{};
    for (int i = 0; i < N_IN; ++i) a.in[i] = (const float*)d_in[i];
    a.out = (float*)d_out; a.ws = (unsigned char*)d_ws;
    for (int li = 0; li < N_LAUNCHES; ++li) {
        a.ph_lo = (N_LAUNCHES == PER_PHASE) ? li : 0; a.ph_hi = (N_LAUNCHES == PER_PHASE) ? li + 1 : PER_PHASE; a.li = li;
        hipLaunchKernelGGL(hawk_fwd, dim3(grid), dim3(NWAVES * 64), LDS_BYTES, stream, a);
        const hipError_t le = hipPeekAtLastError();
        if (le != hipSuccess) { fprintf(stderr, "kernel_launch: launch %d failed: %s\n", li, hipGetErrorName(le)); break; }
    }
}
```

```cpp
#include <hip/hip_runtime.h>
#include <cstdio>
#include <cstdint>

#ifndef MK_N_LAUNCHES
#define MK_N_LAUNCHES 1
#endif
#ifndef PROBE_TA
#define PROBE_TA -1
#define PROBE_TB -1
#endif
#define PROBE_MULT 4
#ifndef PROBE_DOUBLE
#define PROBE_DOUBLE -1
#endif

namespace pg8 {
#define PG8_LAS __attribute__((address_space(3)))
typedef unsigned short bf16_t;
typedef short bf16x8 __attribute__((ext_vector_type(8)));
typedef float f32x4 __attribute__((ext_vector_type(4)));
typedef unsigned u32x4 __attribute__((ext_vector_type(4)));
constexpr int BM = 256, BK = 64, HALF = 128, HTB = HALF * BK * 2  , STAGE_BYTES = 8 * HTB, NXCD = 8, WGM = 8;

__host__ __device__ __forceinline__ int lds_byte(int r, int c) { const int st = (r >> 4) * 2 + (c >> 5), rr = r & 15, cc = c & 31, ob = rr * 64 + cc * 2; return st * 1024 + (ob ^ (((ob >> 9) & 1) << 5)); }
__host__ __device__ __forceinline__ void stage_rc(int b, int& R, int& C) { const int st = b / 1024, sb = b % 1024, swz = sb ^ (((sb >> 9) & 1) << 5); R = (st >> 1) * 16 + swz / 64; C = (st & 1) * 32 + (swz % 64) / 2; }
__host__ __device__ __forceinline__ int perm32(int rho) { const int n = rho >> 4, i = rho & 15; return 8 * (i >> 2) + 4 * n + (i & 3); }

struct Unit { int pm, pn; };
struct Gemm { const bf16_t* A; const bf16_t* Bt; int lda, ldb, K; };

struct StaticOrder {
    int nM, nN, nwg, G, c;
    __host__ __device__ void init(int M, int N, int G_, int c_) { nM = M / BM; nN = N / BM; nwg = nM * nN; G = G_; c = c_; }
    __host__ __device__ bool next(int i, Unit& u) const {
        const long L = (long)i * G + c; if (L >= nwg) return false;
        int wgid = (int)L; { const int q = nwg / NXCD, r = nwg % NXCD, xcd = wgid % NXCD, off = wgid / NXCD; wgid = (xcd < r ? xcd * (q + 1) : r * (q + 1) + (xcd - r) * q) + off; }
        const int nig = WGM * nN, gid = wgid / nig, fm = gid * WGM, gsz = (nM - fm) < WGM ? (nM - fm) : WGM;
        u.pm = fm + ((wgid % nig) % gsz); u.pn = (wgid % nig) / gsz; return true;
    }
    __device__ __forceinline__ void a_ready(const Unit&) const {}
    __device__ __forceinline__ void done(const Unit&) const {}
};

__device__ __forceinline__ unsigned cvt_pk_bf16(float lo, float hi) { unsigned r; asm volatile("v_cvt_pk_bf16_f32 %0, %1, %2" : "=v"(r) : "v"(lo), "v"(hi)); return r; }
__device__ __forceinline__ float bf_lo(unsigned w) { return __uint_as_float(w << 16); }
__device__ __forceinline__ float bf_hi(unsigned w) { return __uint_as_float(w & 0xffff0000u); }
__device__ __forceinline__ float sigmoid_f(float x) { return __builtin_amdgcn_rcpf(1.0f + __builtin_amdgcn_exp2f(-1.4426950408889634f * x)); }
__device__ __forceinline__ float gelu_tanh_f(float x) { const float t = x * (-2.3022081986f + -0.1029432446f * x * x); return x * __builtin_amdgcn_rcpf(1.0f + __builtin_amdgcn_exp2f(t)); }
__device__ __forceinline__ float silu_f(float x) { return x * sigmoid_f(x); }
typedef float f32x2p __attribute__((ext_vector_type(2)));
__device__ __forceinline__ f32x2p exp2_2(f32x2p v) { return (f32x2p){__builtin_amdgcn_exp2f(v.x), __builtin_amdgcn_exp2f(v.y)}; }
__device__ __forceinline__ f32x2p rcp_2(f32x2p v) { return (f32x2p){__builtin_amdgcn_rcpf(v.x), __builtin_amdgcn_rcpf(v.y)}; }
__device__ __forceinline__ f32x2p gelu2(f32x2p x) { const f32x2p t = x * (x * x * -0.1029432446f + -2.3022081986f); return x * rcp_2(exp2_2(t) + 1.0f); }
__device__ __forceinline__ f32x2p sigmoid2(f32x2p x) { return rcp_2(exp2_2(x * -1.4426950408889634f) + 1.0f); }

struct EpiZ {
    static constexpr bool PERM = true, AFTER_DRAIN = false, HAS_MID = false; static constexpr int TMID = -1;
    bf16_t* Z; int ldc; float* stat;
    __device__ __forceinline__ void mid(f32x4 (&)[2][2][4][2], const Unit&, int, int, int, int) const {}
    __device__ __forceinline__ void operator()(const f32x4 (&acc)[2][2][4][2], const Unit& u, int wr, int wc, int fr, int fq) const {
        int row0 = u.pm * BM + wr * 64 + fr; const int col0 = u.pn * BM + wc * 32 + 8 * fq; asm volatile("" : "+v"(row0));
        const int mode = u.pn < 4 ? 0 : (u.pn < 16 ? 1 : 2);
        const bool vstat = (u.pn >= 12 && u.pn < 16);
#pragma unroll
        for (int ai = 0; ai < 2; ++ai)
#pragma unroll
            for (int m = 0; m < 4; ++m) { bf16_t* rowp = Z + (size_t)(row0 + ai * HALF + m * 16) * ldc + col0; float ssum = 0.f, ssq = 0.f;
#pragma unroll
                for (int bj = 0; bj < 2; ++bj) { const f32x4 v0 = acc[ai][bj][m][0], v1 = acc[ai][bj][m][1];
                    f32x2p a0 = (f32x2p){v0[0], v0[1]}, a1 = (f32x2p){v0[2], v0[3]}, a2 = (f32x2p){v1[0], v1[1]}, a3 = (f32x2p){v1[2], v1[3]};
                    if (mode == 1) { a0 = gelu2(a0); a1 = gelu2(a1); a2 = gelu2(a2); a3 = gelu2(a3); }
                    else if (mode == 2) { a0 = sigmoid2(a0); a1 = sigmoid2(a1); a2 = sigmoid2(a2); a3 = sigmoid2(a3); }
                    if (vstat) { const f32x2p t = (a0 + a1) + (a2 + a3), q = (a0 * a0 + a1 * a1) + (a2 * a2 + a3 * a3); ssum += t.x + t.y; ssq += q.x + q.y; }
                    u32x4 w; w.x = cvt_pk_bf16(a0.x, a0.y); w.y = cvt_pk_bf16(a1.x, a1.y); w.z = cvt_pk_bf16(a2.x, a2.y); w.w = cvt_pk_bf16(a3.x, a3.y);
                    *(u32x4*)(rowp + bj * HALF) = w; }
                if (vstat) { ssum += __shfl_xor(ssum, 16); ssq += __shfl_xor(ssq, 16); ssum += __shfl_xor(ssum, 32); ssq += __shfl_xor(ssq, 32);
                    if (fq == 0) { typedef float f32x2 __attribute__((ext_vector_type(2))); *(f32x2*)(stat + ((size_t)(row0 + ai * HALF + m * 16) * 16 + (u.pn - 12) * 4 + wc) * 2) = (f32x2){ssum, ssq}; } } }
    }
};
struct EpiBf16 {
    static constexpr bool PERM = true, AFTER_DRAIN = false, HAS_MID = false; static constexpr int TMID = -1;
    bf16_t* O; int ldc;
    __device__ __forceinline__ void mid(f32x4 (&)[2][2][4][2], const Unit&, int, int, int, int) const {}
    __device__ __forceinline__ void operator()(const f32x4 (&acc)[2][2][4][2], const Unit& u, int wr, int wc, int fr, int fq) const {
        int row0 = u.pm * BM + wr * 64 + fr; const int col0 = u.pn * BM + wc * 32 + 8 * fq; asm volatile("" : "+v"(row0));
#pragma unroll
        for (int ai = 0; ai < 2; ++ai)
#pragma unroll
            for (int m = 0; m < 4; ++m) { bf16_t* rowp = O + (size_t)(row0 + ai * HALF + m * 16) * ldc + col0;
#pragma unroll
                for (int bj = 0; bj < 2; ++bj) { const f32x4 v0 = acc[ai][bj][m][0], v1 = acc[ai][bj][m][1];
                    u32x4 w; w.x = cvt_pk_bf16(v0[0], v0[1]); w.y = cvt_pk_bf16(v0[2], v0[3]); w.z = cvt_pk_bf16(v1[0], v1[1]); w.w = cvt_pk_bf16(v1[2], v1[3]);
                    *(u32x4*)(rowp + bj * HALF) = w; } }
    }
};
struct EpiGate {
    static constexpr bool PERM = true, AFTER_DRAIN = false, HAS_MID = true; static constexpr int TMID = 16;
    const bf16_t* Zg; int ldz;
    bf16_t* O; int ldc;
    __device__ __forceinline__ void mid(f32x4 (&acc)[2][2][4][2], const Unit& u, int wr, int wc, int fr, int fq) const {
        int row0 = u.pm * BM + wr * 64 + fr; const int col0 = u.pn * BM + wc * 32 + 8 * fq; asm volatile("" : "+v"(row0));
#pragma unroll
        for (int ai = 0; ai < 2; ++ai)
#pragma unroll
            for (int m = 0; m < 4; ++m) { const bf16_t* rowp = Zg + (size_t)(row0 + ai * HALF + m * 16) * ldz + col0;
#pragma unroll
                for (int bj = 0; bj < 2; ++bj) { const u32x4 ga = *(const u32x4*)(rowp + bj * HALF), gb = *(const u32x4*)(rowp + 1024 + bj * HALF);
                    f32x4 r0, r1;
                    r0[0] = bf_lo(ga.x) * __builtin_amdgcn_rcpf(fmaxf(bf_lo(gb.x), 1e-30f)); r0[1] = bf_hi(ga.x) * __builtin_amdgcn_rcpf(fmaxf(bf_hi(gb.x), 1e-30f));
                    r0[2] = bf_lo(ga.y) * __builtin_amdgcn_rcpf(fmaxf(bf_lo(gb.y), 1e-30f)); r0[3] = bf_hi(ga.y) * __builtin_amdgcn_rcpf(fmaxf(bf_hi(gb.y), 1e-30f));
                    r1[0] = bf_lo(ga.z) * __builtin_amdgcn_rcpf(fmaxf(bf_lo(gb.z), 1e-30f)); r1[1] = bf_hi(ga.z) * __builtin_amdgcn_rcpf(fmaxf(bf_hi(gb.z), 1e-30f));
                    r1[2] = bf_lo(ga.w) * __builtin_amdgcn_rcpf(fmaxf(bf_lo(gb.w), 1e-30f)); r1[3] = bf_hi(ga.w) * __builtin_amdgcn_rcpf(fmaxf(bf_hi(gb.w), 1e-30f));
                    acc[ai][bj][m][0] *= r0; acc[ai][bj][m][1] *= r1; } }
    }
    __device__ __forceinline__ void operator()(const f32x4 (&acc)[2][2][4][2], const Unit& u, int wr, int wc, int fr, int fq) const {
        int row0 = u.pm * BM + wr * 64 + fr; const int col0 = u.pn * BM + wc * 32 + 8 * fq; asm volatile("" : "+v"(row0));
#pragma unroll
        for (int ai = 0; ai < 2; ++ai)
#pragma unroll
            for (int m = 0; m < 4; ++m) { const size_t r = (size_t)(row0 + ai * HALF + m * 16);
#pragma unroll
                for (int bj = 0; bj < 2; ++bj) { const u32x4 gb = *(const u32x4*)(Zg + r * ldz + col0 + 1024 + bj * HALF);
                    f32x4 v0 = acc[ai][bj][m][0], v1 = acc[ai][bj][m][1];
                    v0[0] *= fmaxf(bf_lo(gb.x), 1e-30f); v0[1] *= fmaxf(bf_hi(gb.x), 1e-30f); v0[2] *= fmaxf(bf_lo(gb.y), 1e-30f); v0[3] *= fmaxf(bf_hi(gb.y), 1e-30f);
                    v1[0] *= fmaxf(bf_lo(gb.z), 1e-30f); v1[1] *= fmaxf(bf_hi(gb.z), 1e-30f); v1[2] *= fmaxf(bf_lo(gb.w), 1e-30f); v1[3] *= fmaxf(bf_hi(gb.w), 1e-30f);
                    u32x4 w; w.x = cvt_pk_bf16(v0[0], v0[1]); w.y = cvt_pk_bf16(v0[2], v0[3]); w.z = cvt_pk_bf16(v1[0], v1[1]); w.w = cvt_pk_bf16(v1[2], v1[3]);
                    *(u32x4*)(O + r * ldc + col0 + bj * HALF) = w; } }
    }
};
struct EpiSwiGLU {
    static constexpr bool PERM = true, AFTER_DRAIN = false, HAS_MID = false; static constexpr int TMID = -1;
    bf16_t* O; int ldc;
    __device__ __forceinline__ void mid(f32x4 (&)[2][2][4][2], const Unit&, int, int, int, int) const {}
    __device__ __forceinline__ void operator()(const f32x4 (&acc)[2][2][4][2], const Unit& u, int wr, int wc, int fr, int fq) const {
        int row0 = u.pm * BM + wr * 64 + fr; const int col0 = u.pn * HALF + wc * 32 + 8 * fq; asm volatile("" : "+v"(row0));
#pragma unroll
        for (int ai = 0; ai < 2; ++ai)
#pragma unroll
            for (int m = 0; m < 4; ++m) { bf16_t* rowp = O + (size_t)(row0 + ai * HALF + m * 16) * ldc + col0;
                const f32x4 g0 = acc[ai][0][m][0], g1 = acc[ai][0][m][1], u0 = acc[ai][1][m][0], u1 = acc[ai][1][m][1];
                const f32x2p ga = (f32x2p){g0[0], g0[1]}, gb = (f32x2p){g0[2], g0[3]}, gc = (f32x2p){g1[0], g1[1]}, gd = (f32x2p){g1[2], g1[3]};
                const f32x2p oa = ga * sigmoid2(ga) * (f32x2p){u0[0], u0[1]}, ob = gb * sigmoid2(gb) * (f32x2p){u0[2], u0[3]}, oc = gc * sigmoid2(gc) * (f32x2p){u1[0], u1[1]}, od = gd * sigmoid2(gd) * (f32x2p){u1[2], u1[3]};
                u32x4 w; w.x = cvt_pk_bf16(oa.x, oa.y); w.y = cvt_pk_bf16(ob.x, ob.y); w.z = cvt_pk_bf16(oc.x, oc.y); w.w = cvt_pk_bf16(od.x, od.y);
                *(u32x4*)rowp = w; }
    }
};

template <class Epi, class Sched, bool ALIGN_EPI = false, bool SP2 = false>
__device__ __forceinline__ void gemm_phase(PG8_LAS unsigned char* lds, const Gemm g, const Sched& S, const Epi& E) {
    const int tid = threadIdx.x, wid = __builtin_amdgcn_readfirstlane(tid >> 6), lane = tid & 63, wr = wid >> 2, wc = wid & 3, fr = lane & 15, fq = lane >> 4;
    const int K = g.K, nt = K / BK;
    unsigned voffA[2], voffB[2];
#pragma unroll
    for (int i = 0; i < 2; ++i) { int R, C; stage_rc(tid * 16 + i * 8192, R, C); const int Rb = Epi::PERM ? ((R & ~31) + perm32(R & 31)) : R;
        voffA[i] = (unsigned)(R * g.lda + C) * 2u; voffB[i] = (unsigned)(Rb * g.ldb + C) * 2u; }
    const size_t kstep = (size_t)(BK * 2);
    const size_t hstepA = (size_t)HALF * g.lda * 2, hstepB = (size_t)HALF * g.ldb * 2;
    const size_t tstepA = 2 * hstepA, tstepB = 2 * hstepB;
    const unsigned ldsw = (unsigned)wid * 1024u;
    const int aoff = lds_byte(wr * 64 + fr, fq * 8), boff = lds_byte(wc * 32 + fr, fq * 8);
#define PG8_SA(b, h) (((b) * 2 + (h)) * HTB)
#define PG8_SB(b, h) ((4 + (b) * 2 + (h)) * HTB)
#define PG8_STAGE(bufoff, gbase, voff) do { _Pragma("unroll") for (int _i = 0; _i < 2; ++_i) \
        __builtin_amdgcn_global_load_lds((const unsigned*)((const char*)(gbase) + (voff)[_i]), (PG8_LAS unsigned*)(lds + (bufoff) + ldsw + _i * 8192), 16, 0, 0); } while (0)
#define PG8_LDA(dst, b, h) do { _Pragma("unroll") for (int m = 0; m < 4; ++m) _Pragma("unroll") for (int k = 0; k < 2; ++k) dst[m][k] = *(const PG8_LAS bf16x8*)(lds + PG8_SA(b, h) + aoff + m * 2048 + k * 1024); } while (0)
#define PG8_LDB(dst, b, h) do { _Pragma("unroll") for (int n = 0; n < 2; ++n) _Pragma("unroll") for (int k = 0; k < 2; ++k) dst[n][k] = *(const PG8_LAS bf16x8*)(lds + PG8_SB(b, h) + boff + n * 2048 + k * 1024); } while (0)
#define PG8_MMA(ai, bj, At, Bt) do { __builtin_amdgcn_s_setprio(1); _Pragma("unroll") for (int m = 0; m < 4; ++m) _Pragma("unroll") for (int n = 0; n < 2; ++n) _Pragma("unroll") for (int k = 0; k < 2; ++k) \
        acc[ai][bj][m][n] = __builtin_amdgcn_mfma_f32_16x16x32_bf16(Bt[n][k], At[m][k], acc[ai][bj][m][n], 0, 0, 0); __builtin_amdgcn_s_setprio(0); } while (0)
#define PG8_WAIT_V(n) asm volatile("s_waitcnt vmcnt(" #n ")" ::: "memory")
#define PG8_WAIT_L(n) asm volatile("s_waitcnt lgkmcnt(" #n ")" ::: "memory")
#define PG8_BAR __builtin_amdgcn_s_barrier()
#define PG8_SCHED __builtin_amdgcn_sched_barrier(0)
    Unit cur, nxt; int ui = 0;
    if (!S.next(0, cur)) return;
    f32x4 acc[2][2][4][2];
#pragma unroll
    for (int a = 0; a < 2; ++a)
#pragma unroll
        for (int b = 0; b < 2; ++b)
#pragma unroll
            for (int m = 0; m < 4; ++m)
#pragma unroll
                for (int n = 0; n < 2; ++n) acc[a][b][m][n] = (f32x4){0.f, 0.f, 0.f, 0.f};
    bf16x8 At[4][2], B0[2][2], B1[2][2];
    const char* cA = (const char*)g.A + (size_t)cur.pm * tstepA; const char* cB = (const char*)g.Bt + (size_t)cur.pn * tstepB;
    S.a_ready(cur);
    if constexpr (SP2) {
        PG8_STAGE(PG8_SB(0, 0), cB, voffB); PG8_STAGE(PG8_SB(0, 1), cB + hstepB, voffB); PG8_STAGE(PG8_SA(0, 0), cA, voffA); PG8_STAGE(PG8_SA(0, 1), cA + hstepA, voffA);
        if (wr == 1) PG8_BAR;
        PG8_WAIT_V(2); PG8_BAR;
        PG8_STAGE(PG8_SB(1, 0), cB + kstep, voffB); PG8_STAGE(PG8_SA(1, 0), cA + kstep, voffA); PG8_STAGE(PG8_SB(1, 1), cB + hstepB + kstep, voffB);
        PG8_WAIT_V(6); PG8_BAR;
    } else {
        PG8_STAGE(PG8_SB(0, 0), cB, voffB); PG8_STAGE(PG8_SA(0, 0), cA, voffA); PG8_STAGE(PG8_SB(0, 1), cB + hstepB, voffB); PG8_STAGE(PG8_SA(0, 1), cA + hstepA, voffA);
        if (wr == 1) PG8_BAR;
        PG8_WAIT_V(4); PG8_BAR;
        PG8_STAGE(PG8_SB(1, 0), cB + kstep, voffB); PG8_STAGE(PG8_SA(1, 0), cA + kstep, voffA); PG8_STAGE(PG8_SB(1, 1), cB + hstepB + kstep, voffB);
        PG8_WAIT_V(6); PG8_BAR;
    }
    for (;;) {
        const bool has_next = S.next(ui + 1, nxt);
        const char* nA = has_next ? (const char*)g.A + (size_t)nxt.pm * tstepA : cA; const char* nB = has_next ? (const char*)g.Bt + (size_t)nxt.pn * tstepB : cB;
        for (int t = 0; t < nt; t += 2) {
            const bool last = (t == nt - 2);
            const char* a1 = cA + (size_t)(t + 1) * kstep;
            const char* a2 = last ? nA : cA + (size_t)(t + 2) * kstep; const char* b2 = last ? nB : cB + (size_t)(t + 2) * kstep;
            const char* a3 = a2 + kstep; const char* b3 = b2 + kstep;
            if (last && has_next) S.a_ready(nxt);
            if constexpr (Epi::HAS_MID) { if (t == Epi::TMID) E.mid(acc, cur, wr, wc, fr, fq); }
            if constexpr (SP2) {
            PG8_LDB(B0, 0, 0); PG8_LDB(B1, 0, 1); PG8_SCHED; PG8_LDA(At, 0, 0); PG8_STAGE(PG8_SA(1, 1), a1 + hstepA, voffA);
            PG8_WAIT_V(8); PG8_WAIT_L(0); PG8_BAR; PG8_MMA(0, 0, At, B0); PG8_MMA(0, 1, At, B1); PG8_BAR; PG8_SCHED;
            PG8_LDA(At, 0, 1); PG8_STAGE(PG8_SB(0, 0), b2, voffB); PG8_STAGE(PG8_SB(0, 1), b2 + hstepB, voffB); PG8_STAGE(PG8_SA(0, 0), a2, voffA);
            PG8_WAIT_V(8); PG8_WAIT_L(0); PG8_BAR; PG8_MMA(1, 0, At, B0); PG8_MMA(1, 1, At, B1); PG8_BAR; PG8_SCHED;
            PG8_LDB(B0, 1, 0); PG8_LDB(B1, 1, 1); PG8_SCHED; PG8_LDA(At, 1, 0); PG8_STAGE(PG8_SA(0, 1), a2 + hstepA, voffA);
            PG8_WAIT_V(8); PG8_WAIT_L(0); PG8_BAR; PG8_MMA(0, 0, At, B0); PG8_MMA(0, 1, At, B1); PG8_BAR; PG8_SCHED;
            PG8_LDA(At, 1, 1); PG8_STAGE(PG8_SB(1, 0), b3, voffB); PG8_STAGE(PG8_SB(1, 1), b3 + hstepB, voffB); PG8_STAGE(PG8_SA(1, 0), a3, voffA);
            PG8_WAIT_V(8); PG8_WAIT_L(0); PG8_BAR; PG8_MMA(1, 0, At, B0); PG8_MMA(1, 1, At, B1); PG8_BAR; PG8_SCHED;
            } else {
            PG8_LDB(B0, 0, 0); PG8_SCHED; PG8_LDA(At, 0, 0); PG8_STAGE(PG8_SA(1, 1), a1 + hstepA, voffA);
            PG8_WAIT_L(8); PG8_BAR; PG8_WAIT_L(0); PG8_MMA(0, 0, At, B0); PG8_BAR; PG8_SCHED;
            PG8_LDB(B1, 0, 1); PG8_STAGE(PG8_SB(0, 0), b2, voffB);
            PG8_BAR; PG8_WAIT_L(0); PG8_MMA(0, 1, At, B1); PG8_BAR;
            PG8_LDA(At, 0, 1); PG8_STAGE(PG8_SA(0, 0), a2, voffA);
            PG8_BAR; PG8_WAIT_L(0); PG8_MMA(1, 0, At, B0); PG8_BAR; PG8_SCHED;
            PG8_STAGE(PG8_SB(0, 1), b2 + hstepB, voffB);
            PG8_WAIT_V(6); PG8_BAR; PG8_MMA(1, 1, At, B1); PG8_BAR;
            PG8_LDB(B0, 1, 0); PG8_SCHED; PG8_LDA(At, 1, 0); PG8_STAGE(PG8_SA(0, 1), a2 + hstepA, voffA);
            PG8_WAIT_L(8); PG8_BAR; PG8_WAIT_L(0); PG8_MMA(0, 0, At, B0); PG8_BAR; PG8_SCHED;
            PG8_LDB(B1, 1, 1); PG8_STAGE(PG8_SB(1, 0), b3, voffB);
            PG8_BAR; PG8_WAIT_L(0); PG8_MMA(0, 1, At, B1); PG8_BAR;
            PG8_LDA(At, 1, 1); PG8_STAGE(PG8_SA(1, 0), a3, voffA);
            PG8_BAR; PG8_WAIT_L(0); PG8_MMA(1, 0, At, B0); PG8_BAR; PG8_SCHED;
            PG8_STAGE(PG8_SB(1, 1), b3 + hstepB, voffB);
            PG8_WAIT_V(6); PG8_BAR; PG8_MMA(1, 1, At, B1); PG8_BAR;
            }
        }
        if constexpr (ALIGN_EPI) { if (wr == 0) PG8_BAR; }
        E(acc, cur, wr, wc, fr, fq); S.done(cur);
        if (!has_next) break;
#pragma unroll
        for (int a = 0; a < 2; ++a)
#pragma unroll
            for (int b = 0; b < 2; ++b)
#pragma unroll
                for (int m = 0; m < 4; ++m)
#pragma unroll
                    for (int n = 0; n < 2; ++n) acc[a][b][m][n] = (f32x4){0.f, 0.f, 0.f, 0.f};
        cur = nxt; cA = nA; cB = nB; ++ui;
        if constexpr (ALIGN_EPI) { if (wr == 1) PG8_BAR; }
    }
    PG8_WAIT_V(0);
    if constexpr (!ALIGN_EPI) { if (wr == 0) PG8_BAR; }
    PG8_BAR;
#undef PG8_SA
#undef PG8_SB
#undef PG8_STAGE
#undef PG8_LDA
#undef PG8_LDB
#undef PG8_MMA
#undef PG8_WAIT_V
#undef PG8_WAIT_L
#undef PG8_BAR
#undef PG8_SCHED
}
}

#ifndef PG8_SP2
#define PG8_SP2 true
#endif
#ifndef PG8_ALIGN
#define PG8_ALIGN true
#endif

constexpr int NWAVES = 8;
constexpr int N_LAUNCHES = MK_N_LAUNCHES;
constexpr int PER_PHASE = 9;
constexpr int DM = 1024, SEQ = 2048, NB = 16, DEC_T = 32;
constexpr int MP = NB * SEQ, MS = NB * DEC_T, M = MP + MS;
constexpr int DIN = 6144, DFF = 2816, DFF2 = 5632;
constexpr int LDX = 1088, LDZ = 6208, LDW2 = 2112;
constexpr float EPS = 1e-6f;
static_assert(M % 256 == 0, "M");
enum { I_XP = 0, I_XS, I_SH, I_SC, I_GPRE, I_WIN, I_CW, I_CB, I_WA, I_BA, I_WX, I_BX, I_LAM, I_WBRA, I_LNG, I_LNB, I_WS, I_BS, I_WBRB, I_WOUT, I_GPOST, I_GFFN, I_WFI, I_WFO, I_GPF, N_IN };
constexpr size_t O_Y = 0, O_HP = (size_t)M * DM, O_CP = O_HP + NB * DM, O_HS = O_CP + (size_t)NB * 3 * DM, O_CS = O_HS + NB * DM, O_VS = O_CS + (size_t)NB * 3 * DM, O_END = O_VS + (size_t)MS * DM;
static_assert(O_END == 34734080, "output size");

constexpr size_t MiB = 1u << 20;
constexpr size_t WS_CTL = 0, CTL_ZERO_BYTES = 1 * MiB;
constexpr size_t WS_W1 = 1 * MiB;
constexpr size_t WS_W2 = WS_W1 + (size_t)DIN * LDX * 2;
constexpr size_t WS_W3 = WS_W2 + (size_t)DM * LDW2 * 2;
constexpr size_t WS_W4 = WS_W3 + (size_t)DM * LDX * 2;
constexpr size_t WS_W5 = WS_W4 + (size_t)DFF2 * LDX * 2;
constexpr size_t WS_GT = WS_W5 + (size_t)DM * DFF * 2;
constexpr size_t WS_WSM = WS_GT + 16 * 128 * 64 * 2;
constexpr size_t WS_WSS = WS_WSM + 8 * 128 * 128 * 2;
constexpr size_t WS_WEND = WS_WSS + 8 * 128 * 128 * 2;
constexpr size_t WS_XN = 39 * MiB;
constexpr size_t WS_Z = 109 * MiB;
constexpr size_t WS_MIX = WS_Z;
constexpr size_t WS_FIN = WS_Z + 70 * MiB;
constexpr size_t WS_F = WS_FIN + 179 * MiB;
constexpr size_t WS_STAT = 504 * MiB;
constexpr size_t WS_END = WS_STAT + (size_t)M * 16 * 2 * 4;
static_assert(WS_WEND <= WS_XN && WS_XN + (size_t)M * LDX * 2 <= WS_Z && WS_MIX + (size_t)M * LDX * 2 <= WS_FIN && WS_FIN + (size_t)M * DFF * 2 <= WS_F && WS_F + (size_t)M * LDX * 2 <= WS_Z + (size_t)M * LDZ * 2 && WS_Z + (size_t)M * LDZ * 2 <= WS_STAT && WS_END <= 512 * MiB, "d_ws map");
constexpr int CW_TMO = 0, CW_BAR = 4096;

constexpr int RING_OFF = 0, RING_BYTES = 131072;
constexpr int LDSCTL_OFF = 139264, MISC_OFF = LDSCTL_OFF + 320;
constexpr int LDS_BYTES = 147456;

#define GAS __attribute__((address_space(1)))
#define LAS __attribute__((address_space(3)))
typedef unsigned short bf16;
typedef unsigned v4u __attribute__((ext_vector_type(4)));
typedef unsigned v2u __attribute__((ext_vector_type(2)));
typedef float f32x4 __attribute__((ext_vector_type(4)));
typedef float f32x16 __attribute__((ext_vector_type(16)));
typedef short bf16x8 __attribute__((ext_vector_type(8)));
typedef GAS unsigned gu32;
#define RLX_AGENT __ATOMIC_RELAXED, __HIP_MEMORY_SCOPE_AGENT
#define LDS_WAIT() asm volatile("s_waitcnt lgkmcnt(0)" ::: "memory")
#define VM_WAIT() asm volatile("s_waitcnt vmcnt(0)" ::: "memory")
__device__ __forceinline__ unsigned f2bf(float f) { unsigned u = __builtin_bit_cast(unsigned, f); return (u + 0x7fffu + ((u >> 16) & 1u)) >> 16; }
__device__ __forceinline__ unsigned pk2(float lo, float hi) { unsigned r; asm volatile("v_cvt_pk_bf16_f32 %0, %1, %2" : "=v"(r) : "v"(lo), "v"(hi)); return r; }
__device__ __forceinline__ float bflo(unsigned w) { return __uint_as_float(w << 16); }
__device__ __forceinline__ float bfhi(unsigned w) { return __uint_as_float(w & 0xffff0000u); }

#define XB_TMO      128
#define XB_XCNT(j)  (256  + 64 * (j))
#define XB_XSUB(j)  (1280 + 64 * (j))
#define XB_XGEN(j)  (2304 + 64 * (j))
#define XB_TOP      3328
#define XB_TOPGEN   3392
#define XCD_BAR_WORDS 3456
#define XB_SPIN_CAP (1u << 22)

__device__ __forceinline__ unsigned xb_ld(unsigned* p)              { return __hip_atomic_load(p, __ATOMIC_RELAXED, __HIP_MEMORY_SCOPE_AGENT); }
__device__ __forceinline__ unsigned xb_add(unsigned* p, unsigned v) { return __hip_atomic_fetch_add(p, v, __ATOMIC_RELAXED, __HIP_MEMORY_SCOPE_AGENT); }
__device__ __forceinline__ unsigned xb_xcc_id() { return (unsigned)__builtin_amdgcn_s_getreg((3 << 11) | 20) & 0xFu; }
#define XB_SPIN(cond, bar) do { unsigned _sp = 0; while (cond) { __builtin_amdgcn_s_sleep(1); \
    if ((++_sp & 255u) == 0u) { if (xb_ld(&(bar)[XB_TMO])) break; if (_sp > XB_SPIN_CAP) { atomicAdd(&(bar)[XB_TMO], 1u); break; } } } } while (0)

struct XcdBarrier { unsigned* bar; unsigned x; volatile LAS unsigned* st; };

__device__ __forceinline__ XcdBarrier xcd_barrier_post(unsigned* bar, volatile LAS unsigned* st) {
    XcdBarrier b; b.bar = bar; b.x = xb_xcc_id(); b.st = st;
    if (threadIdx.x == 0) (void)xb_add(&bar[XB_XCNT(b.x)], 1u);
    return b;
}
__device__ __forceinline__ void xcd_barrier_complete(unsigned* bar, unsigned x, unsigned& nloc, unsigned& nx) {
    const unsigned G = gridDim.x * gridDim.y * gridDim.z;
    unsigned sum, cnt, mine, sp = 0u;
    for (;;) {
        sum = 0u; cnt = 0u; mine = 0u;
#pragma unroll
        for (unsigned j = 0; j < 16; ++j) { const unsigned c = xb_ld(&bar[XB_XCNT(j)]); sum += c; cnt += (c > 0u) ? 1u : 0u; mine = (j == x) ? c : mine; }
        if (sum == G) break;
        __builtin_amdgcn_s_sleep(1);
        if ((++sp & 255u) == 0u) { if (xb_ld(&bar[XB_TMO])) break; if (sp > XB_SPIN_CAP) { atomicAdd(&bar[XB_TMO], 1u); break; } }
    }
    nloc = mine > 0u ? mine : 1u; nx = cnt > 0u ? cnt : 1u;
}
__device__ __forceinline__ void xcd_barrier(const XcdBarrier& b) {
    asm volatile("s_waitcnt vmcnt(0)" ::: "memory");
    __syncthreads();
    if (threadIdx.x == 0) {
        unsigned* bar = b.bar;
        __builtin_amdgcn_s_waitcnt(0);
        unsigned nloc = b.st[0], nx = b.st[1];
        if (nloc == 0u) { xcd_barrier_complete(bar, b.x, nloc, nx); b.st[0] = nloc; b.st[1] = nx; }
        const unsigned old = xb_add(&bar[XB_XSUB(b.x)], 1u);
        const unsigned gen = old / nloc;
        if (old + 1u == (gen + 1u) * nloc) {
            __builtin_amdgcn_fence(__ATOMIC_RELEASE, "agent");
            asm volatile("s_waitcnt vmcnt(0)" ::: "memory");
            const unsigned og = xb_add(&bar[XB_TOP], 1u);
            const unsigned tg = og / nx;
            if (og + 1u == (tg + 1u) * nx) xb_add(&bar[XB_TOPGEN], 1u);
            else XB_SPIN(xb_ld(&bar[XB_TOPGEN]) == tg, bar);
            __builtin_amdgcn_fence(__ATOMIC_ACQUIRE, "agent");
            xb_add(&bar[XB_XGEN(b.x)], 1u);
            asm volatile("s_waitcnt vmcnt(0)" ::: "memory");
        } else {
            XB_SPIN(xb_ld(&bar[XB_XGEN(b.x)]) == gen, bar);
            __builtin_amdgcn_fence(__ATOMIC_ACQUIRE, "agent");
            asm volatile("s_waitcnt vmcnt(0)" ::: "memory");
        }
    }
    __syncthreads();
}

struct Args { const float* in[N_IN]; float* out; unsigned char* ws; int ph_lo, ph_hi, li, pad; };
struct Frame {
    LAS unsigned char* lds;
    volatile LAS unsigned* MISC;
    gu32* ctl;
    int tid, lane, wave, vcu, G;
};
__device__ __forceinline__ float wave_sum(float v) {
#pragma unroll
    for (int o = 1; o < 64; o <<= 1) v += __shfl_xor(v, o);
    return v;
}
__device__ __forceinline__ const float* xrow_ptr(const Args& a, int m) { return m < MP ? a.in[I_XP] + (size_t)m * DM : a.in[I_XS] + (size_t)(m - MP) * DM; }

__device__ __forceinline__ void p0_transpose_item(const float* W, int N, bf16* WT, int ldk, int dcol0, int k0, int n0, int drow0, LAS float* scr, int lane) {
#pragma unroll 8
    for (int i = 0; i < 32; ++i) { const int kk = 2 * i + (lane >> 5); scr[kk * 33 + (lane & 31)] = W[(size_t)(k0 + kk) * N + n0 + (lane & 31)]; }
    LDS_WAIT(); asm volatile("" ::: "memory");
    const int c = lane & 7;
#pragma unroll
    for (int j = 0; j < 4; ++j) { const int n = (lane >> 3) + 8 * j; const LAS float* s = scr + (8 * c) * 33 + n;
        v4u o; o.x = pk2(s[0 * 33], s[1 * 33]); o.y = pk2(s[2 * 33], s[3 * 33]); o.z = pk2(s[4 * 33], s[5 * 33]); o.w = pk2(s[6 * 33], s[7 * 33]);
        *(GAS v4u*)(WT + (size_t)(drow0 + n) * ldk + dcol0 + k0 + 8 * c) = o; }
    LDS_WAIT(); asm volatile("" ::: "memory");
}

__device__ __forceinline__ void p0_items(Frame& F, const Args& a, int stage, int gw, int NGW) {
    unsigned char* ws = a.ws;
    LAS float* scr = (LAS float*)(F.lds + RING_OFF + F.wave * 16384);
    constexpr int I1 = (DM / 64) * (DIN / 32), I2 = (DM / 64) * (DM / 32), I4 = (DM / 64) * (DFF2 / 32), I5 = (DFF / 64) * (DM / 32), IG = 64;
    if (stage == 0) {
        for (int it = gw; it < I1 + IG; it += NGW) {
            int r = it;
            if (r < I1) { const int nb = DIN / 32, kb = r / nb, n0 = 32 * (r % nb); p0_transpose_item(a.in[I_WIN], DIN, (bf16*)(ws + WS_W1), LDX, 0, 64 * kb, n0, n0, scr, F.lane); continue; } r -= I1;
            { const int hd = r >> 2, which = (r >> 1) & 1, n0 = 32 * (r & 1);
              p0_transpose_item((which ? a.in[I_WX] : a.in[I_WA]) + (size_t)hd * 4096, 64, (bf16*)(ws + WS_GT) + (size_t)hd * 8192, 64, 0, 0, n0, which * 64 + n0, scr, F.lane); }
        }
    } else if (stage == 1) {
        for (int it = gw; it < 3 * I2 + I4; it += NGW) {
            int r = it;
            if (r < I2) { const int nb = DM / 32, kb = r / nb, n0 = 32 * (r % nb); p0_transpose_item(a.in[I_WBRA], DM, (bf16*)(ws + WS_W2), LDW2, 0, 64 * kb, n0, n0, scr, F.lane); continue; } r -= I2;
            if (r < I2) { const int nb = DM / 32, kb = r / nb, n0 = 32 * (r % nb); p0_transpose_item(a.in[I_WBRB], DM, (bf16*)(ws + WS_W2), LDW2, 1024, 64 * kb, n0, n0, scr, F.lane); continue; } r -= I2;
            if (r < I2) { const int nb = DM / 32, kb = r / nb, n0 = 32 * (r % nb); p0_transpose_item(a.in[I_WOUT], DM, (bf16*)(ws + WS_W3), LDX, 0, 64 * kb, n0, n0, scr, F.lane); continue; } r -= I2;
            { const int nb = DFF2 / 32, kb = r / nb, n0 = 32 * (r % nb); const int s = n0 / DFF, j0 = n0 % DFF, drow0 = 256 * (j0 / 128) + 128 * s + (j0 % 128);
              p0_transpose_item(a.in[I_WFI], DFF2, (bf16*)(ws + WS_W4), LDX, 0, 64 * kb, n0, drow0, scr, F.lane); }
        }
    } else {
        for (int it = gw; it < I5; it += NGW) { const int nb = DM / 32, kb = it / nb, n0 = 32 * (it % nb); p0_transpose_item(a.in[I_WFO], DM, (bf16*)(ws + WS_W5), DFF, 0, 64 * kb, n0, n0, scr, F.lane); }
    }
}
__device__ __forceinline__ void p0_prologue(Frame& F, const Args& a) {
    unsigned char* ws = a.ws;
    const int gw = F.vcu * NWAVES + F.wave, NGW = F.G * NWAVES;
    p0_items(F, a, 0, gw, NGW);
    { const float* wsp = a.in[I_WS]; bf16* wsm = (bf16*)(ws + WS_WSM); bf16* wss = (bf16*)(ws + WS_WSS);
      for (int i = gw * 64 + F.lane; i < 8 * 128 * 128; i += NGW * 64) { const int g = i >> 14, p = (i >> 7) & 127, q = i & 127;
          wsm[i] = (bf16)(((q >> 6) <= (p >> 6)) ? f2bf(wsp[i]) : 0u);
          wss[i] = (bf16)(((q >> 5) == (p >> 5)) ? f2bf(wsp[(g << 14) + ((p & 31) << 7) + (q & 31)]) : 0u); } }
    { const GAS f32x4* gp = (const GAS f32x4*)a.in[I_GPRE] + F.lane; f32x4 gg[4];
#pragma unroll
      for (int j = 0; j < 4; ++j) gg[j] = gp[64 * j];
      bf16* XN = (bf16*)(ws + WS_XN);
      for (int m0 = gw * 4; m0 < M; m0 += NGW * 4) { f32x4 v[4][4];
#pragma unroll
          for (int r = 0; r < 4; ++r) { const GAS f32x4* xr = (const GAS f32x4*)xrow_ptr(a, m0 + r) + F.lane;
#pragma unroll
              for (int j = 0; j < 4; ++j) v[r][j] = xr[64 * j]; }
#pragma unroll
          for (int r = 0; r < 4; ++r) { float s = 0.f;
#pragma unroll
              for (int j = 0; j < 4; ++j) s += (v[r][j].x * v[r][j].x + v[r][j].y * v[r][j].y) + (v[r][j].z * v[r][j].z + v[r][j].w * v[r][j].w);
              const float rstd = __builtin_amdgcn_rsqf(wave_sum(s) * (1.f / DM) + EPS);
              GAS v2u* o8 = (GAS v2u*)(XN + (size_t)(m0 + r) * LDX) + F.lane;
#pragma unroll
              for (int j = 0; j < 4; ++j) { v2u o; o.x = pk2(v[r][j].x * rstd * gg[j].x, v[r][j].y * rstd * gg[j].y); o.y = pk2(v[r][j].z * rstd * gg[j].z, v[r][j].w * rstd * gg[j].w); o8[64 * j] = o; } } } }
}

__device__ __forceinline__ void p2a_item(Frame& F, const Args& a, int row0, int T, int hd, const float* h0, const float* cprev, float* out_h, float* out_conv) {
    LAS unsigned char* lds = F.lds;
    LAS float* XC = (LAS float*)(lds);
    LAS float* AS = (LAS float*)(lds + 32768);
    LAS float* US = (LAS float*)(lds + 65536);
    LAS bf16* XCB = (LAS bf16*)(lds + 98304);
    LAS float* SEGA = (LAS float*)(lds + 116736);
    LAS float* SEGB = (LAS float*)(lds + 118784);
    LAS float* CAR = (LAS float*)(lds + 120832);
    bf16* Z = (bf16*)(a.ws + WS_Z);
    const int tid = F.tid, lane = F.lane, wave = F.wave;
    const int tr = tid >> 3, cg = tid & 7, ch0 = hd * 64 + cg * 8;
    const int tb = wave >> 1, cb = wave & 1, jl = cb * 32 + (lane & 31), hi = lane >> 5;
    __syncthreads();
    typedef float f32x2c __attribute__((ext_vector_type(2)));
    f32x2c cw2[4][4], cbv2[4];
#pragma unroll
    for (int k = 0; k < 4; ++k) { const f32x4 w0 = *(const GAS f32x4*)(a.in[I_CW] + k * DM + ch0), w1 = *(const GAS f32x4*)(a.in[I_CW] + k * DM + ch0 + 4);
        cw2[k][0] = (f32x2c){w0.x, w0.y}; cw2[k][1] = (f32x2c){w0.z, w0.w}; cw2[k][2] = (f32x2c){w1.x, w1.y}; cw2[k][3] = (f32x2c){w1.z, w1.w}; }
    { const f32x4 w0 = *(const GAS f32x4*)(a.in[I_CB] + ch0), w1 = *(const GAS f32x4*)(a.in[I_CB] + ch0 + 4);
      cbv2[0] = (f32x2c){w0.x, w0.y}; cbv2[1] = (f32x2c){w0.z, w0.w}; cbv2[2] = (f32x2c){w1.x, w1.y}; cbv2[3] = (f32x2c){w1.z, w1.w}; }
    bf16x8 Br[4], Bi[4];
    { const bf16* gt = (const bf16*)(a.ws + WS_GT) + (size_t)hd * 8192;
#pragma unroll
      for (int ks = 0; ks < 4; ++ks) { Br[ks] = *(const GAS bf16x8*)(gt + jl * 64 + ks * 16 + hi * 8); Bi[ks] = *(const GAS bf16x8*)(gt + (64 + jl) * 64 + ks * 16 + hi * 8); } }
    float nba = -1.4426950408889634f * a.in[I_BA][hd * 64 + jl], nbx = -1.4426950408889634f * a.in[I_BX][hd * 64 + jl];
    float cA = -8.0f * log1pf(expf(-a.in[I_LAM][hd * 64 + jl])) * 1.4426950408889634f;
    asm volatile("" : "+v"(cA), "+v"(nba), "+v"(nbx));
    if (tid < 64) CAR[tid] = h0 ? h0[hd * 64 + tid] : 0.f;
    const int ntiles = (T + 127) >> 7;
    typedef float f32x2 __attribute__((ext_vector_type(2)));
    v4u xr[5], gg[2];
    const unsigned zbase = (unsigned)row0 * LDZ + ch0;
#define P2A_ISSUE(t0n) do { _Pragma("unroll") for (int r = 0; r < 5; ++r) { int tt = (t0n) + 2 * tr - 3 + r; tt = tt < 0 ? 0 : (tt > T - 1 ? T - 1 : tt); \
        xr[r] = *(const GAS v4u*)(Z + (zbase + (unsigned)tt * LDZ)); } } while (0)
    P2A_ISSUE(0);
    const int pc = tid & 31, sg8 = tid >> 5;
    for (int tile = 0; tile < ntiles; ++tile) {
        const int t0 = tile << 7, nrows = (T - t0) < 128 ? (T - t0) : 128, par = tile & 1;
        {
            f32x2 f[5][4];
#pragma unroll
            for (int r = 0; r < 5; ++r) { const v4u w = xr[r];
                f[r][0] = (f32x2){bflo(w.x), bfhi(w.x)}; f[r][1] = (f32x2){bflo(w.y), bfhi(w.y)}; f[r][2] = (f32x2){bflo(w.z), bfhi(w.z)}; f[r][3] = (f32x2){bflo(w.w), bfhi(w.w)}; }
            if (tile == 0 || nrows < 128) {
#pragma unroll
                for (int r = 0; r < 5; ++r) { const int tt = t0 + 2 * tr - 3 + r;
                    if (tt < 0) {
                        if (cprev) { const f32x4 p0 = *(const GAS f32x4*)(cprev + (tt + 3) * DM + ch0), p1 = *(const GAS f32x4*)(cprev + (tt + 3) * DM + ch0 + 4);
                            f[r][0] = (f32x2){p0.x, p0.y}; f[r][1] = (f32x2){p0.z, p0.w}; f[r][2] = (f32x2){p1.x, p1.y}; f[r][3] = (f32x2){p1.z, p1.w}; }
                        else {
#pragma unroll
                            for (int e = 0; e < 4; ++e) f[r][e] = (f32x2){0.f, 0.f}; }
                    } else if (tt >= T) {
#pragma unroll
                        for (int e = 0; e < 4; ++e) f[r][e] = (f32x2){0.f, 0.f}; } } }
            if (tile + 1 < ntiles) P2A_ISSUE(t0 + 128);
#pragma unroll
            for (int rr = 0; rr < 2; ++rr) { int tl = 2 * tr + rr; tl = tl < nrows ? tl : nrows - 1; gg[rr] = *(const GAS v4u*)(Z + (zbase + (unsigned)(t0 + tl) * LDZ + 1024u)); }
#pragma unroll
            for (int rr = 0; rr < 2; ++rr) { const int tl = 2 * tr + rr, t = t0 + tl; f32x2 xc[4];
#pragma unroll
                for (int e = 0; e < 4; ++e) xc[e] = cbv2[e] + cw2[0][e] * f[rr][e] + cw2[1][e] * f[rr + 1][e] + cw2[2][e] * f[rr + 2][e] + cw2[3][e] * f[rr + 3][e];
                *(LAS f32x4*)(XC + tl * 64 + cg * 8) = (f32x4){xc[0].x, xc[0].y, xc[1].x, xc[1].y}; *(LAS f32x4*)(XC + tl * 64 + cg * 8 + 4) = (f32x4){xc[2].x, xc[2].y, xc[3].x, xc[3].y};
                v4u pw; pw.x = pk2(xc[0].x, xc[0].y); pw.y = pk2(xc[1].x, xc[1].y); pw.z = pk2(xc[2].x, xc[2].y); pw.w = pk2(xc[3].x, xc[3].y);
                *(LAS v4u*)(XCB + tl * 72 + cg * 8) = pw;
                if (tile == ntiles - 1 && t >= T - 3 && t < T) { float* oc = out_conv + (size_t)(t - (T - 3)) * DM + ch0;
                    *(GAS f32x4*)oc = (f32x4){f[rr + 3][0].x, f[rr + 3][0].y, f[rr + 3][1].x, f[rr + 3][1].y}; *(GAS f32x4*)(oc + 4) = (f32x4){f[rr + 3][2].x, f[rr + 3][2].y, f[rr + 3][3].x, f[rr + 3][3].y}; }
            }
        }
        __syncthreads();
        if (tb * 32 < nrows) {
            f32x16 accr, acci;
#pragma unroll
            for (int i = 0; i < 16; ++i) { accr[i] = 0.f; acci[i] = 0.f; }
#pragma unroll
            for (int ks = 0; ks < 4; ++ks) { const bf16x8 A = *(const LAS bf16x8*)(XCB + (tb * 32 + (lane & 31)) * 72 + ks * 16 + hi * 8);
                accr = __builtin_amdgcn_mfma_f32_32x32x16_bf16(A, Br[ks], accr, 0, 0, 0);
                acci = __builtin_amdgcn_mfma_f32_32x32x16_bf16(A, Bi[ks], acci, 0, 0, 0); }
#pragma unroll
            for (int rg = 0; rg < 16; rg += 2) { const int tl = tb * 32 + (rg & 3) + 8 * (rg >> 2) + 4 * hi;
                const f32x2 xcv = (f32x2){XC[tl * 64 + jl], XC[tl * 64 + 64 + jl]};
                f32x2 er = (f32x2){accr[rg], accr[rg + 1]} * -1.4426950408889634f + nba, ei = (f32x2){acci[rg], acci[rg + 1]} * -1.4426950408889634f + nbx;
                er = (f32x2){__builtin_amdgcn_exp2f(er.x), __builtin_amdgcn_exp2f(er.y)} + 1.0f; ei = (f32x2){__builtin_amdgcn_exp2f(ei.x), __builtin_amdgcn_exp2f(ei.y)} + 1.0f;
                const f32x2 r = (f32x2){__builtin_amdgcn_rcpf(er.x), __builtin_amdgcn_rcpf(er.y)}, ig = (f32x2){__builtin_amdgcn_rcpf(ei.x), __builtin_amdgcn_rcpf(ei.y)};
                const f32x2 l2a = r * cA;
                const f32x2 av = (f32x2){__builtin_amdgcn_exp2f(l2a.x), __builtin_amdgcn_exp2f(l2a.y)};
                const f32x2 y = l2a * 1.3862943611198906f;
                const f32x2 ser = -y * (1.0f + y * (0.5f + y * 0.16666667f)), dir = 1.0f - av * av;
                const f32x2 om = (f32x2){(y.x > -0.02f) ? ser.x : dir.x, (y.y > -0.02f) ? ser.y : dir.y};
                const f32x2 uv = (f32x2){__builtin_amdgcn_sqrtf(om.x), __builtin_amdgcn_sqrtf(om.y)} * (ig * xcv);
                AS[tl * 64 + jl] = av.x; AS[tl * 64 + 64 + jl] = av.y; US[tl * 64 + jl] = uv.x; US[tl * 64 + 64 + jl] = uv.y; }
        }
        __syncthreads();
        if (tid < 256 && sg8 * 16 < nrows) { f32x2 Ap = (f32x2){1.f, 1.f}, Bp = (f32x2){0.f, 0.f};
#pragma unroll
            for (int s2 = 0; s2 < 16; ++s2) { const f32x2 av = *(const LAS f32x2*)(AS + (sg8 * 16 + s2) * 64 + 2 * pc), uv = *(const LAS f32x2*)(US + (sg8 * 16 + s2) * 64 + 2 * pc); Bp = av * Bp + uv; Ap *= av; }
            *(LAS f32x2*)(SEGA + sg8 * 64 + 2 * pc) = Ap; *(LAS f32x2*)(SEGB + sg8 * 64 + 2 * pc) = Bp; }
        __syncthreads();
        if (tid < 256 && sg8 * 16 < nrows) { f32x2 h = *(const LAS f32x2*)(CAR + par * 64 + 2 * pc);
            for (int sg = 0; sg < sg8; ++sg) h = *(const LAS f32x2*)(SEGA + sg * 64 + 2 * pc) * h + *(const LAS f32x2*)(SEGB + sg * 64 + 2 * pc);
#pragma unroll
            for (int s2 = 0; s2 < 16; ++s2) { const int tl = sg8 * 16 + s2; h = *(const LAS f32x2*)(AS + tl * 64 + 2 * pc) * h + *(const LAS f32x2*)(US + tl * 64 + 2 * pc); *(LAS f32x2*)(US + tl * 64 + 2 * pc) = h; }
            if (t0 + sg8 * 16 + 15 == T - 1) *(f32x2*)(out_h + hd * 64 + 2 * pc) = h;
            if (sg8 == 7) *(LAS f32x2*)(CAR + (par ^ 1) * 64 + 2 * pc) = h; }
        __syncthreads();
#pragma unroll
        for (int rr = 0; rr < 2; ++rr) { const int tl = 2 * tr + rr;
            if (tl < nrows) { const v4u w = gg[rr];
                const f32x4 h0v = *(const LAS f32x4*)(US + tl * 64 + cg * 8), h1v = *(const LAS f32x4*)(US + tl * 64 + cg * 8 + 4);
                const f32x2 y0 = (f32x2){h0v.x, h0v.y} * (f32x2){bflo(w.x), bfhi(w.x)}, y1 = (f32x2){h0v.z, h0v.w} * (f32x2){bflo(w.y), bfhi(w.y)};
                const f32x2 y2 = (f32x2){h1v.x, h1v.y} * (f32x2){bflo(w.z), bfhi(w.z)}, y3 = (f32x2){h1v.z, h1v.w} * (f32x2){bflo(w.w), bfhi(w.w)};
                v4u o; o.x = pk2(y0.x, y0.y); o.y = pk2(y1.x, y1.y); o.z = pk2(y2.x, y2.y); o.w = pk2(y3.x, y3.y);
                *(GAS v4u*)(Z + (zbase + (unsigned)(t0 + tl) * LDZ + 1024u)) = o; } }
    }
#undef P2A_ISSUE
}

__device__ __forceinline__ int vt_off(int d, int q) { return d * 256 + ((((q >> 3) ^ (d & 15) ^ ((d >> 4) & 7)) & 15) << 4) + (q & 7) * 2; }
__device__ __forceinline__ void p2b_item(Frame& F, const Args& a, int item, int g_lo, int g_hi) {
    LAS unsigned char* lds = F.lds;
    LAS unsigned char* VT = lds;
    LAS unsigned char* WM = lds + 32768;
    LAS float* SG = (LAS float*)(lds + 65536);
    LAS float* ST = (LAS float*)(lds + 65536 + 67584);
    bf16* Z = (bf16*)(a.ws + WS_Z);
    const int tid = F.tid, lane = F.lane, wave = F.wave;
    const bool sample = item >= MP / 128;
    const int row0 = item * 128;
    const bf16* Wm = (const bf16*)(a.ws + (sample ? WS_WSS : WS_WSM));
    const int cchunk = tid & 15, qg = tid >> 4;
    const int db = wave & 3, pb0 = (wave >> 2) * 2, hi = lane >> 5, l31 = lane & 31;
    typedef float f32x2 __attribute__((ext_vector_type(2)));
    v4u gvr[4], wmr[4]; f32x4 lgr[2], lbr[2]; float bsr[2];
    const unsigned zv0 = (unsigned)(row0 + qg * 4) * LDZ + 3072u + cchunk * 8;
    const unsigned zu0 = (unsigned)(row0 + (tid >> 4)) * LDZ + 2048u + (tid & 15) * 8;
    const unsigned lno = cchunk * 8, bso0 = sample ? l31 : pb0 * 32 + l31, bso1 = sample ? l31 : (pb0 + 1) * 32 + l31;
    const float* lng = a.in[I_LNG]; const float* lnb = a.in[I_LNB]; const float* bsp = a.in[I_BS];
#define P2B_ISSUE(g) do { lgr[0] = *(const GAS f32x4*)(lng + ((g) * 128 + lno)); lgr[1] = *(const GAS f32x4*)(lng + ((g) * 128 + lno + 4)); \
        lbr[0] = *(const GAS f32x4*)(lnb + ((g) * 128 + lno)); lbr[1] = *(const GAS f32x4*)(lnb + ((g) * 128 + lno + 4)); \
        bsr[0] = bsp[(g) * 128 + bso0]; bsr[1] = bsp[(g) * 128 + bso1]; \
        _Pragma("unroll") for (int r = 0; r < 4; ++r) { gvr[r] = *(const GAS v4u*)(Z + (zv0 + (unsigned)r * LDZ + (unsigned)(g) * 128u)); \
        wmr[r] = *(const GAS v4u*)(Wm + ((unsigned)(g) * 16384u + (unsigned)(tid + 512 * r) * 8u)); } } while (0)
    P2B_ISSUE(g_lo);
    __syncthreads();
    if (tid < 128) { const GAS f32x4* sp = (const GAS f32x4*)((const float*)(a.ws + WS_STAT) + (size_t)(row0 + tid) * 32); f32x4 w[8];
#pragma unroll
        for (int i = 0; i < 8; ++i) w[i] = sp[i];
        float s = 0.f, ss = 0.f;
#pragma unroll
        for (int i = 0; i < 8; ++i) { s += w[i].x; ss += w[i].y; s += w[i].z; ss += w[i].w; }
        const float mean = s * (1.f / 1024.f), var = fmaxf(ss * (1.f / 1024.f) - mean * mean, 0.f);
        ST[tid * 2] = mean; ST[tid * 2 + 1] = __builtin_amdgcn_rsqf(var + EPS); }
    __syncthreads();
    for (int g = g_lo; g < g_hi; ++g) {
        { const int d0 = cchunk * 8, col = g * 128 + d0;
          const f32x2 lg2[4] = {(f32x2){lgr[0].x, lgr[0].y}, (f32x2){lgr[0].z, lgr[0].w}, (f32x2){lgr[1].x, lgr[1].y}, (f32x2){lgr[1].z, lgr[1].w}};
          const f32x2 lb2[4] = {(f32x2){lbr[0].x, lbr[0].y}, (f32x2){lbr[0].z, lbr[0].w}, (f32x2){lbr[1].x, lbr[1].y}, (f32x2){lbr[1].z, lbr[1].w}};
          f32x2 vn[4][4];
#pragma unroll
          for (int r = 0; r < 4; ++r) { const int q = qg * 4 + r; const v4u w = gvr[r];
              const f32x2 ms = *(const LAS f32x2*)(ST + q * 2); const float rstd = ms.y, nmr = -ms.x * ms.y;
              vn[r][0] = ((f32x2){bflo(w.x), bfhi(w.x)} * rstd + nmr) * lg2[0] + lb2[0]; vn[r][1] = ((f32x2){bflo(w.y), bfhi(w.y)} * rstd + nmr) * lg2[1] + lb2[1];
              vn[r][2] = ((f32x2){bflo(w.z), bfhi(w.z)} * rstd + nmr) * lg2[2] + lb2[2]; vn[r][3] = ((f32x2){bflo(w.w), bfhi(w.w)} * rstd + nmr) * lg2[3] + lb2[3];
              if (sample) { float* ov = a.out + O_VS + (size_t)(row0 - MP + q) * DM + col;
                  *(GAS f32x4*)ov = (f32x4){vn[r][0].x, vn[r][0].y, vn[r][1].x, vn[r][1].y}; *(GAS f32x4*)(ov + 4) = (f32x4){vn[r][2].x, vn[r][2].y, vn[r][3].x, vn[r][3].y}; } }
#pragma unroll
          for (int ep = 0; ep < 4; ++ep) { v2u o; o.x = pk2(vn[0][ep].x, vn[1][ep].x); o.y = pk2(vn[2][ep].x, vn[3][ep].x); *(LAS v2u*)(VT + vt_off(d0 + 2 * ep, qg * 4)) = o;
              o.x = pk2(vn[0][ep].y, vn[1][ep].y); o.y = pk2(vn[2][ep].y, vn[3][ep].y); *(LAS v2u*)(VT + vt_off(d0 + 2 * ep + 1, qg * 4)) = o; }
#pragma unroll
          for (int r = 0; r < 4; ++r) { const int ch = tid + 512 * r; *(LAS v4u*)(WM + vt_off(ch >> 4, (ch & 15) * 8)) = wmr[r]; } }
        const float bs0 = bsr[0], bs1 = bsr[1];
        v4u gur[4];
#pragma unroll
        for (int r = 0; r < 4; ++r) gur[r] = *(const GAS v4u*)(Z + (zu0 + (unsigned)(32 * r) * LDZ + (unsigned)g * 128u));
        if (g + 1 < g_hi) P2B_ISSUE(g + 1);
        __syncthreads();
        { f32x16 acc[2];
#pragma unroll
          for (int i = 0; i < 16; ++i) { acc[0][i] = 0.f; acc[1][i] = 0.f; }
          const int kmax = (!sample && pb0 == 0) ? 4 : 8;
          const int d = db * 32 + l31;
#pragma unroll
          for (int ks = 0; ks < 8; ++ks) { if (ks < kmax) { const bf16x8 A = *(const LAS bf16x8*)(VT + vt_off(d, ks * 16 + hi * 8));
#pragma unroll
              for (int pi = 0; pi < 2; ++pi) { const bf16x8 B = *(const LAS bf16x8*)(WM + vt_off((pb0 + pi) * 32 + l31, ks * 16 + hi * 8));
                  acc[pi] = __builtin_amdgcn_mfma_f32_32x32x16_bf16(A, B, acc[pi], 0, 0, 0); } } }
#pragma unroll
          for (int pi = 0; pi < 2; ++pi) { const int p = (pb0 + pi) * 32 + l31; const float bs = pi ? bs1 : bs0;
#pragma unroll
              for (int rq = 0; rq < 4; ++rq) *(LAS f32x4*)(SG + p * 132 + db * 32 + 8 * rq + 4 * hi) = (f32x4){acc[pi][rq * 4 + 0], acc[pi][rq * 4 + 1], acc[pi][rq * 4 + 2], acc[pi][rq * 4 + 3]} + bs; } }
        __syncthreads();
#pragma unroll
        for (int r = 0; r < 4; ++r) { const int p = (tid >> 4) + 32 * r, c8 = (tid & 15) * 8;
            const f32x4 s0 = *(const LAS f32x4*)(SG + p * 132 + c8), s1 = *(const LAS f32x4*)(SG + p * 132 + c8 + 4); const v4u w = gur[r];
            const f32x2 y0 = (f32x2){s0.x, s0.y} * (f32x2){bflo(w.x), bfhi(w.x)}, y1 = (f32x2){s0.z, s0.w} * (f32x2){bflo(w.y), bfhi(w.y)};
            const f32x2 y2 = (f32x2){s1.x, s1.y} * (f32x2){bflo(w.z), bfhi(w.z)}, y3 = (f32x2){s1.z, s1.w} * (f32x2){bflo(w.w), bfhi(w.w)};
            v4u o; o.x = pk2(y0.x, y0.y); o.y = pk2(y1.x, y1.y); o.z = pk2(y2.x, y2.y); o.w = pk2(y3.x, y3.y);
            *(GAS v4u*)(Z + (zu0 + (unsigned)(32 * r) * LDZ + (unsigned)g * 128u)) = o; }
    }
#undef P2B_ISSUE
}

__device__ __forceinline__ void p5_rows(Frame& F, const Args& a) {
    const int gw = F.vcu * NWAVES + F.wave, NGW = F.G * NWAVES, lane = F.lane;
    const bf16* MIX = (const bf16*)(a.ws + WS_MIX); bf16* HN = (bf16*)(a.ws + WS_XN);
    f32x4 g1[4], g2[4];
#pragma unroll
    for (int j = 0; j < 4; ++j) { g1[j] = ((const GAS f32x4*)a.in[I_GPOST])[lane + 64 * j]; g2[j] = ((const GAS f32x4*)a.in[I_GFFN])[lane + 64 * j]; }
    for (int m = gw; m < M; m += NGW) { const GAS f32x4* xr = (const GAS f32x4*)xrow_ptr(a, m) + lane; const GAS v2u* mr = (const GAS v2u*)(MIX + (size_t)m * LDX) + lane;
        f32x4 x[4], mx[4]; float s = 0.f;
#pragma unroll
        for (int j = 0; j < 4; ++j) { x[j] = xr[64 * j]; const v2u w = mr[64 * j]; mx[j] = (f32x4){bflo(w.x), bfhi(w.x), bflo(w.y), bfhi(w.y)};
            s += (mx[j].x * mx[j].x + mx[j].y * mx[j].y) + (mx[j].z * mx[j].z + mx[j].w * mx[j].w); }
        const float r1 = __builtin_amdgcn_rsqf(wave_sum(s) * (1.f / DM) + EPS); float s2 = 0.f;
#pragma unroll
        for (int j = 0; j < 4; ++j) { x[j] = x[j] + mx[j] * r1 * g1[j]; s2 += (x[j].x * x[j].x + x[j].y * x[j].y) + (x[j].z * x[j].z + x[j].w * x[j].w); }
        const float r2 = __builtin_amdgcn_rsqf(wave_sum(s2) * (1.f / DM) + EPS);
        GAS v2u* o8 = (GAS v2u*)(HN + (size_t)m * LDX) + lane;
#pragma unroll
        for (int j = 0; j < 4; ++j) { const f32x4 h = x[j] * r2 * g2[j]; v2u o; o.x = pk2(h.x, h.y); o.y = pk2(h.z, h.w); o8[64 * j] = o; } }
}
__device__ __forceinline__ void p8_rows(Frame& F, const Args& a) {
    const int gw = F.vcu * NWAVES + F.wave, NGW = F.G * NWAVES, lane = F.lane;
    const bf16* MIX = (const bf16*)(a.ws + WS_MIX); const bf16* FF = (const bf16*)(a.ws + WS_F);
    f32x4 g1[4], g3[4];
#pragma unroll
    for (int j = 0; j < 4; ++j) { g1[j] = ((const GAS f32x4*)a.in[I_GPOST])[lane + 64 * j]; g3[j] = ((const GAS f32x4*)a.in[I_GPF])[lane + 64 * j]; }
    for (int m = gw; m < M; m += NGW) { const GAS f32x4* xr = (const GAS f32x4*)xrow_ptr(a, m) + lane; const GAS v2u* mr = (const GAS v2u*)(MIX + (size_t)m * LDX) + lane; const GAS v2u* fr = (const GAS v2u*)(FF + (size_t)m * LDX) + lane;
        f32x4 x[4], mx[4], fx[4]; float s = 0.f, sf = 0.f;
#pragma unroll
        for (int j = 0; j < 4; ++j) { x[j] = xr[64 * j]; const v2u w = mr[64 * j]; mx[j] = (f32x4){bflo(w.x), bfhi(w.x), bflo(w.y), bfhi(w.y)}; const v2u wf = fr[64 * j]; fx[j] = (f32x4){bflo(wf.x), bfhi(wf.x), bflo(wf.y), bfhi(wf.y)};
            s += (mx[j].x * mx[j].x + mx[j].y * mx[j].y) + (mx[j].z * mx[j].z + mx[j].w * mx[j].w); sf += (fx[j].x * fx[j].x + fx[j].y * fx[j].y) + (fx[j].z * fx[j].z + fx[j].w * fx[j].w); }
        const float r1 = __builtin_amdgcn_rsqf(wave_sum(s) * (1.f / DM) + EPS), r3 = __builtin_amdgcn_rsqf(wave_sum(sf) * (1.f / DM) + EPS);
        GAS f32x4* o = (GAS f32x4*)(a.out + O_Y + (size_t)m * DM) + lane;
#pragma unroll
        for (int j = 0; j < 4; ++j) o[64 * j] = x[j] + mx[j] * r1 * g1[j] + fx[j] * r3 * g3[j]; }
}

typedef float f32x4s __attribute__((ext_vector_type(4)));
template <int MODE, int NSTEPS>
__device__ __forceinline__ void small_gemm(Frame& F, const bf16* A, int lda, const bf16* Bt, int ldb, bf16* O, int ldo, const bf16* Zg) {
    LAS float* RED = (LAS float*)F.lds;
    const int tid = F.tid, lane = F.lane, wave = F.wave, kc = lane >> 4, l15 = lane & 15;
    constexpr int KS = NSTEPS * 32;
    for (int task = blockIdx.x; task < 256; task += F.G) {
        const int mt = task & 7, nt = task >> 3;
        const int r0 = MP + mt * 64, c0 = nt * 32;
        const bf16* pa = A + (size_t)(r0 + l15) * lda + wave * KS + kc * 8;
        const bf16* pb = Bt + (size_t)(c0 + l15) * ldb + wave * KS + kc * 8;
        f32x4s acc[4][2];
#pragma unroll
        for (int i = 0; i < 4; ++i) { acc[i][0] = (f32x4s){0.f, 0.f, 0.f, 0.f}; acc[i][1] = (f32x4s){0.f, 0.f, 0.f, 0.f}; }
        bf16x8 fa[2][4][4], fb[2][4][2];
#define SG_LOAD(buf, s0, ns) do { _Pragma("unroll") for (int s = 0; s < (ns); ++s) { \
            _Pragma("unroll") for (int i = 0; i < 4; ++i) fa[buf][s][i] = *(const GAS bf16x8*)(pa + (size_t)(16 * i) * lda + ((s0) + s) * 32); \
            _Pragma("unroll") for (int j = 0; j < 2; ++j) fb[buf][s][j] = *(const GAS bf16x8*)(pb + (size_t)(16 * j) * ldb + ((s0) + s) * 32); } } while (0)
#define SG_MMA(buf, ns) do { _Pragma("unroll") for (int s = 0; s < (ns); ++s) _Pragma("unroll") for (int i = 0; i < 4; ++i) _Pragma("unroll") for (int j = 0; j < 2; ++j) \
            acc[i][j] = __builtin_amdgcn_mfma_f32_16x16x32_bf16(fa[buf][s][i], fb[buf][s][j], acc[i][j], 0, 0, 0); } while (0)
        if (NSTEPS == 4) { SG_LOAD(0, 0, 4); SG_MMA(0, 4); }
        else if (NSTEPS == 8) { SG_LOAD(0, 0, 4); SG_LOAD(1, 4, 4); SG_MMA(0, 4); SG_MMA(1, 4); }
        else { SG_LOAD(0, 0, 4); SG_LOAD(1, 4, 4); SG_MMA(0, 4); SG_LOAD(0, 8, 3); SG_MMA(1, 4); SG_MMA(0, 3); }
#undef SG_LOAD
#undef SG_MMA
        __syncthreads();
#pragma unroll
        for (int i = 0; i < 4; ++i)
#pragma unroll
            for (int j = 0; j < 2; ++j)
#pragma unroll
                for (int rg = 0; rg < 4; ++rg) RED[wave * 2304 + (16 * i + 4 * kc + rg) * 36 + 16 * j + l15] = acc[i][j][rg];
        __syncthreads();
        { const int row = tid >> 3, c4 = (tid & 7) * 4, col = c0 + c4; f32x4 v;
            if (MODE == 1) { f32x4 oa = (f32x4){0.f, 0.f, 0.f, 0.f}, ob = oa;
#pragma unroll
                for (int w = 0; w < 4; ++w) { oa += *(const LAS f32x4*)(RED + w * 2304 + row * 36 + c4); ob += *(const LAS f32x4*)(RED + (w + 4) * 2304 + row * 36 + c4); }
                const v2u ga = *(const GAS v2u*)(Zg + (size_t)(r0 + row) * LDZ + col), gb = *(const GAS v2u*)(Zg + (size_t)(r0 + row) * LDZ + 1024 + col);
                v.x = bflo(ga.x) * oa.x + bflo(gb.x) * ob.x; v.y = bfhi(ga.x) * oa.y + bfhi(gb.x) * ob.y; v.z = bflo(ga.y) * oa.z + bflo(gb.y) * ob.z; v.w = bfhi(ga.y) * oa.w + bfhi(gb.y) * ob.w;
            } else { v = (f32x4){0.f, 0.f, 0.f, 0.f};
#pragma unroll
                for (int w = 0; w < 8; ++w) v += *(const LAS f32x4*)(RED + w * 2304 + row * 36 + c4); }
            v2u o; o.x = pk2(v.x, v.y); o.y = pk2(v.z, v.w);
            *(GAS v2u*)(O + (size_t)(r0 + row) * ldo + col) = o; }
    }
    __syncthreads();
}

__global__ void __launch_bounds__(NWAVES * 64, 2) hawk_fwd(Args args) {
    extern __shared__ __attribute__((aligned(16))) unsigned char lds[];
    Frame F;
    F.lds = (LAS unsigned char*)lds;
    F.MISC = (volatile LAS unsigned*)(F.lds + MISC_OFF);
    F.tid = threadIdx.x; F.lane = F.tid & 63; F.wave = __builtin_amdgcn_readfirstlane(F.tid >> 6);
    F.G = gridDim.x; { const int bx = blockIdx.x; F.vcu = (F.G % 8 == 0) ? (bx % 8) * (F.G / 8) + bx / 8 : bx; }
    unsigned char* ws = args.ws;
    F.ctl = (gu32*)(ws + WS_CTL);
    for (int u = F.tid; u < (LDS_BYTES - LDSCTL_OFF) / 4; u += NWAVES * 64) ((LAS unsigned*)(F.lds + LDSCTL_OFF))[u] = 0u;
    __syncthreads();
    XcdBarrier bar; bar.bar = (unsigned*)(F.ctl + CW_BAR); bar.x = 0; bar.st = nullptr;
    if (N_LAUNCHES != PER_PHASE) bar = xcd_barrier_post((unsigned*)(F.ctl + CW_BAR), F.MISC + 8);
#define GRID_BAR() do { if (N_LAUNCHES != PER_PHASE) xcd_barrier(bar); } while (0)
    volatile LAS unsigned long long* tsb = (volatile LAS unsigned long long*)(F.lds + LDSCTL_OFF + 1024);
#define TS(i) do { if (PROBE_TA >= 0 && blockIdx.x == 0 && F.tid == 0) tsb[i] = __builtin_amdgcn_s_memrealtime(); } while (0)
    TS(63);
    const int lo = args.ph_lo, hi = args.ph_hi;
#define IN(k) (lo <= (k) && (k) < hi)
#define BOTH(k) (IN(k) && IN((k) + 1))
    bf16* XN = (bf16*)(ws + WS_XN); bf16* Z = (bf16*)(ws + WS_Z);

#define PH0() do { p0_prologue(F, args); } while (0)
#define PH1() do { pg8::Gemm g{XN, (const bf16*)(ws + WS_W1), LDX, LDX, DM}; pg8::StaticOrder S; S.init(M, DIN, F.G, (int)blockIdx.x); pg8::EpiZ E{Z, LDZ, (float*)(ws + WS_STAT)}; \
        pg8::gemm_phase<pg8::EpiZ, pg8::StaticOrder, PG8_ALIGN, PG8_SP2>(F.lds + RING_OFF, g, S, E); \
        { const int rem = S.nwg % F.G, c = (int)blockIdx.x; if (rem == 0) p0_items(F, args, 1, c * NWAVES + F.wave, F.G * NWAVES); else if (c >= rem) p0_items(F, args, 1, (c - rem) * NWAVES + F.wave, (F.G - rem) * NWAVES); } } while (0)
#define PH3() do { pg8::Gemm g{Z + 1024, (const bf16*)(ws + WS_W2), LDZ, LDW2, 2048}; pg8::StaticOrder S; S.init(MP, DM, F.G, (int)blockIdx.x); pg8::EpiGate E{Z + 4096, LDZ, XN, LDX}; \
        pg8::gemm_phase<pg8::EpiGate, pg8::StaticOrder, PG8_ALIGN, PG8_SP2>(F.lds + RING_OFF, g, S, E); \
        small_gemm<1, 8>(F, Z + 1024, LDZ, (const bf16*)(ws + WS_W2), LDW2, XN, LDX, Z + 4096); } while (0)
#define PH4() do { pg8::Gemm g{XN, (const bf16*)(ws + WS_W3), LDX, LDX, DM}; pg8::StaticOrder S; S.init(MP, DM, F.G, (int)blockIdx.x); pg8::EpiBf16 E{(bf16*)(ws + WS_MIX), LDX}; \
        pg8::gemm_phase<pg8::EpiBf16, pg8::StaticOrder, PG8_ALIGN, PG8_SP2>(F.lds + RING_OFF, g, S, E); \
        small_gemm<2, 4>(F, XN, LDX, (const bf16*)(ws + WS_W3), LDX, (bf16*)(ws + WS_MIX), LDX, nullptr); } while (0)
#define PH5() do { p5_rows(F, args); } while (0)
#define PH6() do { pg8::Gemm g{XN, (const bf16*)(ws + WS_W4), LDX, LDX, DM}; pg8::StaticOrder S; S.init(M, DFF2, F.G, (int)blockIdx.x); pg8::EpiSwiGLU E{(bf16*)(ws + WS_FIN), DFF}; \
        pg8::gemm_phase<pg8::EpiSwiGLU, pg8::StaticOrder, PG8_ALIGN, PG8_SP2>(F.lds + RING_OFF, g, S, E); \
        { const int rem = S.nwg % F.G, c = (int)blockIdx.x; if (rem == 0) p0_items(F, args, 2, c * NWAVES + F.wave, F.G * NWAVES); else if (c >= rem) p0_items(F, args, 2, (c - rem) * NWAVES + F.wave, (F.G - rem) * NWAVES); } } while (0)
#define PH7() do { pg8::Gemm g{(const bf16*)(ws + WS_FIN), (const bf16*)(ws + WS_W5), DFF, DFF, DFF}; pg8::StaticOrder S; S.init(MP, DM, F.G, (int)blockIdx.x); pg8::EpiBf16 E{(bf16*)(ws + WS_F), LDX}; \
        pg8::gemm_phase<pg8::EpiBf16, pg8::StaticOrder, PG8_ALIGN, PG8_SP2>(F.lds + RING_OFF, g, S, E); \
        small_gemm<2, 11>(F, (const bf16*)(ws + WS_FIN), DFF, (const bf16*)(ws + WS_W5), DFF, (bf16*)(ws + WS_F), LDX, nullptr); } while (0)
#define PH8() do { p8_rows(F, args); } while (0)
#define RUN(k, PH) do { if (IN(k)) { PH(); if (PROBE_DOUBLE == (k)) { GRID_BAR(); PH(); } TS(2 * (k)); if (BOTH(k)) GRID_BAR(); TS(2 * (k) + 1); } } while (0)
    RUN(0, PH0);
    RUN(1, PH1);
    if (IN(2)) {
        for (int it = blockIdx.x; it < 2 * NB * 16; it += F.G) {
            if (it < NB * 16) { const int b = it >> 4, hd = it & 15;
                p2a_item(F, args, b * SEQ, SEQ, hd, nullptr, nullptr, args.out + O_HP + (size_t)b * DM, args.out + O_CP + (size_t)b * 3 * DM); }
            else { const int b = (it - NB * 16) >> 4, hd = it & 15;
                p2a_item(F, args, MP + b * DEC_T, DEC_T, hd, args.in[I_SH] + (size_t)b * DM, args.in[I_SC] + (size_t)b * 3 * DM, args.out + O_HS + (size_t)b * DM, args.out + O_CS + (size_t)b * 3 * DM); }
        }
        TS(40);
        for (int it = blockIdx.x; it < MP / 128; it += F.G) p2b_item(F, args, it, 0, 8);
        for (int it = blockIdx.x; it < 32; it += F.G) p2b_item(F, args, MP / 128 + (it >> 3), it & 7, (it & 7) + 1);
        TS(4);
        if (BOTH(2)) GRID_BAR();
        TS(5);
    }
    RUN(3, PH3);
    RUN(4, PH4);
    RUN(5, PH5);
    RUN(6, PH6);
    RUN(7, PH7);
    RUN(8, PH8);
    if (PROBE_TA >= 0 && blockIdx.x == 0 && F.tid == 0) { const unsigned long long d = (tsb[PROBE_TB] - tsb[PROBE_TA]) * PROBE_MULT, t0 = __builtin_amdgcn_s_memrealtime();
        while (__builtin_amdgcn_s_memrealtime() - t0 < d) __builtin_amdgcn_s_sleep(16); }
#undef IN
#undef BOTH
#undef GRID_BAR
}

extern "C" void kernel_launch(void* const* d_in, const int* in_sizes, int n_in, void* d_out, int out_size, void* d_ws, size_t ws_size, hipStream_t stream) {
    static int grid = 0;
    if (grid == 0) {
        if (n_in != N_IN || in_sizes[0] != MP * DM || (size_t)out_size != O_END || ws_size < WS_END) {
            fprintf(stderr, "kernel_launch: shape mismatch (n_in %d, in0 %d, out %d, ws %zu; need ws >= %zu); nothing launched\n", n_in, n_in > 0 ? in_sizes[0] : -1, out_size, ws_size, (size_t)WS_END); grid = -1; return; }
        int dev = 0, cus = 0, per_cu = 0;
        if (hipGetDevice(&dev) != hipSuccess || hipDeviceGetAttribute(&cus, hipDeviceAttributeMultiprocessorCount, dev) != hipSuccess) { fprintf(stderr, "kernel_launch: device query failed\n"); grid = -1; return; }
        if (hipFuncSetAttribute((const void*)hawk_fwd, hipFuncAttributeMaxDynamicSharedMemorySize, LDS_BYTES) != hipSuccess) { fprintf(stderr, "kernel_launch: hipFuncSetAttribute failed\n"); grid = -1; return; }
        if (hipOccupancyMaxActiveBlocksPerMultiprocessor(&per_cu, (const void*)hawk_fwd, NWAVES * 64, LDS_BYTES) != hipSuccess || per_cu < 1) {
            fprintf(stderr, "kernel_launch: occupancy query reports %d workgroups per CU; nothing launched\n", per_cu); (void)hipGetLastError(); grid = -1; return; }
        grid = cus;
    }
    if (grid < 0) return;
    if (hipMemsetAsync((char*)d_ws + WS_CTL, 0, CTL_ZERO_BYTES, stream) != hipSuccess) { fprintf(stderr, "kernel_launch: memset failed\n"); return; }
    Args a{};
    for (int i = 0; i < N_IN; ++i) a.in[i] = (const float*)d_in[i];
    a.out = (float*)d_out; a.ws = (unsigned char*)d_ws;
    for (int li = 0; li < N_LAUNCHES; ++li) {
        a.ph_lo = (N_LAUNCHES == PER_PHASE) ? li : 0; a.ph_hi = (N_LAUNCHES == PER_PHASE) ? li + 1 : PER_PHASE; a.li = li;
        hipLaunchKernelGGL(hawk_fwd, dim3(grid), dim3(NWAVES * 64), LDS_BYTES, stream, a);
        const hipError_t le = hipPeekAtLastError();
        if (le != hipSuccess) { fprintf(stderr, "kernel_launch: launch %d failed: %s\n", li, hipGetErrorName(le)); break; }
    }
}
```

```cpp
#include <hip/hip_runtime.h>
#include <cstdio>
#include <cstdint>

#ifndef MK_N_LAUNCHES
#define MK_N_LAUNCHES 1
#endif
#ifndef PROBE_TA
#define PROBE_TA -1
#define PROBE_TB -1
#endif
#define PROBE_MULT 4
#ifndef PROBE_DOUBLE
#define PROBE_DOUBLE -1
#endif

namespace pg8 {
#define PG8_LAS __attribute__((address_space(3)))
typedef unsigned short bf16_t;
typedef short bf16x8 __attribute__((ext_vector_type(8)));
typedef float f32x4 __attribute__((ext_vector_type(4)));
typedef unsigned u32x4 __attribute__((ext_vector_type(4)));
constexpr int BM = 256, BK = 64, HALF = 128, HTB = HALF * BK * 2  , STAGE_BYTES = 8 * HTB, NXCD = 8, WGM = 8;

__host__ __device__ __forceinline__ int lds_byte(int r, int c) { const int st = (r >> 4) * 2 + (c >> 5), rr = r & 15, cc = c & 31, ob = rr * 64 + cc * 2; return st * 1024 + (ob ^ (((ob >> 9) & 1) << 5)); }
__host__ __device__ __forceinline__ void stage_rc(int b, int& R, int& C) { const int st = b / 1024, sb = b % 1024, swz = sb ^ (((sb >> 9) & 1) << 5); R = (st >> 1) * 16 + swz / 64; C = (st & 1) * 32 + (swz % 64) / 2; }
__host__ __device__ __forceinline__ int perm32(int rho) { const int n = rho >> 4, i = rho & 15; return 8 * (i >> 2) + 4 * n + (i & 3); }

struct Unit { int pm, pn; };
struct Gemm { const bf16_t* A; const bf16_t* Bt; int lda, ldb, K; };

struct StaticOrder {
    int nM, nN, nwg, G, c;
    __host__ __device__ void init(int M, int N, int G_, int c_) { nM = M / BM; nN = N / BM; nwg = nM * nN; G = G_; c = c_; }
    __host__ __device__ bool next(int i, Unit& u) const {
        const long L = (long)i * G + c; if (L >= nwg) return false;
        int wgid = (int)L; { const int q = nwg / NXCD, r = nwg % NXCD, xcd = wgid % NXCD, off = wgid / NXCD; wgid = (xcd < r ? xcd * (q + 1) : r * (q + 1) + (xcd - r) * q) + off; }
        const int nig = WGM * nN, gid = wgid / nig, fm = gid * WGM, gsz = (nM - fm) < WGM ? (nM - fm) : WGM;
        u.pm = fm + ((wgid % nig) % gsz); u.pn = (wgid % nig) / gsz; return true;
    }
    __device__ __forceinline__ void a_ready(const Unit&) const {}
    __device__ __forceinline__ void done(const Unit&) const {}
};

__device__ __forceinline__ unsigned cvt_pk_bf16(float lo, float hi) { unsigned r; asm volatile("v_cvt_pk_bf16_f32 %0, %1, %2" : "=v"(r) : "v"(lo), "v"(hi)); return r; }
__device__ __forceinline__ float bf_lo(unsigned w) { return __uint_as_float(w << 16); }
__device__ __forceinline__ float bf_hi(unsigned w) { return __uint_as_float(w & 0xffff0000u); }
__device__ __forceinline__ float sigmoid_f(float x) { return __builtin_amdgcn_rcpf(1.0f + __builtin_amdgcn_exp2f(-1.4426950408889634f * x)); }
__device__ __forceinline__ float gelu_tanh_f(float x) { const float t = x * (-2.3022081986f + -0.1029432446f * x * x); return x * __builtin_amdgcn_rcpf(1.0f + __builtin_amdgcn_exp2f(t)); }
__device__ __forceinline__ float silu_f(float x) { return x * sigmoid_f(x); }
typedef float f32x2p __attribute__((ext_vector_type(2)));
__device__ __forceinline__ f32x2p exp2_2(f32x2p v) { return (f32x2p){__builtin_amdgcn_exp2f(v.x), __builtin_amdgcn_exp2f(v.y)}; }
__device__ __forceinline__ f32x2p rcp_2(f32x2p v) { return (f32x2p){__builtin_amdgcn_rcpf(v.x), __builtin_amdgcn_rcpf(v.y)}; }
__device__ __forceinline__ f32x2p gelu2(f32x2p x) { const f32x2p t = x * (x * x * -0.1029432446f + -2.3022081986f); return x * rcp_2(exp2_2(t) + 1.0f); }
__device__ __forceinline__ f32x2p sigmoid2(f32x2p x) { return rcp_2(exp2_2(x * -1.4426950408889634f) + 1.0f); }

struct EpiZ {
    static constexpr bool PERM = true, AFTER_DRAIN = false, HAS_MID = false; static constexpr int TMID = -1;
    bf16_t* Z; int ldc; float* stat;
    __device__ __forceinline__ void mid(f32x4 (&)[2][2][4][2], const Unit&, int, int, int, int) const {}
    __device__ __forceinline__ void operator()(const f32x4 (&acc)[2][2][4][2], const Unit& u, int wr, int wc, int fr, int fq) const {
        int row0 = u.pm * BM + wr * 64 + fr; const int col0 = u.pn * BM + wc * 32 + 8 * fq; asm volatile("" : "+v"(row0));
        const int mode = u.pn < 4 ? 0 : (u.pn < 16 ? 1 : 2);
        const bool vstat = (u.pn >= 12 && u.pn < 16);
#pragma unroll
        for (int ai = 0; ai < 2; ++ai)
#pragma unroll
            for (int m = 0; m < 4; ++m) { bf16_t* rowp = Z + (size_t)(row0 + ai * HALF + m * 16) * ldc + col0; float ssum = 0.f, ssq = 0.f;
#pragma unroll
                for (int bj = 0; bj < 2; ++bj) { const f32x4 v0 = acc[ai][bj][m][0], v1 = acc[ai][bj][m][1];
                    f32x2p a0 = (f32x2p){v0[0], v0[1]}, a1 = (f32x2p){v0[2], v0[3]}, a2 = (f32x2p){v1[0], v1[1]}, a3 = (f32x2p){v1[2], v1[3]};
                    if (mode == 1) { a0 = gelu2(a0); a1 = gelu2(a1); a2 = gelu2(a2); a3 = gelu2(a3); }
                    else if (mode == 2) { a0 = sigmoid2(a0); a1 = sigmoid2(a1); a2 = sigmoid2(a2); a3 = sigmoid2(a3); }
                    if (vstat) { const f32x2p t = (a0 + a1) + (a2 + a3), q = (a0 * a0 + a1 * a1) + (a2 * a2 + a3 * a3); ssum += t.x + t.y; ssq += q.x + q.y; }
                    u32x4 w; w.x = cvt_pk_bf16(a0.x, a0.y); w.y = cvt_pk_bf16(a1.x, a1.y); w.z = cvt_pk_bf16(a2.x, a2.y); w.w = cvt_pk_bf16(a3.x, a3.y);
                    *(u32x4*)(rowp + bj * HALF) = w; }
                if (vstat) { ssum += __shfl_xor(ssum, 16); ssq += __shfl_xor(ssq, 16); ssum += __shfl_xor(ssum, 32); ssq += __shfl_xor(ssq, 32);
                    if (fq == 0) { typedef float f32x2 __attribute__((ext_vector_type(2))); *(f32x2*)(stat + ((size_t)(row0 + ai * HALF + m * 16) * 16 + (u.pn - 12) * 4 + wc) * 2) = (f32x2){ssum, ssq}; } } }
    }
};
struct EpiBf16 {
    static constexpr bool PERM = true, AFTER_DRAIN = false, HAS_MID = false; static constexpr int TMID = -1;
    bf16_t* O; int ldc;
    __device__ __forceinline__ void mid(f32x4 (&)[2][2][4][2], const Unit&, int, int, int, int) const {}
    __device__ __forceinline__ void operator()(const f32x4 (&acc)[2][2][4][2], const Unit& u, int wr, int wc, int fr, int fq) const {
        int row0 = u.pm * BM + wr * 64 + fr; const int col0 = u.pn * BM + wc * 32 + 8 * fq; asm volatile("" : "+v"(row0));
#pragma unroll
        for (int ai = 0; ai < 2; ++ai)
#pragma unroll
            for (int m = 0; m < 4; ++m) { bf16_t* rowp = O + (size_t)(row0 + ai * HALF + m * 16) * ldc + col0;
#pragma unroll
                for (int bj = 0; bj < 2; ++bj) { const f32x4 v0 = acc[ai][bj][m][0], v1 = acc[ai][bj][m][1];
                    u32x4 w; w.x = cvt_pk_bf16(v0[0], v0[1]); w.y = cvt_pk_bf16(v0[2], v0[3]); w.z = cvt_pk_bf16(v1[0], v1[1]); w.w = cvt_pk_bf16(v1[2], v1[3]);
                    *(u32x4*)(rowp + bj * HALF) = w; } }
    }
};
struct EpiGate {
    static constexpr bool PERM = true, AFTER_DRAIN = false, HAS_MID = true; static constexpr int TMID = 16;
    const bf16_t* Zg; int ldz;
    bf16_t* O; int ldc;
    __device__ __forceinline__ void mid(f32x4 (&acc)[2][2][4][2], const Unit& u, int wr, int wc, int fr, int fq) const {
        int row0 = u.pm * BM + wr * 64 + fr; const int col0 = u.pn * BM + wc * 32 + 8 * fq; asm volatile("" : "+v"(row0));
#pragma unroll
        for (int ai = 0; ai < 2; ++ai)
#pragma unroll
            for (int m = 0; m < 4; ++m) { const bf16_t* rowp = Zg + (size_t)(row0 + ai * HALF + m * 16) * ldz + col0;
#pragma unroll
                for (int bj = 0; bj < 2; ++bj) { const u32x4 ga = *(const u32x4*)(rowp + bj * HALF), gb = *(const u32x4*)(rowp + 1024 + bj * HALF);
                    f32x4 r0, r1;
                    r0[0] = bf_lo(ga.x) * __builtin_amdgcn_rcpf(fmaxf(bf_lo(gb.x), 1e-30f)); r0[1] = bf_hi(ga.x) * __builtin_amdgcn_rcpf(fmaxf(bf_hi(gb.x), 1e-30f));
                    r0[2] = bf_lo(ga.y) * __builtin_amdgcn_rcpf(fmaxf(bf_lo(gb.y), 1e-30f)); r0[3] = bf_hi(ga.y) * __builtin_amdgcn_rcpf(fmaxf(bf_hi(gb.y), 1e-30f));
                    r1[0] = bf_lo(ga.z) * __builtin_amdgcn_rcpf(fmaxf(bf_lo(gb.z), 1e-30f)); r1[1] = bf_hi(ga.z) * __builtin_amdgcn_rcpf(fmaxf(bf_hi(gb.z), 1e-30f));
                    r1[2] = bf_lo(ga.w) * __builtin_amdgcn_rcpf(fmaxf(bf_lo(gb.w), 1e-30f)); r1[3] = bf_hi(ga.w) * __builtin_amdgcn_rcpf(fmaxf(bf_hi(gb.w), 1e-30f));
                    acc[ai][bj][m][0] *= r0; acc[ai][bj][m][1] *= r1; } }
    }
    __device__ __forceinline__ void operator()(const f32x4 (&acc)[2][2][4][2], const Unit& u, int wr, int wc, int fr, int fq) const {
        int row0 = u.pm * BM + wr * 64 + fr; const int col0 = u.pn * BM + wc * 32 + 8 * fq; asm volatile("" : "+v"(row0));
#pragma unroll
        for (int ai = 0; ai < 2; ++ai)
#pragma unroll
            for (int m = 0; m < 4; ++m) { const size_t r = (size_t)(row0 + ai * HALF + m * 16);
#pragma unroll
                for (int bj = 0; bj < 2; ++bj) { const u32x4 gb = *(const u32x4*)(Zg + r * ldz + col0 + 1024 + bj * HALF);
                    f32x4 v0 = acc[ai][bj][m][0], v1 = acc[ai][bj][m][1];
                    v0[0] *= fmaxf(bf_lo(gb.x), 1e-30f); v0[1] *= fmaxf(bf_hi(gb.x), 1e-30f); v0[2] *= fmaxf(bf_lo(gb.y), 1e-30f); v0[3] *= fmaxf(bf_hi(gb.y), 1e-30f);
                    v1[0] *= fmaxf(bf_lo(gb.z), 1e-30f); v1[1] *= fmaxf(bf_hi(gb.z), 1e-30f); v1[2] *= fmaxf(bf_lo(gb.w), 1e-30f); v1[3] *= fmaxf(bf_hi(gb.w), 1e-30f);
                    u32x4 w; w.x = cvt_pk_bf16(v0[0], v0[1]); w.y = cvt_pk_bf16(v0[2], v0[3]); w.z = cvt_pk_bf16(v1[0], v1[1]); w.w = cvt_pk_bf16(v1[2], v1[3]);
                    *(u32x4*)(O + r * ldc + col0 + bj * HALF) = w; } }
    }
};
struct EpiSwiGLU {
    static constexpr bool PERM = true, AFTER_DRAIN = false, HAS_MID = false; static constexpr int TMID = -1;
    bf16_t* O; int ldc;
    __device__ __forceinline__ void mid(f32x4 (&)[2][2][4][2], const Unit&, int, int, int, int) const {}
    __device__ __forceinline__ void operator()(const f32x4 (&acc)[2][2][4][2], const Unit& u, int wr, int wc, int fr, int fq) const {
        int row0 = u.pm * BM + wr * 64 + fr; const int col0 = u.pn * HALF + wc * 32 + 8 * fq; asm volatile("" : "+v"(row0));
#pragma unroll
        for (int ai = 0; ai < 2; ++ai)
#pragma unroll
            for (int m = 0; m < 4; ++m) { bf16_t* rowp = O + (size_t)(row0 + ai * HALF + m * 16) * ldc + col0;
                const f32x4 g0 = acc[ai][0][m][0], g1 = acc[ai][0][m][1], u0 = acc[ai][1][m][0], u1 = acc[ai][1][m][1];
                const f32x2p ga = (f32x2p){g0[0], g0[1]}, gb = (f32x2p){g0[2], g0[3]}, gc = (f32x2p){g1[0], g1[1]}, gd = (f32x2p){g1[2], g1[3]};
                const f32x2p oa = ga * sigmoid2(ga) * (f32x2p){u0[0], u0[1]}, ob = gb * sigmoid2(gb) * (f32x2p){u0[2], u0[3]}, oc = gc * sigmoid2(gc) * (f32x2p){u1[0], u1[1]}, od = gd * sigmoid2(gd) * (f32x2p){u1[2], u1[3]};
                u32x4 w; w.x = cvt_pk_bf16(oa.x, oa.y); w.y = cvt_pk_bf16(ob.x, ob.y); w.z = cvt_pk_bf16(oc.x, oc.y); w.w = cvt_pk_bf16(od.x, od.y);
                *(u32x4*)rowp = w; }
    }
};

struct EpiFinal {
    static constexpr bool PERM = true, AFTER_DRAIN = false, HAS_MID = false; static constexpr int TMID = -1;
    const float* x; const bf16_t* mix; int ldm; const float* rstd1; const float* g1; const float* g3; float* out;
    float* xch; unsigned* cnt; PG8_LAS unsigned char* scr;
    __device__ __forceinline__ void mid(f32x4 (&)[2][2][4][2], const Unit&, int, int, int, int) const {}
    __device__ __forceinline__ void operator()(const f32x4 (&acc)[2][2][4][2], const Unit& u, int wr, int wc, int fr, int fq) const {
        const int tid = threadIdx.x, lane = tid & 63, wid = __builtin_amdgcn_readfirstlane(tid >> 6);
        PG8_LAS float* P = (PG8_LAS float*)scr;
        PG8_LAS float* S = (PG8_LAS float*)(scr + 4096);
#pragma unroll
        for (int ai = 0; ai < 2; ++ai)
#pragma unroll
            for (int m = 0; m < 4; ++m) { float q = 0.f;
#pragma unroll
                for (int bj = 0; bj < 2; ++bj)
#pragma unroll
                    for (int n = 0; n < 2; ++n) { const f32x4 v = acc[ai][bj][m][n]; q += (v[0] * v[0] + v[1] * v[1]) + (v[2] * v[2] + v[3] * v[3]); }
                q += __shfl_xor(q, 16); q += __shfl_xor(q, 32);
                if (fq == 0) P[(ai * HALF + wr * 64 + m * 16 + fr) * 4 + wc] = q; }
        asm volatile("s_waitcnt lgkmcnt(0)" ::: "memory"); __builtin_amdgcn_s_barrier(); asm volatile("" ::: "memory");
        if (tid < 256) { const f32x4 p = *(const PG8_LAS f32x4*)(P + tid * 4);
            __hip_atomic_store(xch + ((size_t)(u.pm * BM + tid) * 4 + u.pn), (p[0] + p[1]) + (p[2] + p[3]), __ATOMIC_RELAXED, __HIP_MEMORY_SCOPE_AGENT); }
        asm volatile("s_waitcnt vmcnt(0)" ::: "memory");
        if (tid < 256 && lane == 0) __hip_atomic_fetch_add(cnt + 64 * u.pm, 1u, __ATOMIC_RELAXED, __HIP_MEMORY_SCOPE_AGENT);
        if (wid == 0) { unsigned sp = 0;
            while ((unsigned)__builtin_amdgcn_readfirstlane(__hip_atomic_load(cnt + 64 * u.pm, __ATOMIC_RELAXED, __HIP_MEMORY_SCOPE_AGENT)) < 16u) { __builtin_amdgcn_s_sleep(2); if (++sp > (1u << 24)) break; }
            __builtin_amdgcn_fence(__ATOMIC_ACQUIRE, "agent"); }
        asm volatile("s_waitcnt vmcnt(0) lgkmcnt(0)" ::: "memory"); __builtin_amdgcn_s_barrier(); asm volatile("" ::: "memory");
        if (tid < 256) { const float* slot = xch + (size_t)(u.pm * BM + tid) * 4;
            const float t0 = __hip_atomic_load(slot + 0, __ATOMIC_RELAXED, __HIP_MEMORY_SCOPE_AGENT), t1 = __hip_atomic_load(slot + 1, __ATOMIC_RELAXED, __HIP_MEMORY_SCOPE_AGENT);
            const float t2 = __hip_atomic_load(slot + 2, __ATOMIC_RELAXED, __HIP_MEMORY_SCOPE_AGENT), t3 = __hip_atomic_load(slot + 3, __ATOMIC_RELAXED, __HIP_MEMORY_SCOPE_AGENT);
            S[tid] = __builtin_amdgcn_rsqf(((t0 + t1) + (t2 + t3)) * (1.0f / 1024.0f) + 1e-6f); }
        asm volatile("s_waitcnt lgkmcnt(0)" ::: "memory"); __builtin_amdgcn_s_barrier(); asm volatile("" ::: "memory");
        int row0 = u.pm * BM + wr * 64 + fr; const int col0 = u.pn * BM + wc * 32 + 8 * fq; asm volatile("" : "+v"(row0));
        f32x4 ga[2][2], gc[2][2];
#pragma unroll
        for (int bj = 0; bj < 2; ++bj)
#pragma unroll
            for (int n = 0; n < 2; ++n) { ga[bj][n] = *(const f32x4*)(g1 + col0 + bj * HALF + 4 * n); gc[bj][n] = *(const f32x4*)(g3 + col0 + bj * HALF + 4 * n); }
#pragma unroll
        for (int ai = 0; ai < 2; ++ai)
#pragma unroll
            for (int m = 0; m < 4; ++m) { const int rl = ai * HALF + wr * 64 + m * 16 + fr; const size_t r = (size_t)(row0 + ai * HALF + m * 16);
                const float r3 = S[rl], r1 = rstd1[r];
#pragma unroll
                for (int bj = 0; bj < 2; ++bj) { const float* xp = x + r * 1024 + col0 + bj * HALF; const u32x4 mw = *(const u32x4*)(mix + r * ldm + col0 + bj * HALF);
                    const f32x4 x0 = *(const f32x4*)xp, x1 = *(const f32x4*)(xp + 4);
                    const f32x4 m0 = (f32x4){bf_lo(mw.x), bf_hi(mw.x), bf_lo(mw.y), bf_hi(mw.y)}, m1 = (f32x4){bf_lo(mw.z), bf_hi(mw.z), bf_lo(mw.w), bf_hi(mw.w)};
                    float* op = out + r * 1024 + col0 + bj * HALF;
                    *(f32x4*)op = x0 + m0 * r1 * ga[bj][0] + acc[ai][bj][m][0] * r3 * gc[bj][0];
                    *(f32x4*)(op + 4) = x1 + m1 * r1 * ga[bj][1] + acc[ai][bj][m][1] * r3 * gc[bj][1]; }
                asm volatile("" ::: "memory"); }
    }
};

template <class Epi, class Sched, bool ALIGN_EPI = false, bool SP2 = false>
__device__ __forceinline__ void gemm_phase(PG8_LAS unsigned char* lds, const Gemm g, const Sched& S, const Epi& E) {
    const int tid = threadIdx.x, wid = __builtin_amdgcn_readfirstlane(tid >> 6), lane = tid & 63, wr = wid >> 2, wc = wid & 3, fr = lane & 15, fq = lane >> 4;
    const int K = g.K, nt = K / BK;
    unsigned voffA[2], voffB[2];
#pragma unroll
    for (int i = 0; i < 2; ++i) { int R, C; stage_rc(tid * 16 + i * 8192, R, C); const int Rb = Epi::PERM ? ((R & ~31) + perm32(R & 31)) : R;
        voffA[i] = (unsigned)(R * g.lda + C) * 2u; voffB[i] = (unsigned)(Rb * g.ldb + C) * 2u; }
    const size_t kstep = (size_t)(BK * 2);
    const size_t hstepA = (size_t)HALF * g.lda * 2, hstepB = (size_t)HALF * g.ldb * 2;
    const size_t tstepA = 2 * hstepA, tstepB = 2 * hstepB;
    const unsigned ldsw = (unsigned)wid * 1024u;
    const int aoff = lds_byte(wr * 64 + fr, fq * 8), boff = lds_byte(wc * 32 + fr, fq * 8);
#define PG8_SA(b, h) (((b) * 2 + (h)) * HTB)
#define PG8_SB(b, h) ((4 + (b) * 2 + (h)) * HTB)
#define PG8_STAGE(bufoff, gbase, voff) do { _Pragma("unroll") for (int _i = 0; _i < 2; ++_i) \
        __builtin_amdgcn_global_load_lds((const unsigned*)((const char*)(gbase) + (voff)[_i]), (PG8_LAS unsigned*)(lds + (bufoff) + ldsw + _i * 8192), 16, 0, 0); } while (0)
#define PG8_LDA(dst, b, h) do { _Pragma("unroll") for (int m = 0; m < 4; ++m) _Pragma("unroll") for (int k = 0; k < 2; ++k) dst[m][k] = *(const PG8_LAS bf16x8*)(lds + PG8_SA(b, h) + aoff + m * 2048 + k * 1024); } while (0)
#define PG8_LDB(dst, b, h) do { _Pragma("unroll") for (int n = 0; n < 2; ++n) _Pragma("unroll") for (int k = 0; k < 2; ++k) dst[n][k] = *(const PG8_LAS bf16x8*)(lds + PG8_SB(b, h) + boff + n * 2048 + k * 1024); } while (0)
#define PG8_MMA(ai, bj, At, Bt) do { __builtin_amdgcn_s_setprio(1); _Pragma("unroll") for (int m = 0; m < 4; ++m) _Pragma("unroll") for (int n = 0; n < 2; ++n) _Pragma("unroll") for (int k = 0; k < 2; ++k) \
        acc[ai][bj][m][n] = __builtin_amdgcn_mfma_f32_16x16x32_bf16(Bt[n][k], At[m][k], acc[ai][bj][m][n], 0, 0, 0); __builtin_amdgcn_s_setprio(0); } while (0)
#define PG8_WAIT_V(n) asm volatile("s_waitcnt vmcnt(" #n ")" ::: "memory")
#define PG8_WAIT_L(n) asm volatile("s_waitcnt lgkmcnt(" #n ")" ::: "memory")
#define PG8_BAR __builtin_amdgcn_s_barrier()
#define PG8_SCHED __builtin_amdgcn_sched_barrier(0)
    Unit cur, nxt; int ui = 0;
    if (!S.next(0, cur)) return;
    f32x4 acc[2][2][4][2];
#pragma unroll
    for (int a = 0; a < 2; ++a)
#pragma unroll
        for (int b = 0; b < 2; ++b)
#pragma unroll
            for (int m = 0; m < 4; ++m)
#pragma unroll
                for (int n = 0; n < 2; ++n) acc[a][b][m][n] = (f32x4){0.f, 0.f, 0.f, 0.f};
    bf16x8 At[4][2], B0[2][2], B1[2][2];
    const char* cA = (const char*)g.A + (size_t)cur.pm * tstepA; const char* cB = (const char*)g.Bt + (size_t)cur.pn * tstepB;
    S.a_ready(cur);
    if constexpr (SP2) {
        PG8_STAGE(PG8_SB(0, 0), cB, voffB); PG8_STAGE(PG8_SB(0, 1), cB + hstepB, voffB); PG8_STAGE(PG8_SA(0, 0), cA, voffA); PG8_STAGE(PG8_SA(0, 1), cA + hstepA, voffA);
        if (wr == 1) PG8_BAR;
        PG8_WAIT_V(2); PG8_BAR;
        PG8_STAGE(PG8_SB(1, 0), cB + kstep, voffB); PG8_STAGE(PG8_SA(1, 0), cA + kstep, voffA); PG8_STAGE(PG8_SB(1, 1), cB + hstepB + kstep, voffB);
        PG8_WAIT_V(6); PG8_BAR;
    } else {
        PG8_STAGE(PG8_SB(0, 0), cB, voffB); PG8_STAGE(PG8_SA(0, 0), cA, voffA); PG8_STAGE(PG8_SB(0, 1), cB + hstepB, voffB); PG8_STAGE(PG8_SA(0, 1), cA + hstepA, voffA);
        if (wr == 1) PG8_BAR;
        PG8_WAIT_V(4); PG8_BAR;
        PG8_STAGE(PG8_SB(1, 0), cB + kstep, voffB); PG8_STAGE(PG8_SA(1, 0), cA + kstep, voffA); PG8_STAGE(PG8_SB(1, 1), cB + hstepB + kstep, voffB);
        PG8_WAIT_V(6); PG8_BAR;
    }
    for (;;) {
        const bool has_next = S.next(ui + 1, nxt);
        const char* nA = has_next ? (const char*)g.A + (size_t)nxt.pm * tstepA : cA; const char* nB = has_next ? (const char*)g.Bt + (size_t)nxt.pn * tstepB : cB;
        for (int t = 0; t < nt; t += 2) {
            const bool last = (t == nt - 2);
            const char* a1 = cA + (size_t)(t + 1) * kstep;
            const char* a2 = last ? nA : cA + (size_t)(t + 2) * kstep; const char* b2 = last ? nB : cB + (size_t)(t + 2) * kstep;
            const char* a3 = a2 + kstep; const char* b3 = b2 + kstep;
            if (last && has_next) S.a_ready(nxt);
            if constexpr (Epi::HAS_MID) { if (t == Epi::TMID) E.mid(acc, cur, wr, wc, fr, fq); }
            if constexpr (SP2) {
            PG8_LDB(B0, 0, 0); PG8_LDB(B1, 0, 1); PG8_SCHED; PG8_LDA(At, 0, 0); PG8_STAGE(PG8_SA(1, 1), a1 + hstepA, voffA);
            PG8_WAIT_V(8); PG8_WAIT_L(0); PG8_BAR; PG8_MMA(0, 0, At, B0); PG8_MMA(0, 1, At, B1); PG8_BAR; PG8_SCHED;
            PG8_LDA(At, 0, 1); PG8_STAGE(PG8_SB(0, 0), b2, voffB); PG8_STAGE(PG8_SB(0, 1), b2 + hstepB, voffB); PG8_STAGE(PG8_SA(0, 0), a2, voffA);
            PG8_WAIT_V(8); PG8_WAIT_L(0); PG8_BAR; PG8_MMA(1, 0, At, B0); PG8_MMA(1, 1, At, B1); PG8_BAR; PG8_SCHED;
            PG8_LDB(B0, 1, 0); PG8_LDB(B1, 1, 1); PG8_SCHED; PG8_LDA(At, 1, 0); PG8_STAGE(PG8_SA(0, 1), a2 + hstepA, voffA);
            PG8_WAIT_V(8); PG8_WAIT_L(0); PG8_BAR; PG8_MMA(0, 0, At, B0); PG8_MMA(0, 1, At, B1); PG8_BAR; PG8_SCHED;
            PG8_LDA(At, 1, 1); PG8_STAGE(PG8_SB(1, 0), b3, voffB); PG8_STAGE(PG8_SB(1, 1), b3 + hstepB, voffB); PG8_STAGE(PG8_SA(1, 0), a3, voffA);
            PG8_WAIT_V(8); PG8_WAIT_L(0); PG8_BAR; PG8_MMA(1, 0, At, B0); PG8_MMA(1, 1, At, B1); PG8_BAR; PG8_SCHED;
            } else {
            PG8_LDB(B0, 0, 0); PG8_SCHED; PG8_LDA(At, 0, 0); PG8_STAGE(PG8_SA(1, 1), a1 + hstepA, voffA);
            PG8_WAIT_L(8); PG8_BAR; PG8_WAIT_L(0); PG8_MMA(0, 0, At, B0); PG8_BAR; PG8_SCHED;
            PG8_LDB(B1, 0, 1); PG8_STAGE(PG8_SB(0, 0), b2, voffB);
            PG8_BAR; PG8_WAIT_L(0); PG8_MMA(0, 1, At, B1); PG8_BAR;
            PG8_LDA(At, 0, 1); PG8_STAGE(PG8_SA(0, 0), a2, voffA);
            PG8_BAR; PG8_WAIT_L(0); PG8_MMA(1, 0, At, B0); PG8_BAR; PG8_SCHED;
            PG8_STAGE(PG8_SB(0, 1), b2 + hstepB, voffB);
            PG8_WAIT_V(6); PG8_BAR; PG8_MMA(1, 1, At, B1); PG8_BAR;
            PG8_LDB(B0, 1, 0); PG8_SCHED; PG8_LDA(At, 1, 0); PG8_STAGE(PG8_SA(0, 1), a2 + hstepA, voffA);
            PG8_WAIT_L(8); PG8_BAR; PG8_WAIT_L(0); PG8_MMA(0, 0, At, B0); PG8_BAR; PG8_SCHED;
            PG8_LDB(B1, 1, 1); PG8_STAGE(PG8_SB(1, 0), b3, voffB);
            PG8_BAR; PG8_WAIT_L(0); PG8_MMA(0, 1, At, B1); PG8_BAR;
            PG8_LDA(At, 1, 1); PG8_STAGE(PG8_SA(1, 0), a3, voffA);
            PG8_BAR; PG8_WAIT_L(0); PG8_MMA(1, 0, At, B0); PG8_BAR; PG8_SCHED;
            PG8_STAGE(PG8_SB(1, 1), b3 + hstepB, voffB);
            PG8_WAIT_V(6); PG8_BAR; PG8_MMA(1, 1, At, B1); PG8_BAR;
            }
        }
        if constexpr (ALIGN_EPI) { if (wr == 0) PG8_BAR; }
        E(acc, cur, wr, wc, fr, fq); S.done(cur);
        if (!has_next) break;
#pragma unroll
        for (int a = 0; a < 2; ++a)
#pragma unroll
            for (int b = 0; b < 2; ++b)
#pragma unroll
                for (int m = 0; m < 4; ++m)
#pragma unroll
                    for (int n = 0; n < 2; ++n) acc[a][b][m][n] = (f32x4){0.f, 0.f, 0.f, 0.f};
        cur = nxt; cA = nA; cB = nB; ++ui;
        if constexpr (ALIGN_EPI) { if (wr == 1) PG8_BAR; }
    }
    PG8_WAIT_V(0);
    if constexpr (!ALIGN_EPI) { if (wr == 0) PG8_BAR; }
    PG8_BAR;
#undef PG8_SA
#undef PG8_SB
#undef PG8_STAGE
#undef PG8_LDA
#undef PG8_LDB
#undef PG8_MMA
#undef PG8_WAIT_V
#undef PG8_WAIT_L
#undef PG8_BAR
#undef PG8_SCHED
}
}

#ifndef PG8_SP2
#define PG8_SP2 true
#endif
#ifndef PG8_ALIGN
#define PG8_ALIGN true
#endif

constexpr int NWAVES = 8;
constexpr int N_LAUNCHES = MK_N_LAUNCHES;
constexpr int PER_PHASE = 9;
constexpr int DM = 1024, SEQ = 2048, NB = 16, DEC_T = 32;
constexpr int MP = NB * SEQ, MS = NB * DEC_T, M = MP + MS;
constexpr int DIN = 6144, DFF = 2816, DFF2 = 5632;
constexpr int LDX = 1088, LDZ = 6208, LDW2 = 2112;
constexpr float EPS = 1e-6f;
static_assert(M % 256 == 0, "M");
enum { I_XP = 0, I_XS, I_SH, I_SC, I_GPRE, I_WIN, I_CW, I_CB, I_WA, I_BA, I_WX, I_BX, I_LAM, I_WBRA, I_LNG, I_LNB, I_WS, I_BS, I_WBRB, I_WOUT, I_GPOST, I_GFFN, I_WFI, I_WFO, I_GPF, N_IN };
constexpr size_t O_Y = 0, O_HP = (size_t)M * DM, O_CP = O_HP + NB * DM, O_HS = O_CP + (size_t)NB * 3 * DM, O_CS = O_HS + NB * DM, O_VS = O_CS + (size_t)NB * 3 * DM, O_END = O_VS + (size_t)MS * DM;
static_assert(O_END == 34734080, "output size");

constexpr size_t MiB = 1u << 20;
constexpr size_t WS_CTL = 0, CTL_ZERO_BYTES = 1 * MiB;
constexpr size_t WS_W1 = 1 * MiB;
constexpr size_t WS_W2 = WS_W1 + (size_t)DIN * LDX * 2;
constexpr size_t WS_W3 = WS_W2 + (size_t)DM * LDW2 * 2;
constexpr size_t WS_W4 = WS_W3 + (size_t)DM * LDX * 2;
constexpr size_t WS_W5 = WS_W4 + (size_t)DFF2 * LDX * 2;
constexpr size_t WS_GT = WS_W5 + (size_t)DM * DFF * 2;
constexpr size_t WS_WSM = WS_GT + 16 * 128 * 64 * 2;
constexpr size_t WS_WSS = WS_WSM + 8 * 128 * 128 * 2;
constexpr size_t WS_WEND = WS_WSS + 8 * 128 * 128 * 2;
constexpr size_t WS_XN = 39 * MiB;
constexpr size_t WS_Z = 109 * MiB;
constexpr size_t WS_MIX = WS_Z;
constexpr size_t WS_FIN = WS_Z + 70 * MiB;
constexpr size_t WS_F = WS_FIN + 179 * MiB;
constexpr size_t WS_STAT = 504 * MiB;
constexpr size_t WS_END = WS_STAT + (size_t)M * 16 * 2 * 4;
static_assert(WS_WEND <= WS_XN && WS_XN + (size_t)M * LDX * 2 <= WS_Z && WS_MIX + (size_t)M * LDX * 2 <= WS_FIN && WS_FIN + (size_t)M * DFF * 2 <= WS_F && WS_F + (size_t)M * LDX * 2 <= WS_Z + (size_t)M * LDZ * 2 && WS_Z + (size_t)M * LDZ * 2 <= WS_STAT && WS_END <= 512 * MiB, "d_ws map");
constexpr int CW_TMO = 0, CW_BAR = 4096, CW_SEAM = 16384;
constexpr size_t WS_XCH = WS_STAT, WS_RSTD1 = WS_STAT + 1 * MiB;

constexpr int RING_OFF = 0, RING_BYTES = 131072;
constexpr int LDSCTL_OFF = 139264, MISC_OFF = LDSCTL_OFF + 320;
constexpr int LDS_BYTES = 147456;

#define GAS __attribute__((address_space(1)))
#define LAS __attribute__((address_space(3)))
typedef unsigned short bf16;
typedef unsigned v4u __attribute__((ext_vector_type(4)));
typedef unsigned v2u __attribute__((ext_vector_type(2)));
typedef float f32x4 __attribute__((ext_vector_type(4)));
typedef float f32x16 __attribute__((ext_vector_type(16)));
typedef short bf16x8 __attribute__((ext_vector_type(8)));
typedef GAS unsigned gu32;
#define RLX_AGENT __ATOMIC_RELAXED, __HIP_MEMORY_SCOPE_AGENT
#define LDS_WAIT() asm volatile("s_waitcnt lgkmcnt(0)" ::: "memory")
#define VM_WAIT() asm volatile("s_waitcnt vmcnt(0)" ::: "memory")
__device__ __forceinline__ unsigned f2bf(float f) { unsigned u = __builtin_bit_cast(unsigned, f); return (u + 0x7fffu + ((u >> 16) & 1u)) >> 16; }
__device__ __forceinline__ unsigned pk2(float lo, float hi) { unsigned r; asm volatile("v_cvt_pk_bf16_f32 %0, %1, %2" : "=v"(r) : "v"(lo), "v"(hi)); return r; }
__device__ __forceinline__ float bflo(unsigned w) { return __uint_as_float(w << 16); }
__device__ __forceinline__ float bfhi(unsigned w) { return __uint_as_float(w & 0xffff0000u); }

#define XB_TMO      128
#define XB_XCNT(j)  (256  + 64 * (j))
#define XB_XSUB(j)  (1280 + 64 * (j))
#define XB_XGEN(j)  (2304 + 64 * (j))
#define XB_TOP      3328
#define XB_TOPGEN   3392
#define XCD_BAR_WORDS 3456
#define XB_SPIN_CAP (1u << 22)

__device__ __forceinline__ unsigned xb_ld(unsigned* p)              { return __hip_atomic_load(p, __ATOMIC_RELAXED, __HIP_MEMORY_SCOPE_AGENT); }
__device__ __forceinline__ unsigned xb_add(unsigned* p, unsigned v) { return __hip_atomic_fetch_add(p, v, __ATOMIC_RELAXED, __HIP_MEMORY_SCOPE_AGENT); }
__device__ __forceinline__ unsigned xb_xcc_id() { return (unsigned)__builtin_amdgcn_s_getreg((3 << 11) | 20) & 0xFu; }
#define XB_SPIN(cond, bar) do { unsigned _sp = 0; while (cond) { __builtin_amdgcn_s_sleep(1); \
    if ((++_sp & 255u) == 0u) { if (xb_ld(&(bar)[XB_TMO])) break; if (_sp > XB_SPIN_CAP) { atomicAdd(&(bar)[XB_TMO], 1u); break; } } } } while (0)

struct XcdBarrier { unsigned* bar; unsigned x; volatile LAS unsigned* st; };

__device__ __forceinline__ XcdBarrier xcd_barrier_post(unsigned* bar, volatile LAS unsigned* st) {
    XcdBarrier b; b.bar = bar; b.x = xb_xcc_id(); b.st = st;
    if (threadIdx.x == 0) (void)xb_add(&bar[XB_XCNT(b.x)], 1u);
    return b;
}
__device__ __forceinline__ void xcd_barrier_complete(unsigned* bar, unsigned x, unsigned& nloc, unsigned& nx) {
    const unsigned G = gridDim.x * gridDim.y * gridDim.z;
    unsigned sum, cnt, mine, sp = 0u;
    for (;;) {
        sum = 0u; cnt = 0u; mine = 0u;
#pragma unroll
        for (unsigned j = 0; j < 16; ++j) { const unsigned c = xb_ld(&bar[XB_XCNT(j)]); sum += c; cnt += (c > 0u) ? 1u : 0u; mine = (j == x) ? c : mine; }
        if (sum == G) break;
        __builtin_amdgcn_s_sleep(1);
        if ((++sp & 255u) == 0u) { if (xb_ld(&bar[XB_TMO])) break; if (sp > XB_SPIN_CAP) { atomicAdd(&bar[XB_TMO], 1u); break; } }
    }
    nloc = mine > 0u ? mine : 1u; nx = cnt > 0u ? cnt : 1u;
}
__device__ __forceinline__ void xcd_barrier(const XcdBarrier& b) {
    asm volatile("s_waitcnt vmcnt(0)" ::: "memory");
    __syncthreads();
    if (threadIdx.x == 0) {
        unsigned* bar = b.bar;
        __builtin_amdgcn_s_waitcnt(0);
        unsigned nloc = b.st[0], nx = b.st[1];
        if (nloc == 0u) { xcd_barrier_complete(bar, b.x, nloc, nx); b.st[0] = nloc; b.st[1] = nx; }
        const unsigned old = xb_add(&bar[XB_XSUB(b.x)], 1u);
        const unsigned gen = old / nloc;
        if (old + 1u == (gen + 1u) * nloc) {
            __builtin_amdgcn_fence(__ATOMIC_RELEASE, "agent");
            asm volatile("s_waitcnt vmcnt(0)" ::: "memory");
            const unsigned og = xb_add(&bar[XB_TOP], 1u);
            const unsigned tg = og / nx;
            if (og + 1u == (tg + 1u) * nx) xb_add(&bar[XB_TOPGEN], 1u);
            else XB_SPIN(xb_ld(&bar[XB_TOPGEN]) == tg, bar);
            __builtin_amdgcn_fence(__ATOMIC_ACQUIRE, "agent");
            xb_add(&bar[XB_XGEN(b.x)], 1u);
            asm volatile("s_waitcnt vmcnt(0)" ::: "memory");
        } else {
            XB_SPIN(xb_ld(&bar[XB_XGEN(b.x)]) == gen, bar);
            __builtin_amdgcn_fence(__ATOMIC_ACQUIRE, "agent");
            asm volatile("s_waitcnt vmcnt(0)" ::: "memory");
        }
    }
    __syncthreads();
}

struct Args { const float* in[N_IN]; float* out; unsigned char* ws; int ph_lo, ph_hi, li, pad; };
struct Frame {
    LAS unsigned char* lds;
    volatile LAS unsigned* MISC;
    gu32* ctl;
    int tid, lane, wave, vcu, G;
};
__device__ __forceinline__ float wave_sum(float v) {
#pragma unroll
    for (int o = 1; o < 64; o <<= 1) v += __shfl_xor(v, o);
    return v;
}
__device__ __forceinline__ const float* xrow_ptr(const Args& a, int m) { return m < MP ? a.in[I_XP] + (size_t)m * DM : a.in[I_XS] + (size_t)(m - MP) * DM; }

__device__ __forceinline__ void p0_transpose_item(const float* W, int N, bf16* WT, int ldk, int dcol0, int k0, int n0, int drow0, LAS float* scr, int lane) {
#pragma unroll 8
    for (int i = 0; i < 32; ++i) { const int kk = 2 * i + (lane >> 5); scr[kk * 33 + (lane & 31)] = W[(size_t)(k0 + kk) * N + n0 + (lane & 31)]; }
    LDS_WAIT(); asm volatile("" ::: "memory");
    const int c = lane & 7;
#pragma unroll
    for (int j = 0; j < 4; ++j) { const int n = (lane >> 3) + 8 * j; const LAS float* s = scr + (8 * c) * 33 + n;
        v4u o; o.x = pk2(s[0 * 33], s[1 * 33]); o.y = pk2(s[2 * 33], s[3 * 33]); o.z = pk2(s[4 * 33], s[5 * 33]); o.w = pk2(s[6 * 33], s[7 * 33]);
        *(GAS v4u*)(WT + (size_t)(drow0 + n) * ldk + dcol0 + k0 + 8 * c) = o; }
    LDS_WAIT(); asm volatile("" ::: "memory");
}

__device__ __forceinline__ void p0_items(Frame& F, const Args& a, int stage, int gw, int NGW) {
    unsigned char* ws = a.ws;
    LAS float* scr = (LAS float*)(F.lds + RING_OFF + F.wave * 16384);
    constexpr int I1 = (DM / 64) * (DIN / 32), I2 = (DM / 64) * (DM / 32), I4 = (DM / 64) * (DFF2 / 32), I5 = (DFF / 64) * (DM / 32), IG = 64;
    if (stage == 0) {
        for (int it = gw; it < I1 + IG; it += NGW) {
            int r = it;
            if (r < I1) { const int nb = DIN / 32, kb = r / nb, n0 = 32 * (r % nb); p0_transpose_item(a.in[I_WIN], DIN, (bf16*)(ws + WS_W1), LDX, 0, 64 * kb, n0, n0, scr, F.lane); continue; } r -= I1;
            { const int hd = r >> 2, which = (r >> 1) & 1, n0 = 32 * (r & 1);
              p0_transpose_item((which ? a.in[I_WX] : a.in[I_WA]) + (size_t)hd * 4096, 64, (bf16*)(ws + WS_GT) + (size_t)hd * 8192, 64, 0, 0, n0, which * 64 + n0, scr, F.lane); }
        }
    } else if (stage == 1) {
        for (int it = gw; it < 3 * I2 + I4; it += NGW) {
            int r = it;
            if (r < I2) { const int nb = DM / 32, kb = r / nb, n0 = 32 * (r % nb); p0_transpose_item(a.in[I_WBRA], DM, (bf16*)(ws + WS_W2), LDW2, 0, 64 * kb, n0, n0, scr, F.lane); continue; } r -= I2;
            if (r < I2) { const int nb = DM / 32, kb = r / nb, n0 = 32 * (r % nb); p0_transpose_item(a.in[I_WBRB], DM, (bf16*)(ws + WS_W2), LDW2, 1024, 64 * kb, n0, n0, scr, F.lane); continue; } r -= I2;
            if (r < I2) { const int nb = DM / 32, kb = r / nb, n0 = 32 * (r % nb); p0_transpose_item(a.in[I_WOUT], DM, (bf16*)(ws + WS_W3), LDX, 0, 64 * kb, n0, n0, scr, F.lane); continue; } r -= I2;
            { const int nb = DFF2 / 32, kb = r / nb, n0 = 32 * (r % nb); const int s = n0 / DFF, j0 = n0 % DFF, drow0 = 256 * (j0 / 128) + 128 * s + (j0 % 128);
              p0_transpose_item(a.in[I_WFI], DFF2, (bf16*)(ws + WS_W4), LDX, 0, 64 * kb, n0, drow0, scr, F.lane); }
        }
    } else {
        for (int it = gw; it < I5; it += NGW) { const int nb = DM / 32, kb = it / nb, n0 = 32 * (it % nb); p0_transpose_item(a.in[I_WFO], DM, (bf16*)(ws + WS_W5), DFF, 0, 64 * kb, n0, n0, scr, F.lane); }
    }
}
__device__ __forceinline__ void p0_prologue(Frame& F, const Args& a) {
    unsigned char* ws = a.ws;
    const int gw = F.vcu * NWAVES + F.wave, NGW = F.G * NWAVES;
    p0_items(F, a, 0, gw, NGW);
    { const float* wsp = a.in[I_WS]; bf16* wsm = (bf16*)(ws + WS_WSM); bf16* wss = (bf16*)(ws + WS_WSS);
      for (int i = gw * 64 + F.lane; i < 8 * 128 * 128; i += NGW * 64) { const int g = i >> 14, p = (i >> 7) & 127, q = i & 127;
          wsm[i] = (bf16)(((q >> 6) <= (p >> 6)) ? f2bf(wsp[i]) : 0u);
          wss[i] = (bf16)(((q >> 5) == (p >> 5)) ? f2bf(wsp[(g << 14) + ((p & 31) << 7) + (q & 31)]) : 0u); } }
    { const GAS f32x4* gp = (const GAS f32x4*)a.in[I_GPRE] + F.lane; f32x4 gg[4];
#pragma unroll
      for (int j = 0; j < 4; ++j) gg[j] = gp[64 * j];
      bf16* XN = (bf16*)(ws + WS_XN);
      for (int m0 = gw * 4; m0 < M; m0 += NGW * 4) { f32x4 v[4][4];
#pragma unroll
          for (int r = 0; r < 4; ++r) { const GAS f32x4* xr = (const GAS f32x4*)xrow_ptr(a, m0 + r) + F.lane;
#pragma unroll
              for (int j = 0; j < 4; ++j) v[r][j] = xr[64 * j]; }
#pragma unroll
          for (int r = 0; r < 4; ++r) { float s = 0.f;
#pragma unroll
              for (int j = 0; j < 4; ++j) s += (v[r][j].x * v[r][j].x + v[r][j].y * v[r][j].y) + (v[r][j].z * v[r][j].z + v[r][j].w * v[r][j].w);
              const float rstd = __builtin_amdgcn_rsqf(wave_sum(s) * (1.f / DM) + EPS);
              GAS v2u* o8 = (GAS v2u*)(XN + (size_t)(m0 + r) * LDX) + F.lane;
#pragma unroll
              for (int j = 0; j < 4; ++j) { v2u o; o.x = pk2(v[r][j].x * rstd * gg[j].x, v[r][j].y * rstd * gg[j].y); o.y = pk2(v[r][j].z * rstd * gg[j].z, v[r][j].w * rstd * gg[j].w); o8[64 * j] = o; } } } }
}

__device__ __forceinline__ void p2a_item(Frame& F, const Args& a, int row0, int T, int hd, const float* h0, const float* cprev, float* out_h, float* out_conv) {
    LAS unsigned char* lds = F.lds;
    LAS float* XC = (LAS float*)(lds);
    LAS float* AS = (LAS float*)(lds + 32768);
    LAS float* US = (LAS float*)(lds + 65536);
    LAS bf16* XCB = (LAS bf16*)(lds + 98304);
    LAS float* SEGA = (LAS float*)(lds + 116736);
    LAS float* SEGB = (LAS float*)(lds + 118784);
    LAS float* CAR = (LAS float*)(lds + 120832);
    bf16* Z = (bf16*)(a.ws + WS_Z);
    const int tid = F.tid, lane = F.lane, wave = F.wave;
    const int tr = tid >> 3, cg = tid & 7, ch0 = hd * 64 + cg * 8;
    const int tb = wave >> 1, cb = wave & 1, jl = cb * 32 + (lane & 31), hi = lane >> 5;
    __syncthreads();
    typedef float f32x2c __attribute__((ext_vector_type(2)));
    f32x2c cw2[4][4], cbv2[4];
#pragma unroll
    for (int k = 0; k < 4; ++k) { const f32x4 w0 = *(const GAS f32x4*)(a.in[I_CW] + k * DM + ch0), w1 = *(const GAS f32x4*)(a.in[I_CW] + k * DM + ch0 + 4);
        cw2[k][0] = (f32x2c){w0.x, w0.y}; cw2[k][1] = (f32x2c){w0.z, w0.w}; cw2[k][2] = (f32x2c){w1.x, w1.y}; cw2[k][3] = (f32x2c){w1.z, w1.w}; }
    { const f32x4 w0 = *(const GAS f32x4*)(a.in[I_CB] + ch0), w1 = *(const GAS f32x4*)(a.in[I_CB] + ch0 + 4);
      cbv2[0] = (f32x2c){w0.x, w0.y}; cbv2[1] = (f32x2c){w0.z, w0.w}; cbv2[2] = (f32x2c){w1.x, w1.y}; cbv2[3] = (f32x2c){w1.z, w1.w}; }
    bf16x8 Br[4], Bi[4];
    { const bf16* gt = (const bf16*)(a.ws + WS_GT) + (size_t)hd * 8192;
#pragma unroll
      for (int ks = 0; ks < 4; ++ks) { Br[ks] = *(const GAS bf16x8*)(gt + jl * 64 + ks * 16 + hi * 8); Bi[ks] = *(const GAS bf16x8*)(gt + (64 + jl) * 64 + ks * 16 + hi * 8); } }
    float nba = -1.4426950408889634f * a.in[I_BA][hd * 64 + jl], nbx = -1.4426950408889634f * a.in[I_BX][hd * 64 + jl];
    float cA = -8.0f * log1pf(expf(-a.in[I_LAM][hd * 64 + jl])) * 1.4426950408889634f;
    asm volatile("" : "+v"(cA), "+v"(nba), "+v"(nbx));
    if (tid < 64) CAR[tid] = h0 ? h0[hd * 64 + tid] : 0.f;
    const int ntiles = (T + 127) >> 7;
    typedef float f32x2 __attribute__((ext_vector_type(2)));
    v4u xr[5], gg[2];
    const unsigned zbase = (unsigned)row0 * LDZ + ch0;
#define P2A_ISSUE(t0n) do { _Pragma("unroll") for (int r = 0; r < 5; ++r) { int tt = (t0n) + 2 * tr - 3 + r; tt = tt < 0 ? 0 : (tt > T - 1 ? T - 1 : tt); \
        xr[r] = *(const GAS v4u*)(Z + (zbase + (unsigned)tt * LDZ)); } } while (0)
    P2A_ISSUE(0);
    const int pc = tid & 31, sg8 = tid >> 5;
    for (int tile = 0; tile < ntiles; ++tile) {
        const int t0 = tile << 7, nrows = (T - t0) < 128 ? (T - t0) : 128, par = tile & 1;
        {
            f32x2 f[5][4];
#pragma unroll
            for (int r = 0; r < 5; ++r) { const v4u w = xr[r];
                f[r][0] = (f32x2){bflo(w.x), bfhi(w.x)}; f[r][1] = (f32x2){bflo(w.y), bfhi(w.y)}; f[r][2] = (f32x2){bflo(w.z), bfhi(w.z)}; f[r][3] = (f32x2){bflo(w.w), bfhi(w.w)}; }
            if (tile == 0 || nrows < 128) {
#pragma unroll
                for (int r = 0; r < 5; ++r) { const int tt = t0 + 2 * tr - 3 + r;
                    if (tt < 0) {
                        if (cprev) { const f32x4 p0 = *(const GAS f32x4*)(cprev + (tt + 3) * DM + ch0), p1 = *(const GAS f32x4*)(cprev + (tt + 3) * DM + ch0 + 4);
                            f[r][0] = (f32x2){p0.x, p0.y}; f[r][1] = (f32x2){p0.z, p0.w}; f[r][2] = (f32x2){p1.x, p1.y}; f[r][3] = (f32x2){p1.z, p1.w}; }
                        else {
#pragma unroll
                            for (int e = 0; e < 4; ++e) f[r][e] = (f32x2){0.f, 0.f}; }
                    } else if (tt >= T) {
#pragma unroll
                        for (int e = 0; e < 4; ++e) f[r][e] = (f32x2){0.f, 0.f}; } } }
            if (tile + 1 < ntiles) P2A_ISSUE(t0 + 128);
#pragma unroll
            for (int rr = 0; rr < 2; ++rr) { int tl = 2 * tr + rr; tl = tl < nrows ? tl : nrows - 1; gg[rr] = *(const GAS v4u*)(Z + (zbase + (unsigned)(t0 + tl) * LDZ + 1024u)); }
#pragma unroll
            for (int rr = 0; rr < 2; ++rr) { const int tl = 2 * tr + rr, t = t0 + tl; f32x2 xc[4];
#pragma unroll
                for (int e = 0; e < 4; ++e) xc[e] = cbv2[e] + cw2[0][e] * f[rr][e] + cw2[1][e] * f[rr + 1][e] + cw2[2][e] * f[rr + 2][e] + cw2[3][e] * f[rr + 3][e];
                *(LAS f32x4*)(XC + tl * 64 + cg * 8) = (f32x4){xc[0].x, xc[0].y, xc[1].x, xc[1].y}; *(LAS f32x4*)(XC + tl * 64 + cg * 8 + 4) = (f32x4){xc[2].x, xc[2].y, xc[3].x, xc[3].y};
                v4u pw; pw.x = pk2(xc[0].x, xc[0].y); pw.y = pk2(xc[1].x, xc[1].y); pw.z = pk2(xc[2].x, xc[2].y); pw.w = pk2(xc[3].x, xc[3].y);
                *(LAS v4u*)(XCB + tl * 72 + cg * 8) = pw;
                if (tile == ntiles - 1 && t >= T - 3 && t < T) { float* oc = out_conv + (size_t)(t - (T - 3)) * DM + ch0;
                    *(GAS f32x4*)oc = (f32x4){f[rr + 3][0].x, f[rr + 3][0].y, f[rr + 3][1].x, f[rr + 3][1].y}; *(GAS f32x4*)(oc + 4) = (f32x4){f[rr + 3][2].x, f[rr + 3][2].y, f[rr + 3][3].x, f[rr + 3][3].y}; }
            }
        }
        __syncthreads();
        if (tb * 32 < nrows) {
            f32x16 accr, acci;
#pragma unroll
            for (int i = 0; i < 16; ++i) { accr[i] = 0.f; acci[i] = 0.f; }
#pragma unroll
            for (int ks = 0; ks < 4; ++ks) { const bf16x8 A = *(const LAS bf16x8*)(XCB + (tb * 32 + (lane & 31)) * 72 + ks * 16 + hi * 8);
                accr = __builtin_amdgcn_mfma_f32_32x32x16_bf16(A, Br[ks], accr, 0, 0, 0);
                acci = __builtin_amdgcn_mfma_f32_32x32x16_bf16(A, Bi[ks], acci, 0, 0, 0); }
#pragma unroll
            for (int rg = 0; rg < 16; rg += 2) { const int tl = tb * 32 + (rg & 3) + 8 * (rg >> 2) + 4 * hi;
                const f32x2 xcv = (f32x2){XC[tl * 64 + jl], XC[tl * 64 + 64 + jl]};
                f32x2 er = (f32x2){accr[rg], accr[rg + 1]} * -1.4426950408889634f + nba, ei = (f32x2){acci[rg], acci[rg + 1]} * -1.4426950408889634f + nbx;
                er = (f32x2){__builtin_amdgcn_exp2f(er.x), __builtin_amdgcn_exp2f(er.y)} + 1.0f; ei = (f32x2){__builtin_amdgcn_exp2f(ei.x), __builtin_amdgcn_exp2f(ei.y)} + 1.0f;
                const f32x2 r = (f32x2){__builtin_amdgcn_rcpf(er.x), __builtin_amdgcn_rcpf(er.y)}, ig = (f32x2){__builtin_amdgcn_rcpf(ei.x), __builtin_amdgcn_rcpf(ei.y)};
                const f32x2 l2a = r * cA;
                const f32x2 av = (f32x2){__builtin_amdgcn_exp2f(l2a.x), __builtin_amdgcn_exp2f(l2a.y)};
                const f32x2 y = l2a * 1.3862943611198906f;
                const f32x2 ser = -y * (1.0f + y * (0.5f + y * 0.16666667f)), dir = 1.0f - av * av;
                const f32x2 om = (f32x2){(y.x > -0.02f) ? ser.x : dir.x, (y.y > -0.02f) ? ser.y : dir.y};
                const f32x2 uv = (f32x2){__builtin_amdgcn_sqrtf(om.x), __builtin_amdgcn_sqrtf(om.y)} * (ig * xcv);
                AS[tl * 64 + jl] = av.x; AS[tl * 64 + 64 + jl] = av.y; US[tl * 64 + jl] = uv.x; US[tl * 64 + 64 + jl] = uv.y; }
        }
        __syncthreads();
        if (tid < 256 && sg8 * 16 < nrows) { f32x2 Ap = (f32x2){1.f, 1.f}, Bp = (f32x2){0.f, 0.f};
#pragma unroll
            for (int s2 = 0; s2 < 16; ++s2) { const f32x2 av = *(const LAS f32x2*)(AS + (sg8 * 16 + s2) * 64 + 2 * pc), uv = *(const LAS f32x2*)(US + (sg8 * 16 + s2) * 64 + 2 * pc); Bp = av * Bp + uv; Ap *= av; }
            *(LAS f32x2*)(SEGA + sg8 * 64 + 2 * pc) = Ap; *(LAS f32x2*)(SEGB + sg8 * 64 + 2 * pc) = Bp; }
        __syncthreads();
        if (tid < 256 && sg8 * 16 < nrows) { f32x2 h = *(const LAS f32x2*)(CAR + par * 64 + 2 * pc);
            for (int sg = 0; sg < sg8; ++sg) h = *(const LAS f32x2*)(SEGA + sg * 64 + 2 * pc) * h + *(const LAS f32x2*)(SEGB + sg * 64 + 2 * pc);
#pragma unroll
            for (int s2 = 0; s2 < 16; ++s2) { const int tl = sg8 * 16 + s2; h = *(const LAS f32x2*)(AS + tl * 64 + 2 * pc) * h + *(const LAS f32x2*)(US + tl * 64 + 2 * pc); *(LAS f32x2*)(US + tl * 64 + 2 * pc) = h; }
            if (t0 + sg8 * 16 + 15 == T - 1) *(f32x2*)(out_h + hd * 64 + 2 * pc) = h;
            if (sg8 == 7) *(LAS f32x2*)(CAR + (par ^ 1) * 64 + 2 * pc) = h; }
        __syncthreads();
#pragma unroll
        for (int rr = 0; rr < 2; ++rr) { const int tl = 2 * tr + rr;
            if (tl < nrows) { const v4u w = gg[rr];
                const f32x4 h0v = *(const LAS f32x4*)(US + tl * 64 + cg * 8), h1v = *(const LAS f32x4*)(US + tl * 64 + cg * 8 + 4);
                const f32x2 y0 = (f32x2){h0v.x, h0v.y} * (f32x2){bflo(w.x), bfhi(w.x)}, y1 = (f32x2){h0v.z, h0v.w} * (f32x2){bflo(w.y), bfhi(w.y)};
                const f32x2 y2 = (f32x2){h1v.x, h1v.y} * (f32x2){bflo(w.z), bfhi(w.z)}, y3 = (f32x2){h1v.z, h1v.w} * (f32x2){bflo(w.w), bfhi(w.w)};
                v4u o; o.x = pk2(y0.x, y0.y); o.y = pk2(y1.x, y1.y); o.z = pk2(y2.x, y2.y); o.w = pk2(y3.x, y3.y);
                *(GAS v4u*)(Z + (zbase + (unsigned)(t0 + tl) * LDZ + 1024u)) = o; } }
    }
#undef P2A_ISSUE
}

__device__ __forceinline__ int vt_off(int d, int q) { return d * 256 + ((((q >> 3) ^ (d & 15) ^ ((d >> 4) & 7)) & 15) << 4) + (q & 7) * 2; }
__device__ __forceinline__ void p2b_item(Frame& F, const Args& a, int item, int g_lo, int g_hi) {
    LAS unsigned char* lds = F.lds;
    LAS unsigned char* VT = lds;
    LAS unsigned char* WM = lds + 32768;
    LAS float* SG = (LAS float*)(lds + 65536);
    LAS float* ST = (LAS float*)(lds + 65536 + 67584);
    bf16* Z = (bf16*)(a.ws + WS_Z);
    const int tid = F.tid, lane = F.lane, wave = F.wave;
    const bool sample = item >= MP / 128;
    const int row0 = item * 128;
    const bf16* Wm = (const bf16*)(a.ws + (sample ? WS_WSS : WS_WSM));
    const int cchunk = tid & 15, qg = tid >> 4;
    const int db = wave & 3, pb0 = (wave >> 2) * 2, hi = lane >> 5, l31 = lane & 31;
    typedef float f32x2 __attribute__((ext_vector_type(2)));
    v4u gvr[4], wmr[4]; f32x4 lgr[2], lbr[2]; float bsr[2];
    const unsigned zv0 = (unsigned)(row0 + qg * 4) * LDZ + 3072u + cchunk * 8;
    const unsigned zu0 = (unsigned)(row0 + (tid >> 4)) * LDZ + 2048u + (tid & 15) * 8;
    const unsigned lno = cchunk * 8, bso0 = sample ? l31 : pb0 * 32 + l31, bso1 = sample ? l31 : (pb0 + 1) * 32 + l31;
    const float* lng = a.in[I_LNG]; const float* lnb = a.in[I_LNB]; const float* bsp = a.in[I_BS];
#define P2B_ISSUE(g) do { lgr[0] = *(const GAS f32x4*)(lng + ((g) * 128 + lno)); lgr[1] = *(const GAS f32x4*)(lng + ((g) * 128 + lno + 4)); \
        lbr[0] = *(const GAS f32x4*)(lnb + ((g) * 128 + lno)); lbr[1] = *(const GAS f32x4*)(lnb + ((g) * 128 + lno + 4)); \
        bsr[0] = bsp[(g) * 128 + bso0]; bsr[1] = bsp[(g) * 128 + bso1]; \
        _Pragma("unroll") for (int r = 0; r < 4; ++r) { gvr[r] = *(const GAS v4u*)(Z + (zv0 + (unsigned)r * LDZ + (unsigned)(g) * 128u)); \
        wmr[r] = *(const GAS v4u*)(Wm + ((unsigned)(g) * 16384u + (unsigned)(tid + 512 * r) * 8u)); } } while (0)
    P2B_ISSUE(g_lo);
    __syncthreads();
    if (tid < 128) { const GAS f32x4* sp = (const GAS f32x4*)((const float*)(a.ws + WS_STAT) + (size_t)(row0 + tid) * 32); f32x4 w[8];
#pragma unroll
        for (int i = 0; i < 8; ++i) w[i] = sp[i];
        float s = 0.f, ss = 0.f;
#pragma unroll
        for (int i = 0; i < 8; ++i) { s += w[i].x; ss += w[i].y; s += w[i].z; ss += w[i].w; }
        const float mean = s * (1.f / 1024.f), var = fmaxf(ss * (1.f / 1024.f) - mean * mean, 0.f);
        ST[tid * 2] = mean; ST[tid * 2 + 1] = __builtin_amdgcn_rsqf(var + EPS); }
    __syncthreads();
    for (int g = g_lo; g < g_hi; ++g) {
        { const int d0 = cchunk * 8, col = g * 128 + d0;
          const f32x2 lg2[4] = {(f32x2){lgr[0].x, lgr[0].y}, (f32x2){lgr[0].z, lgr[0].w}, (f32x2){lgr[1].x, lgr[1].y}, (f32x2){lgr[1].z, lgr[1].w}};
          const f32x2 lb2[4] = {(f32x2){lbr[0].x, lbr[0].y}, (f32x2){lbr[0].z, lbr[0].w}, (f32x2){lbr[1].x, lbr[1].y}, (f32x2){lbr[1].z, lbr[1].w}};
          f32x2 vn[4][4];
#pragma unroll
          for (int r = 0; r < 4; ++r) { const int q = qg * 4 + r; const v4u w = gvr[r];
              const f32x2 ms = *(const LAS f32x2*)(ST + q * 2); const float rstd = ms.y, nmr = -ms.x * ms.y;
              vn[r][0] = ((f32x2){bflo(w.x), bfhi(w.x)} * rstd + nmr) * lg2[0] + lb2[0]; vn[r][1] = ((f32x2){bflo(w.y), bfhi(w.y)} * rstd + nmr) * lg2[1] + lb2[1];
              vn[r][2] = ((f32x2){bflo(w.z), bfhi(w.z)} * rstd + nmr) * lg2[2] + lb2[2]; vn[r][3] = ((f32x2){bflo(w.w), bfhi(w.w)} * rstd + nmr) * lg2[3] + lb2[3];
              if (sample) { float* ov = a.out + O_VS + (size_t)(row0 - MP + q) * DM + col;
                  *(GAS f32x4*)ov = (f32x4){vn[r][0].x, vn[r][0].y, vn[r][1].x, vn[r][1].y}; *(GAS f32x4*)(ov + 4) = (f32x4){vn[r][2].x, vn[r][2].y, vn[r][3].x, vn[r][3].y}; } }
#pragma unroll
          for (int ep = 0; ep < 4; ++ep) { v2u o; o.x = pk2(vn[0][ep].x, vn[1][ep].x); o.y = pk2(vn[2][ep].x, vn[3][ep].x); *(LAS v2u*)(VT + vt_off(d0 + 2 * ep, qg * 4)) = o;
              o.x = pk2(vn[0][ep].y, vn[1][ep].y); o.y = pk2(vn[2][ep].y, vn[3][ep].y); *(LAS v2u*)(VT + vt_off(d0 + 2 * ep + 1, qg * 4)) = o; }
#pragma unroll
          for (int r = 0; r < 4; ++r) { const int ch = tid + 512 * r; *(LAS v4u*)(WM + vt_off(ch >> 4, (ch & 15) * 8)) = wmr[r]; } }
        const float bs0 = bsr[0], bs1 = bsr[1];
        v4u gur[4];
#pragma unroll
        for (int r = 0; r < 4; ++r) gur[r] = *(const GAS v4u*)(Z + (zu0 + (unsigned)(32 * r) * LDZ + (unsigned)g * 128u));
        if (g + 1 < g_hi) P2B_ISSUE(g + 1);
        __syncthreads();
        { f32x16 acc[2];
#pragma unroll
          for (int i = 0; i < 16; ++i) { acc[0][i] = 0.f; acc[1][i] = 0.f; }
          const int kmax = (!sample && pb0 == 0) ? 4 : 8;
          const int d = db * 32 + l31;
#pragma unroll
          for (int ks = 0; ks < 8; ++ks) { if (ks < kmax) { const bf16x8 A = *(const LAS bf16x8*)(VT + vt_off(d, ks * 16 + hi * 8));
#pragma unroll
              for (int pi = 0; pi < 2; ++pi) { const bf16x8 B = *(const LAS bf16x8*)(WM + vt_off((pb0 + pi) * 32 + l31, ks * 16 + hi * 8));
                  acc[pi] = __builtin_amdgcn_mfma_f32_32x32x16_bf16(A, B, acc[pi], 0, 0, 0); } } }
#pragma unroll
          for (int pi = 0; pi < 2; ++pi) { const int p = (pb0 + pi) * 32 + l31; const float bs = pi ? bs1 : bs0;
#pragma unroll
              for (int rq = 0; rq < 4; ++rq) *(LAS f32x4*)(SG + p * 132 + db * 32 + 8 * rq + 4 * hi) = (f32x4){acc[pi][rq * 4 + 0], acc[pi][rq * 4 + 1], acc[pi][rq * 4 + 2], acc[pi][rq * 4 + 3]} + bs; } }
        __syncthreads();
#pragma unroll
        for (int r = 0; r < 4; ++r) { const int p = (tid >> 4) + 32 * r, c8 = (tid & 15) * 8;
            const f32x4 s0 = *(const LAS f32x4*)(SG + p * 132 + c8), s1 = *(const LAS f32x4*)(SG + p * 132 + c8 + 4); const v4u w = gur[r];
            const f32x2 y0 = (f32x2){s0.x, s0.y} * (f32x2){bflo(w.x), bfhi(w.x)}, y1 = (f32x2){s0.z, s0.w} * (f32x2){bflo(w.y), bfhi(w.y)};
            const f32x2 y2 = (f32x2){s1.x, s1.y} * (f32x2){bflo(w.z), bfhi(w.z)}, y3 = (f32x2){s1.z, s1.w} * (f32x2){bflo(w.w), bfhi(w.w)};
            v4u o; o.x = pk2(y0.x, y0.y); o.y = pk2(y1.x, y1.y); o.z = pk2(y2.x, y2.y); o.w = pk2(y3.x, y3.y);
            *(GAS v4u*)(Z + (zu0 + (unsigned)(32 * r) * LDZ + (unsigned)g * 128u)) = o; }
    }
#undef P2B_ISSUE
}

__device__ __forceinline__ void p5_rows(Frame& F, const Args& a) {
    const int gw = F.vcu * NWAVES + F.wave, NGW = F.G * NWAVES, lane = F.lane;
    const bf16* MIX = (const bf16*)(a.ws + WS_MIX); bf16* HN = (bf16*)(a.ws + WS_XN);
    f32x4 g1[4], g2[4];
#pragma unroll
    for (int j = 0; j < 4; ++j) { g1[j] = ((const GAS f32x4*)a.in[I_GPOST])[lane + 64 * j]; g2[j] = ((const GAS f32x4*)a.in[I_GFFN])[lane + 64 * j]; }
    for (int m = gw; m < M; m += NGW) { const GAS f32x4* xr = (const GAS f32x4*)xrow_ptr(a, m) + lane; const GAS v2u* mr = (const GAS v2u*)(MIX + (size_t)m * LDX) + lane;
        f32x4 x[4], mx[4]; float s = 0.f;
#pragma unroll
        for (int j = 0; j < 4; ++j) { x[j] = xr[64 * j]; const v2u w = mr[64 * j]; mx[j] = (f32x4){bflo(w.x), bfhi(w.x), bflo(w.y), bfhi(w.y)};
            s += (mx[j].x * mx[j].x + mx[j].y * mx[j].y) + (mx[j].z * mx[j].z + mx[j].w * mx[j].w); }
        const float r1 = __builtin_amdgcn_rsqf(wave_sum(s) * (1.f / DM) + EPS); float s2 = 0.f;
        if (lane == 0) ((float*)(a.ws + WS_RSTD1))[m] = r1;
#pragma unroll
        for (int j = 0; j < 4; ++j) { x[j] = x[j] + mx[j] * r1 * g1[j]; s2 += (x[j].x * x[j].x + x[j].y * x[j].y) + (x[j].z * x[j].z + x[j].w * x[j].w); }
        const float r2 = __builtin_amdgcn_rsqf(wave_sum(s2) * (1.f / DM) + EPS);
        GAS v2u* o8 = (GAS v2u*)(HN + (size_t)m * LDX) + lane;
#pragma unroll
        for (int j = 0; j < 4; ++j) { const f32x4 h = x[j] * r2 * g2[j]; v2u o; o.x = pk2(h.x, h.y); o.y = pk2(h.z, h.w); o8[64 * j] = o; } }
}
__device__ __forceinline__ void p8_rows(Frame& F, const Args& a) {
    const int gw = F.vcu * NWAVES + F.wave, NGW = F.G * NWAVES, lane = F.lane;
    const bf16* MIX = (const bf16*)(a.ws + WS_MIX); const bf16* FF = (const bf16*)(a.ws + WS_F);
    f32x4 g1[4], g3[4];
#pragma unroll
    for (int j = 0; j < 4; ++j) { g1[j] = ((const GAS f32x4*)a.in[I_GPOST])[lane + 64 * j]; g3[j] = ((const GAS f32x4*)a.in[I_GPF])[lane + 64 * j]; }
    for (int m = MP + gw; m < M; m += NGW) { const GAS f32x4* xr = (const GAS f32x4*)xrow_ptr(a, m) + lane; const GAS v2u* mr = (const GAS v2u*)(MIX + (size_t)m * LDX) + lane; const GAS v2u* fr = (const GAS v2u*)(FF + (size_t)m * LDX) + lane;
        f32x4 x[4], mx[4], fx[4]; float s = 0.f, sf = 0.f;
#pragma unroll
        for (int j = 0; j < 4; ++j) { x[j] = xr[64 * j]; const v2u w = mr[64 * j]; mx[j] = (f32x4){bflo(w.x), bfhi(w.x), bflo(w.y), bfhi(w.y)}; const v2u wf = fr[64 * j]; fx[j] = (f32x4){bflo(wf.x), bfhi(wf.x), bflo(wf.y), bfhi(wf.y)};
            s += (mx[j].x * mx[j].x + mx[j].y * mx[j].y) + (mx[j].z * mx[j].z + mx[j].w * mx[j].w); sf += (fx[j].x * fx[j].x + fx[j].y * fx[j].y) + (fx[j].z * fx[j].z + fx[j].w * fx[j].w); }
        const float r1 = __builtin_amdgcn_rsqf(wave_sum(s) * (1.f / DM) + EPS), r3 = __builtin_amdgcn_rsqf(wave_sum(sf) * (1.f / DM) + EPS);
        GAS f32x4* o = (GAS f32x4*)(a.out + O_Y + (size_t)m * DM) + lane;
#pragma unroll
        for (int j = 0; j < 4; ++j) o[64 * j] = x[j] + mx[j] * r1 * g1[j] + fx[j] * r3 * g3[j]; }
}

typedef float f32x4s __attribute__((ext_vector_type(4)));
template <int MODE, int NSTEPS>
__device__ __forceinline__ void small_gemm(Frame& F, const bf16* A, int lda, const bf16* Bt, int ldb, bf16* O, int ldo, const bf16* Zg) {
    LAS float* RED = (LAS float*)F.lds;
    const int tid = F.tid, lane = F.lane, wave = F.wave, kc = lane >> 4, l15 = lane & 15;
    constexpr int KS = NSTEPS * 32;
    for (int task = blockIdx.x; task < 256; task += F.G) {
        const int mt = task & 7, nt = task >> 3;
        const int r0 = MP + mt * 64, c0 = nt * 32;
        const bf16* pa = A + (size_t)(r0 + l15) * lda + wave * KS + kc * 8;
        const bf16* pb = Bt + (size_t)(c0 + l15) * ldb + wave * KS + kc * 8;
        f32x4s acc[4][2];
#pragma unroll
        for (int i = 0; i < 4; ++i) { acc[i][0] = (f32x4s){0.f, 0.f, 0.f, 0.f}; acc[i][1] = (f32x4s){0.f, 0.f, 0.f, 0.f}; }
        bf16x8 fa[2][4][4], fb[2][4][2];
#define SG_LOAD(buf, s0, ns) do { _Pragma("unroll") for (int s = 0; s < (ns); ++s) { \
            _Pragma("unroll") for (int i = 0; i < 4; ++i) fa[buf][s][i] = *(const GAS bf16x8*)(pa + (size_t)(16 * i) * lda + ((s0) + s) * 32); \
            _Pragma("unroll") for (int j = 0; j < 2; ++j) fb[buf][s][j] = *(const GAS bf16x8*)(pb + (size_t)(16 * j) * ldb + ((s0) + s) * 32); } } while (0)
#define SG_MMA(buf, ns) do { _Pragma("unroll") for (int s = 0; s < (ns); ++s) _Pragma("unroll") for (int i = 0; i < 4; ++i) _Pragma("unroll") for (int j = 0; j < 2; ++j) \
            acc[i][j] = __builtin_amdgcn_mfma_f32_16x16x32_bf16(fa[buf][s][i], fb[buf][s][j], acc[i][j], 0, 0, 0); } while (0)
        if (NSTEPS == 4) { SG_LOAD(0, 0, 4); SG_MMA(0, 4); }
        else if (NSTEPS == 8) { SG_LOAD(0, 0, 4); SG_LOAD(1, 4, 4); SG_MMA(0, 4); SG_MMA(1, 4); }
        else { SG_LOAD(0, 0, 4); SG_LOAD(1, 4, 4); SG_MMA(0, 4); SG_LOAD(0, 8, 3); SG_MMA(1, 4); SG_MMA(0, 3); }
#undef SG_LOAD
#undef SG_MMA
        __syncthreads();
#pragma unroll
        for (int i = 0; i < 4; ++i)
#pragma unroll
            for (int j = 0; j < 2; ++j)
#pragma unroll
                for (int rg = 0; rg < 4; ++rg) RED[wave * 2304 + (16 * i + 4 * kc + rg) * 36 + 16 * j + l15] = acc[i][j][rg];
        __syncthreads();
        { const int row = tid >> 3, c4 = (tid & 7) * 4, col = c0 + c4; f32x4 v;
            if (MODE == 1) { f32x4 oa = (f32x4){0.f, 0.f, 0.f, 0.f}, ob = oa;
#pragma unroll
                for (int w = 0; w < 4; ++w) { oa += *(const LAS f32x4*)(RED + w * 2304 + row * 36 + c4); ob += *(const LAS f32x4*)(RED + (w + 4) * 2304 + row * 36 + c4); }
                const v2u ga = *(const GAS v2u*)(Zg + (size_t)(r0 + row) * LDZ + col), gb = *(const GAS v2u*)(Zg + (size_t)(r0 + row) * LDZ + 1024 + col);
                v.x = bflo(ga.x) * oa.x + bflo(gb.x) * ob.x; v.y = bfhi(ga.x) * oa.y + bfhi(gb.x) * ob.y; v.z = bflo(ga.y) * oa.z + bflo(gb.y) * ob.z; v.w = bfhi(ga.y) * oa.w + bfhi(gb.y) * ob.w;
            } else { v = (f32x4){0.f, 0.f, 0.f, 0.f};
#pragma unroll
                for (int w = 0; w < 8; ++w) v += *(const LAS f32x4*)(RED + w * 2304 + row * 36 + c4); }
            v2u o; o.x = pk2(v.x, v.y); o.y = pk2(v.z, v.w);
            *(GAS v2u*)(O + (size_t)(r0 + row) * ldo + col) = o; }
    }
    __syncthreads();
}

__global__ void __launch_bounds__(NWAVES * 64, 2) hawk_fwd(Args args) {
    extern __shared__ __attribute__((aligned(16))) unsigned char lds[];
    Frame F;
    F.lds = (LAS unsigned char*)lds;
    F.MISC = (volatile LAS unsigned*)(F.lds + MISC_OFF);
    F.tid = threadIdx.x; F.lane = F.tid & 63; F.wave = __builtin_amdgcn_readfirstlane(F.tid >> 6);
    F.G = gridDim.x; { const int bx = blockIdx.x; F.vcu = (F.G % 8 == 0) ? (bx % 8) * (F.G / 8) + bx / 8 : bx; }
    unsigned char* ws = args.ws;
    F.ctl = (gu32*)(ws + WS_CTL);
    for (int u = F.tid; u < (LDS_BYTES - LDSCTL_OFF) / 4; u += NWAVES * 64) ((LAS unsigned*)(F.lds + LDSCTL_OFF))[u] = 0u;
    __syncthreads();
    XcdBarrier bar; bar.bar = (unsigned*)(F.ctl + CW_BAR); bar.x = 0; bar.st = nullptr;
    if (N_LAUNCHES != PER_PHASE) bar = xcd_barrier_post((unsigned*)(F.ctl + CW_BAR), F.MISC + 8);
#define GRID_BAR() do { if (N_LAUNCHES != PER_PHASE) xcd_barrier(bar); } while (0)
    volatile LAS unsigned long long* tsb = (volatile LAS unsigned long long*)(F.lds + LDSCTL_OFF + 1024);
#define TS(i) do { if (PROBE_TA >= 0 && blockIdx.x == 0 && F.tid == 0) tsb[i] = __builtin_amdgcn_s_memrealtime(); } while (0)
    TS(63);
    const int lo = args.ph_lo, hi = args.ph_hi;
#define IN(k) (lo <= (k) && (k) < hi)
#define BOTH(k) (IN(k) && IN((k) + 1))
    bf16* XN = (bf16*)(ws + WS_XN); bf16* Z = (bf16*)(ws + WS_Z);

#define PH0() do { p0_prologue(F, args); } while (0)
#define PH1() do { pg8::Gemm g{XN, (const bf16*)(ws + WS_W1), LDX, LDX, DM}; pg8::StaticOrder S; S.init(M, DIN, F.G, (int)blockIdx.x); pg8::EpiZ E{Z, LDZ, (float*)(ws + WS_STAT)}; \
        pg8::gemm_phase<pg8::EpiZ, pg8::StaticOrder, PG8_ALIGN, PG8_SP2>(F.lds + RING_OFF, g, S, E); \
        { const int rem = S.nwg % F.G, c = (int)blockIdx.x; if (rem == 0) p0_items(F, args, 1, c * NWAVES + F.wave, F.G * NWAVES); else if (c >= rem) p0_items(F, args, 1, (c - rem) * NWAVES + F.wave, (F.G - rem) * NWAVES); } } while (0)
#define PH3() do { pg8::Gemm g{Z + 1024, (const bf16*)(ws + WS_W2), LDZ, LDW2, 2048}; pg8::StaticOrder S; S.init(MP, DM, F.G, (int)blockIdx.x); pg8::EpiGate E{Z + 4096, LDZ, XN, LDX}; \
        pg8::gemm_phase<pg8::EpiGate, pg8::StaticOrder, PG8_ALIGN, PG8_SP2>(F.lds + RING_OFF, g, S, E); \
        small_gemm<1, 8>(F, Z + 1024, LDZ, (const bf16*)(ws + WS_W2), LDW2, XN, LDX, Z + 4096); } while (0)
#define PH4() do { pg8::Gemm g{XN, (const bf16*)(ws + WS_W3), LDX, LDX, DM}; pg8::StaticOrder S; S.init(MP, DM, F.G, (int)blockIdx.x); pg8::EpiBf16 E{(bf16*)(ws + WS_MIX), LDX}; \
        pg8::gemm_phase<pg8::EpiBf16, pg8::StaticOrder, PG8_ALIGN, PG8_SP2>(F.lds + RING_OFF, g, S, E); \
        small_gemm<2, 4>(F, XN, LDX, (const bf16*)(ws + WS_W3), LDX, (bf16*)(ws + WS_MIX), LDX, nullptr); } while (0)
#define PH5() do { p5_rows(F, args); } while (0)
#define PH6() do { pg8::Gemm g{XN, (const bf16*)(ws + WS_W4), LDX, LDX, DM}; pg8::StaticOrder S; S.init(M, DFF2, F.G, (int)blockIdx.x); pg8::EpiSwiGLU E{(bf16*)(ws + WS_FIN), DFF}; \
        pg8::gemm_phase<pg8::EpiSwiGLU, pg8::StaticOrder, PG8_ALIGN, PG8_SP2>(F.lds + RING_OFF, g, S, E); \
        { const int rem = S.nwg % F.G, c = (int)blockIdx.x; if (rem == 0) p0_items(F, args, 2, c * NWAVES + F.wave, F.G * NWAVES); else if (c >= rem) p0_items(F, args, 2, (c - rem) * NWAVES + F.wave, (F.G - rem) * NWAVES); } } while (0)
#define PH7() do { pg8::Gemm g{(const bf16*)(ws + WS_FIN), (const bf16*)(ws + WS_W5), DFF, DFF, DFF}; pg8::StaticOrder S; S.init(MP, DM, F.G, (int)blockIdx.x); \
        pg8::EpiFinal E{args.in[I_XP], (const bf16*)(ws + WS_MIX), LDX, (const float*)(ws + WS_RSTD1), args.in[I_GPOST], args.in[I_GPF], args.out, (float*)(ws + WS_XCH), (unsigned*)(F.ctl + CW_SEAM), F.lds + RING_BYTES}; \
        const bool small_first = (blockIdx.x & 4) == 0;     \
        if (small_first) small_gemm<2, 11>(F, (const bf16*)(ws + WS_FIN), DFF, (const bf16*)(ws + WS_W5), DFF, (bf16*)(ws + WS_F), LDX, nullptr); \
        pg8::gemm_phase<pg8::EpiFinal, pg8::StaticOrder, PG8_ALIGN, PG8_SP2>(F.lds + RING_OFF, g, S, E); \
        if (!small_first) small_gemm<2, 11>(F, (const bf16*)(ws + WS_FIN), DFF, (const bf16*)(ws + WS_W5), DFF, (bf16*)(ws + WS_F), LDX, nullptr); } while (0)
#define PH8() do { p8_rows(F, args); } while (0)
#define RUN(k, PH) do { if (IN(k)) { PH(); if (PROBE_DOUBLE == (k)) { GRID_BAR(); PH(); } TS(2 * (k)); if (BOTH(k)) GRID_BAR(); TS(2 * (k) + 1); } } while (0)
    RUN(0, PH0);
    RUN(1, PH1);
    if (IN(2)) {
        for (int it = blockIdx.x; it < 2 * NB * 16; it += F.G) {
            if (it < NB * 16) { const int b = it >> 4, hd = it & 15;
                p2a_item(F, args, b * SEQ, SEQ, hd, nullptr, nullptr, args.out + O_HP + (size_t)b * DM, args.out + O_CP + (size_t)b * 3 * DM); }
            else { const int b = (it - NB * 16) >> 4, hd = it & 15;
                p2a_item(F, args, MP + b * DEC_T, DEC_T, hd, args.in[I_SH] + (size_t)b * DM, args.in[I_SC] + (size_t)b * 3 * DM, args.out + O_HS + (size_t)b * DM, args.out + O_CS + (size_t)b * 3 * DM); }
        }
        TS(40);
        for (int it = blockIdx.x; it < MP / 128; it += F.G) p2b_item(F, args, it, 0, 8);
        for (int it = blockIdx.x; it < 32; it += F.G) p2b_item(F, args, MP / 128 + (it >> 3), it & 7, (it & 7) + 1);
        TS(4);
        if (BOTH(2)) GRID_BAR();
        TS(5);
    }
    RUN(3, PH3);
    RUN(4, PH4);
    RUN(5, PH5);
    RUN(6, PH6);
    RUN(7, PH7);
    RUN(8, PH8);
    if (PROBE_TA >= 0 && blockIdx.x == 0 && F.tid == 0) { const unsigned long long d = (tsb[PROBE_TB] - tsb[PROBE_TA]) * PROBE_MULT, t0 = __builtin_amdgcn_s_memrealtime();
        while (__builtin_amdgcn_s_memrealtime() - t0 < d) __builtin_amdgcn_s_sleep(16); }
#undef IN
#undef BOTH
#undef GRID_BAR
}

extern "C" void kernel_launch(void* const* d_in, const int* in_sizes, int n_in, void* d_out, int out_size, void* d_ws, size_t ws_size, hipStream_t stream) {
    static int grid = 0;
    if (grid == 0) {
        if (n_in != N_IN || in_sizes[0] != MP * DM || (size_t)out_size != O_END || ws_size < WS_END) {
            fprintf(stderr, "kernel_launch: shape mismatch (n_in %d, in0 %d, out %d, ws %zu; need ws >= %zu); nothing launched\n", n_in, n_in > 0 ? in_sizes[0] : -1, out_size, ws_size, (size_t)WS_END); grid = -1; return; }
        int dev = 0, cus = 0, per_cu = 0;
        if (hipGetDevice(&dev) != hipSuccess || hipDeviceGetAttribute(&cus, hipDeviceAttributeMultiprocessorCount, dev) != hipSuccess) { fprintf(stderr, "kernel_launch: device query failed\n"); grid = -1; return; }
        if (hipFuncSetAttribute((const void*)hawk_fwd, hipFuncAttributeMaxDynamicSharedMemorySize, LDS_BYTES) != hipSuccess) { fprintf(stderr, "kernel_launch: hipFuncSetAttribute failed\n"); grid = -1; return; }
        if (hipOccupancyMaxActiveBlocksPerMultiprocessor(&per_cu, (const void*)hawk_fwd, NWAVES * 64, LDS_BYTES) != hipSuccess || per_cu < 1) {
            fprintf(stderr, "kernel_launch: occupancy query reports %d workgroups per CU; nothing launched\n", per_cu); (void)hipGetLastError(); grid = -1; return; }
        grid = cus;
    }
    if (grid < 0) return;
    if (hipMemsetAsync((char*)d_ws + WS_CTL, 0, CTL_ZERO_BYTES, stream) != hipSuccess) { fprintf(stderr, "kernel_launch: memset failed\n"); return; }
    Args a{};
    for (int i = 0; i < N_IN; ++i) a.in[i] = (const float*)d_in[i];
    a.out = (float*)d_out; a.ws = (unsigned char*)d_ws;
    for (int li = 0; li < N_LAUNCHES; ++li) {
        a.ph_lo = (N_LAUNCHES == PER_PHASE) ? li : 0; a.ph_hi = (N_LAUNCHES == PER_PHASE) ? li + 1 : PER_PHASE; a.li = li;
        hipLaunchKernelGGL(hawk_fwd, dim3(grid), dim3(NWAVES * 64), LDS_BYTES, stream, a);
        const hipError_t le = hipPeekAtLastError();
        if (le != hipSuccess) { fprintf(stderr, "kernel_launch: launch %d failed: %s\n", li, hipGetErrorName(le)); break; }
    }
}
```

```cpp
#include <hip/hip_runtime.h>
#include <cstdio>
#include <cstdint>

#ifndef MK_N_LAUNCHES
#define MK_N_LAUNCHES 1
#endif
#ifndef PROBE_TA
#define PROBE_TA -1
#define PROBE_TB -1
#endif
#define PROBE_MULT 4
#ifndef PROBE_BLK
#define PROBE_BLK 0
#endif
#ifndef PROBE_DOUBLE
#define PROBE_DOUBLE -1
#endif

namespace pg8 {
#define PG8_LAS __attribute__((address_space(3)))
typedef unsigned short bf16_t;
typedef short bf16x8 __attribute__((ext_vector_type(8)));
typedef float f32x4 __attribute__((ext_vector_type(4)));
typedef unsigned u32x4 __attribute__((ext_vector_type(4)));
constexpr int BM = 256, BK = 64, HALF = 128, HTB = HALF * BK * 2  , STAGE_BYTES = 8 * HTB, NXCD = 8, WGM = 8;

__host__ __device__ __forceinline__ int lds_byte(int r, int c) { const int st = (r >> 4) * 2 + (c >> 5), rr = r & 15, cc = c & 31, ob = rr * 64 + cc * 2; return st * 1024 + (ob ^ (((ob >> 9) & 1) << 5)); }
__host__ __device__ __forceinline__ void stage_rc(int b, int& R, int& C) { const int st = b / 1024, sb = b % 1024, swz = sb ^ (((sb >> 9) & 1) << 5); R = (st >> 1) * 16 + swz / 64; C = (st & 1) * 32 + (swz % 64) / 2; }
__host__ __device__ __forceinline__ int perm32(int rho) { const int n = rho >> 4, i = rho & 15; return 8 * (i >> 2) + 4 * n + (i & 3); }

struct Unit { int pm, pn; };
struct Gemm { const bf16_t* A; const bf16_t* Bt; int lda, ldb, K; };

struct StaticOrder {
    int nM, nN, nwg, G, c;
    __host__ __device__ void init(int M, int N, int G_, int c_) { nM = M / BM; nN = N / BM; nwg = nM * nN; G = G_; c = c_; }
    __host__ __device__ bool next(int i, Unit& u) const {
        const long L = (long)i * G + c; if (L >= nwg) return false;
        int wgid = (int)L; { const int q = nwg / NXCD, r = nwg % NXCD, xcd = wgid % NXCD, off = wgid / NXCD; wgid = (xcd < r ? xcd * (q + 1) : r * (q + 1) + (xcd - r) * q) + off; }
        const int nig = WGM * nN, gid = wgid / nig, fm = gid * WGM, gsz = (nM - fm) < WGM ? (nM - fm) : WGM;
        u.pm = fm + ((wgid % nig) % gsz); u.pn = (wgid % nig) / gsz; return true;
    }
    __device__ __forceinline__ void a_ready(const Unit&) const {}
    __device__ __forceinline__ void done(const Unit&) const {}
};

__device__ __forceinline__ unsigned cvt_pk_bf16(float lo, float hi) { unsigned r; asm volatile("v_cvt_pk_bf16_f32 %0, %1, %2" : "=v"(r) : "v"(lo), "v"(hi)); return r; }
__device__ __forceinline__ float bf_lo(unsigned w) { return __uint_as_float(w << 16); }
__device__ __forceinline__ float bf_hi(unsigned w) { return __uint_as_float(w & 0xffff0000u); }
__device__ __forceinline__ float sigmoid_f(float x) { return __builtin_amdgcn_rcpf(1.0f + __builtin_amdgcn_exp2f(-1.4426950408889634f * x)); }
__device__ __forceinline__ float gelu_tanh_f(float x) { const float t = x * (-2.3022081986f + -0.1029432446f * x * x); return x * __builtin_amdgcn_rcpf(1.0f + __builtin_amdgcn_exp2f(t)); }
__device__ __forceinline__ float silu_f(float x) { return x * sigmoid_f(x); }
typedef float f32x2p __attribute__((ext_vector_type(2)));
__device__ __forceinline__ f32x2p exp2_2(f32x2p v) { return (f32x2p){__builtin_amdgcn_exp2f(v.x), __builtin_amdgcn_exp2f(v.y)}; }
__device__ __forceinline__ f32x2p rcp_2(f32x2p v) { return (f32x2p){__builtin_amdgcn_rcpf(v.x), __builtin_amdgcn_rcpf(v.y)}; }
__device__ __forceinline__ f32x2p gelu2(f32x2p x) { const f32x2p t = x * (x * x * -0.1029432446f + -2.3022081986f); return x * rcp_2(exp2_2(t) + 1.0f); }
__device__ __forceinline__ f32x2p sigmoid2(f32x2p x) { return rcp_2(exp2_2(x * -1.4426950408889634f) + 1.0f); }

struct EpiZ {
    static constexpr bool PERM = true, AFTER_DRAIN = false, HAS_MID = false; static constexpr int TMID = -1;
    bf16_t* Z; int ldc; float* stat; bf16_t* gr; bf16_t* gb;
    __device__ __forceinline__ void mid(f32x4 (&)[2][2][4][2], const Unit&, int, int, int, int) const {}
    template <bool HM = false>
    __device__ __forceinline__ void operator()(const f32x4 (&acc)[2][2][4][2], const Unit& u, int wr, int wc, int fr, int fq) const {
        constexpr int NAI = HM ? 1 : 2;
        int row0 = u.pm * (HM ? HALF : BM) + wr * 64 + fr; const int col0 = u.pn * BM + wc * 32 + 8 * fq; asm volatile("" : "+v"(row0));
        const int mode = u.pn < 4 ? 0 : (u.pn < 16 ? 1 : 2);
        if (mode == 2) {
            const int pmf = HM ? (u.pm >> 1) : u.pm, ai0 = HM ? (u.pm & 1) : 0; int tix = (int)threadIdx.x; asm volatile("" : "+v"(tix)); const size_t blk = ((size_t)pmf * 8 + (u.pn - 16)) * 32768 + (size_t)tix * 8;
#pragma unroll
            for (int ai = 0; ai < NAI; ++ai)
#pragma unroll
                for (int m = 0; m < 4; ++m) { const size_t go = blk + (size_t)((ai + ai0) * 4 + m) * 4096;
                    const f32x4 a0v = acc[ai][0][m][0], a1v = acc[ai][0][m][1], b0v = acc[ai][1][m][0], b1v = acc[ai][1][m][1];
                    const f32x2p big = (f32x2p){1e30f, 1e30f}, tiny = (f32x2p){1e-30f, 1e-30f}; constexpr float NL2E = -1.4426950408889634f;
                    const f32x2p da0 = exp2_2((f32x2p){a0v[0], a0v[1]} * NL2E) + 1.0f, da1 = exp2_2((f32x2p){a0v[2], a0v[3]} * NL2E) + 1.0f, da2 = exp2_2((f32x2p){a1v[0], a1v[1]} * NL2E) + 1.0f, da3 = exp2_2((f32x2p){a1v[2], a1v[3]} * NL2E) + 1.0f;
                    const f32x2p db0 = exp2_2((f32x2p){b0v[0], b0v[1]} * NL2E) + 1.0f, db1 = exp2_2((f32x2p){b0v[2], b0v[3]} * NL2E) + 1.0f, db2 = exp2_2((f32x2p){b1v[0], b1v[1]} * NL2E) + 1.0f, db3 = exp2_2((f32x2p){b1v[2], b1v[3]} * NL2E) + 1.0f;
                    const f32x2p sb0 = __builtin_elementwise_max(rcp_2(db0), tiny), sb1 = __builtin_elementwise_max(rcp_2(db1), tiny), sb2 = __builtin_elementwise_max(rcp_2(db2), tiny), sb3 = __builtin_elementwise_max(rcp_2(db3), tiny);
                    const f32x2p r0 = rcp_2(da0) * __builtin_elementwise_min(db0, big), r1 = rcp_2(da1) * __builtin_elementwise_min(db1, big), r2 = rcp_2(da2) * __builtin_elementwise_min(db2, big), r3 = rcp_2(da3) * __builtin_elementwise_min(db3, big);
                    u32x4 w; w.x = cvt_pk_bf16(r0.x, r0.y); w.y = cvt_pk_bf16(r1.x, r1.y); w.z = cvt_pk_bf16(r2.x, r2.y); w.w = cvt_pk_bf16(r3.x, r3.y);
                    __builtin_nontemporal_store(w, (u32x4*)(gr + go));
                    w.x = cvt_pk_bf16(sb0.x, sb0.y); w.y = cvt_pk_bf16(sb1.x, sb1.y); w.z = cvt_pk_bf16(sb2.x, sb2.y); w.w = cvt_pk_bf16(sb3.x, sb3.y);
                    __builtin_nontemporal_store(w, (u32x4*)(gb + go)); }
            return; }
        const bool vstat = (u.pn >= 12 && u.pn < 16);
#pragma unroll
        for (int ai = 0; ai < NAI; ++ai)
#pragma unroll
            for (int m = 0; m < 4; ++m) { bf16_t* rowp = Z + (size_t)(row0 + ai * HALF + m * 16) * ldc + col0; float ssum = 0.f, ssq = 0.f;
#pragma unroll
                for (int bj = 0; bj < 2; ++bj) { const f32x4 v0 = acc[ai][bj][m][0], v1 = acc[ai][bj][m][1];
                    f32x2p a0 = (f32x2p){v0[0], v0[1]}, a1 = (f32x2p){v0[2], v0[3]}, a2 = (f32x2p){v1[0], v1[1]}, a3 = (f32x2p){v1[2], v1[3]};
                    if (mode == 1) { a0 = gelu2(a0); a1 = gelu2(a1); a2 = gelu2(a2); a3 = gelu2(a3); }
                    if (vstat) { const f32x2p t = (a0 + a1) + (a2 + a3), q = (a0 * a0 + a1 * a1) + (a2 * a2 + a3 * a3); ssum += t.x + t.y; ssq += q.x + q.y; }
                    u32x4 w; w.x = cvt_pk_bf16(a0.x, a0.y); w.y = cvt_pk_bf16(a1.x, a1.y); w.z = cvt_pk_bf16(a2.x, a2.y); w.w = cvt_pk_bf16(a3.x, a3.y);
                    __builtin_nontemporal_store(w, (u32x4*)(rowp + bj * HALF)); }
                if (vstat) { ssum += __shfl_xor(ssum, 16); ssq += __shfl_xor(ssq, 16); ssum += __shfl_xor(ssum, 32); ssq += __shfl_xor(ssq, 32);
                    if (fq == 0) { typedef float f32x2 __attribute__((ext_vector_type(2))); *(f32x2*)(stat + ((size_t)(row0 + ai * HALF + m * 16) * 16 + (u.pn - 12) * 4 + wc) * 2) = (f32x2){ssum, ssq}; } } }
    }
};
struct EpiBf16 {
    static constexpr bool PERM = true, AFTER_DRAIN = false, HAS_MID = false; static constexpr int TMID = -1;
    bf16_t* O; int ldc;
    __device__ __forceinline__ void mid(f32x4 (&)[2][2][4][2], const Unit&, int, int, int, int) const {}
    __device__ __forceinline__ void operator()(const f32x4 (&acc)[2][2][4][2], const Unit& u, int wr, int wc, int fr, int fq) const {
        int row0 = u.pm * BM + wr * 64 + fr; const int col0 = u.pn * BM + wc * 32 + 8 * fq; asm volatile("" : "+v"(row0));
#pragma unroll
        for (int ai = 0; ai < 2; ++ai)
#pragma unroll
            for (int m = 0; m < 4; ++m) { bf16_t* rowp = O + (size_t)(row0 + ai * HALF + m * 16) * ldc + col0;
#pragma unroll
                for (int bj = 0; bj < 2; ++bj) { const f32x4 v0 = acc[ai][bj][m][0], v1 = acc[ai][bj][m][1];
                    u32x4 w; w.x = cvt_pk_bf16(v0[0], v0[1]); w.y = cvt_pk_bf16(v0[2], v0[3]); w.z = cvt_pk_bf16(v1[0], v1[1]); w.w = cvt_pk_bf16(v1[2], v1[3]);
                    *(u32x4*)(rowp + bj * HALF) = w; } }
    }
};
struct EpiGate {
    static constexpr bool PERM = true, AFTER_DRAIN = false, HAS_MID = true; static constexpr int TMID = 16;
    const bf16_t* gr; const bf16_t* gb;
    bf16_t* O; int ldc;
    __device__ __forceinline__ void mid(f32x4 (&acc)[2][2][4][2], const Unit& u, int wr, int wc, int fr, int fq) const {
        int tix = (int)threadIdx.x; asm volatile("" : "+v"(tix));
#pragma unroll
        for (int ai = 0; ai < 2; ++ai)
#pragma unroll
            for (int m = 0; m < 4; ++m) { const bf16_t* gp = gr + ((size_t)u.pm * 8 + 2 * u.pn) * 32768 + (size_t)((ai * 4 + m) * 512 + tix) * 8;
#pragma unroll
                for (int bj = 0; bj < 2; ++bj) { const u32x4 rt = __builtin_nontemporal_load((const u32x4*)(gp + bj * 32768));
                    acc[ai][bj][m][0] *= (f32x4){bf_lo(rt.x), bf_hi(rt.x), bf_lo(rt.y), bf_hi(rt.y)}; acc[ai][bj][m][1] *= (f32x4){bf_lo(rt.z), bf_hi(rt.z), bf_lo(rt.w), bf_hi(rt.w)}; } }
    }
    __device__ __forceinline__ void operator()(const f32x4 (&acc)[2][2][4][2], const Unit& u, int wr, int wc, int fr, int fq) const {
        int row0 = u.pm * BM + wr * 64 + fr; const int col0 = u.pn * BM + wc * 32 + 8 * fq; asm volatile("" : "+v"(row0)); int tix = (int)threadIdx.x; asm volatile("" : "+v"(tix));
        u32x4 gbv[2][4][2];
#pragma unroll
        for (int ai = 0; ai < 2; ++ai)
#pragma unroll
            for (int m = 0; m < 4; ++m)
#pragma unroll
                for (int bj = 0; bj < 2; ++bj) gbv[ai][m][bj] = __builtin_nontemporal_load((const u32x4*)(this->gb + ((size_t)u.pm * 8 + 2 * u.pn + bj) * 32768 + (size_t)((ai * 4 + m) * 512 + tix) * 8));
#pragma unroll
        for (int ai = 0; ai < 2; ++ai)
#pragma unroll
            for (int m = 0; m < 4; ++m) { const size_t r = (size_t)(row0 + ai * HALF + m * 16);
#pragma unroll
                for (int bj = 0; bj < 2; ++bj) { const u32x4 gb = gbv[ai][m][bj];
                    f32x4 v0 = acc[ai][bj][m][0], v1 = acc[ai][bj][m][1];
                    v0 *= (f32x4){bf_lo(gb.x), bf_hi(gb.x), bf_lo(gb.y), bf_hi(gb.y)}; v1 *= (f32x4){bf_lo(gb.z), bf_hi(gb.z), bf_lo(gb.w), bf_hi(gb.w)};
                    u32x4 w; w.x = cvt_pk_bf16(v0[0], v0[1]); w.y = cvt_pk_bf16(v0[2], v0[3]); w.z = cvt_pk_bf16(v1[0], v1[1]); w.w = cvt_pk_bf16(v1[2], v1[3]);
                    *(u32x4*)(O + r * ldc + col0 + bj * HALF) = w; } }
    }
};
struct EpiSwiGLU {
    static constexpr bool PERM = true, AFTER_DRAIN = false, HAS_MID = false; static constexpr int TMID = -1;
    bf16_t* O; int ldc;
    __device__ __forceinline__ void mid(f32x4 (&)[2][2][4][2], const Unit&, int, int, int, int) const {}
    template <bool HM = false>
    __device__ __forceinline__ void operator()(const f32x4 (&acc)[2][2][4][2], const Unit& u, int wr, int wc, int fr, int fq) const {
        constexpr int NAI = HM ? 1 : 2;
        int row0 = u.pm * (HM ? HALF : BM) + wr * 64 + fr; const int col0 = u.pn * HALF + wc * 32 + 8 * fq; asm volatile("" : "+v"(row0));
#pragma unroll
        for (int ai = 0; ai < NAI; ++ai)
#pragma unroll
            for (int m = 0; m < 4; ++m) { bf16_t* rowp = O + (size_t)(row0 + ai * HALF + m * 16) * ldc + col0;
                const f32x4 g0 = acc[ai][0][m][0], g1 = acc[ai][0][m][1], u0 = acc[ai][1][m][0], u1 = acc[ai][1][m][1];
                const f32x2p ga = (f32x2p){g0[0], g0[1]}, gb = (f32x2p){g0[2], g0[3]}, gc = (f32x2p){g1[0], g1[1]}, gd = (f32x2p){g1[2], g1[3]};
                const f32x2p oa = ga * sigmoid2(ga) * (f32x2p){u0[0], u0[1]}, ob = gb * sigmoid2(gb) * (f32x2p){u0[2], u0[3]}, oc = gc * sigmoid2(gc) * (f32x2p){u1[0], u1[1]}, od = gd * sigmoid2(gd) * (f32x2p){u1[2], u1[3]};
                u32x4 w; w.x = cvt_pk_bf16(oa.x, oa.y); w.y = cvt_pk_bf16(ob.x, ob.y); w.z = cvt_pk_bf16(oc.x, oc.y); w.w = cvt_pk_bf16(od.x, od.y);
                *(u32x4*)rowp = w; }
    }
};

struct EpiFinal {
    static constexpr bool PERM = true, AFTER_DRAIN = false, HAS_MID = false; static constexpr int TMID = -1;
    const bf16_t* x1b; int ldx; const float* inv2; const float* g3; float* out;
    float* xch; unsigned* cnt; PG8_LAS unsigned char* scr;
    __device__ __forceinline__ void mid(f32x4 (&)[2][2][4][2], const Unit&, int, int, int, int) const {}
    __device__ __forceinline__ void operator()(const f32x4 (&acc)[2][2][4][2], const Unit& u, int wr, int wc, int fr, int fq) const {
        const int tid = threadIdx.x, lane = tid & 63, wid = __builtin_amdgcn_readfirstlane(tid >> 6);
        PG8_LAS float* P = (PG8_LAS float*)scr;
        PG8_LAS float* S = (PG8_LAS float*)(scr + 4096);
#pragma unroll
        for (int ai = 0; ai < 2; ++ai)
#pragma unroll
            for (int m = 0; m < 4; ++m) { float q = 0.f;
#pragma unroll
                for (int bj = 0; bj < 2; ++bj)
#pragma unroll
                    for (int n = 0; n < 2; ++n) { const f32x4 v = acc[ai][bj][m][n]; q += (v[0] * v[0] + v[1] * v[1]) + (v[2] * v[2] + v[3] * v[3]); }
                q += __shfl_xor(q, 16); q += __shfl_xor(q, 32);
                if (fq == 0) P[(ai * HALF + wr * 64 + m * 16 + fr) * 4 + wc] = q; }
        asm volatile("s_waitcnt lgkmcnt(0)" ::: "memory"); __builtin_amdgcn_s_barrier(); asm volatile("" ::: "memory");
        if (tid < 256) { const f32x4 p = *(const PG8_LAS f32x4*)(P + tid * 4);
            unsigned* slot = (unsigned*)xch + ((size_t)(u.pm * BM + tid) * 4);
            __hip_atomic_store(slot + u.pn, __float_as_uint((p[0] + p[1]) + (p[2] + p[3])) | 0x80000000u, __ATOMIC_RELAXED, __HIP_MEMORY_SCOPE_AGENT);
            unsigned t0, t1, t2, t3, sp = 0;
            for (;;) { t0 = __hip_atomic_load(slot + 0, __ATOMIC_RELAXED, __HIP_MEMORY_SCOPE_AGENT); t1 = __hip_atomic_load(slot + 1, __ATOMIC_RELAXED, __HIP_MEMORY_SCOPE_AGENT);
                t2 = __hip_atomic_load(slot + 2, __ATOMIC_RELAXED, __HIP_MEMORY_SCOPE_AGENT); t3 = __hip_atomic_load(slot + 3, __ATOMIC_RELAXED, __HIP_MEMORY_SCOPE_AGENT);
                if ((t0 != 0u && t1 != 0u && t2 != 0u && t3 != 0u) || ++sp > (1u << 22)) break;
                __builtin_amdgcn_s_sleep(1); }
            const float q0 = __uint_as_float(t0 & 0x7fffffffu), q1 = __uint_as_float(t1 & 0x7fffffffu), q2 = __uint_as_float(t2 & 0x7fffffffu), q3 = __uint_as_float(t3 & 0x7fffffffu);
            S[tid] = __builtin_amdgcn_rsqf(((q0 + q1) + (q2 + q3)) * (1.0f / 1024.0f) + 1e-6f); }
        asm volatile("s_waitcnt vmcnt(0) lgkmcnt(0)" ::: "memory"); __builtin_amdgcn_s_barrier(); asm volatile("" ::: "memory");
        int row0 = u.pm * BM + wr * 64 + fr; const int col0 = u.pn * BM + wc * 32 + 8 * fq; asm volatile("" : "+v"(row0));
        f32x4 gc[2][2];
#pragma unroll
        for (int bj = 0; bj < 2; ++bj)
#pragma unroll
            for (int n = 0; n < 2; ++n) gc[bj][n] = *(const f32x4*)(g3 + col0 + bj * HALF + 4 * n);
#pragma unroll
        for (int ai = 0; ai < 2; ++ai)
#pragma unroll
            for (int m = 0; m < 4; ++m) { const int rl = ai * HALF + wr * 64 + m * 16 + fr; const size_t r = (size_t)(row0 + ai * HALF + m * 16);
                const float r3 = S[rl], ri = inv2[r];
#pragma unroll
                for (int bj = 0; bj < 2; ++bj) { const u32x4 xw = __builtin_nontemporal_load((const u32x4*)(x1b + r * ldx + col0 + bj * HALF));
                    const f32x4 x0 = (f32x4){bf_lo(xw.x), bf_hi(xw.x), bf_lo(xw.y), bf_hi(xw.y)}, x1 = (f32x4){bf_lo(xw.z), bf_hi(xw.z), bf_lo(xw.w), bf_hi(xw.w)};
                    float* op = out + r * 1024 + col0 + bj * HALF;
                    __builtin_nontemporal_store(x0 * ri + acc[ai][bj][m][0] * r3 * gc[bj][0], (f32x4*)op);
                    __builtin_nontemporal_store(x1 * ri + acc[ai][bj][m][1] * r3 * gc[bj][1], (f32x4*)(op + 4)); }
                asm volatile("" ::: "memory"); }
    }
};

template <class Epi, class Sched, bool ALIGN_EPI = false, bool SP2 = false>
__device__ __forceinline__ void gemm_phase(PG8_LAS unsigned char* lds, const Gemm g, const Sched& S, const Epi& E) {
    const int tid = threadIdx.x, wid = __builtin_amdgcn_readfirstlane(tid >> 6), lane = tid & 63, wr = wid >> 2, wc = wid & 3, fr = lane & 15, fq = lane >> 4;
    const int K = g.K, nt = K / BK;
    unsigned voffA[2], voffB[2];
#pragma unroll
    for (int i = 0; i < 2; ++i) { int R, C; stage_rc(tid * 16 + i * 8192, R, C); const int Rb = Epi::PERM ? ((R & ~31) + perm32(R & 31)) : R;
        voffA[i] = (unsigned)(R * g.lda + C) * 2u; voffB[i] = (unsigned)(Rb * g.ldb + C) * 2u; }
    const size_t kstep = (size_t)(BK * 2);
    const size_t hstepA = (size_t)HALF * g.lda * 2, hstepB = (size_t)HALF * g.ldb * 2;
    const size_t tstepA = 2 * hstepA, tstepB = 2 * hstepB;
    const unsigned ldsw = (unsigned)wid * 1024u;
    const int aoff = lds_byte(wr * 64 + fr, fq * 8), boff = lds_byte(wc * 32 + fr, fq * 8);
#define PG8_SA(b, h) (((b) * 2 + (h)) * HTB)
#define PG8_SB(b, h) ((4 + (b) * 2 + (h)) * HTB)
#define PG8_STAGE(bufoff, gbase, voff) do { _Pragma("unroll") for (int _i = 0; _i < 2; ++_i) \
        __builtin_amdgcn_global_load_lds((const unsigned*)((const char*)(gbase) + (voff)[_i]), (PG8_LAS unsigned*)(lds + (bufoff) + ldsw + _i * 8192), 16, 0, 0); } while (0)
#define PG8_LDA(dst, b, h) do { _Pragma("unroll") for (int m = 0; m < 4; ++m) _Pragma("unroll") for (int k = 0; k < 2; ++k) dst[m][k] = *(const PG8_LAS bf16x8*)(lds + PG8_SA(b, h) + aoff + m * 2048 + k * 1024); } while (0)
#define PG8_LDB(dst, b, h) do { _Pragma("unroll") for (int n = 0; n < 2; ++n) _Pragma("unroll") for (int k = 0; k < 2; ++k) dst[n][k] = *(const PG8_LAS bf16x8*)(lds + PG8_SB(b, h) + boff + n * 2048 + k * 1024); } while (0)
#define PG8_MMA(ai, bj, At, Bt) do { __builtin_amdgcn_s_setprio(1); _Pragma("unroll") for (int m = 0; m < 4; ++m) _Pragma("unroll") for (int n = 0; n < 2; ++n) _Pragma("unroll") for (int k = 0; k < 2; ++k) \
        acc[ai][bj][m][n] = __builtin_amdgcn_mfma_f32_16x16x32_bf16(Bt[n][k], At[m][k], acc[ai][bj][m][n], 0, 0, 0); __builtin_amdgcn_s_setprio(0); } while (0)
#define PG8_WAIT_V(n) asm volatile("s_waitcnt vmcnt(" #n ")" ::: "memory")
#define PG8_WAIT_L(n) asm volatile("s_waitcnt lgkmcnt(" #n ")" ::: "memory")
#define PG8_BAR __builtin_amdgcn_s_barrier()
#define PG8_SCHED __builtin_amdgcn_sched_barrier(0)
    Unit cur, nxt; int ui = 0;
    if (!S.next(0, cur)) return;
    f32x4 acc[2][2][4][2];
#pragma unroll
    for (int a = 0; a < 2; ++a)
#pragma unroll
        for (int b = 0; b < 2; ++b)
#pragma unroll
            for (int m = 0; m < 4; ++m)
#pragma unroll
                for (int n = 0; n < 2; ++n) acc[a][b][m][n] = (f32x4){0.f, 0.f, 0.f, 0.f};
    bf16x8 At[4][2], B0[2][2], B1[2][2];
    const char* cA = (const char*)g.A + (size_t)cur.pm * tstepA; const char* cB = (const char*)g.Bt + (size_t)cur.pn * tstepB;
    S.a_ready(cur);
    if constexpr (SP2) {
        PG8_STAGE(PG8_SB(0, 0), cB, voffB); PG8_STAGE(PG8_SB(0, 1), cB + hstepB, voffB); PG8_STAGE(PG8_SA(0, 0), cA, voffA); PG8_STAGE(PG8_SA(0, 1), cA + hstepA, voffA);
        if (wr == 1) PG8_BAR;
        PG8_WAIT_V(2); PG8_BAR;
        PG8_STAGE(PG8_SB(1, 0), cB + kstep, voffB); PG8_STAGE(PG8_SA(1, 0), cA + kstep, voffA); PG8_STAGE(PG8_SB(1, 1), cB + hstepB + kstep, voffB);
        PG8_WAIT_V(6); PG8_BAR;
    } else {
        PG8_STAGE(PG8_SB(0, 0), cB, voffB); PG8_STAGE(PG8_SA(0, 0), cA, voffA); PG8_STAGE(PG8_SB(0, 1), cB + hstepB, voffB); PG8_STAGE(PG8_SA(0, 1), cA + hstepA, voffA);
        if (wr == 1) PG8_BAR;
        PG8_WAIT_V(4); PG8_BAR;
        PG8_STAGE(PG8_SB(1, 0), cB + kstep, voffB); PG8_STAGE(PG8_SA(1, 0), cA + kstep, voffA); PG8_STAGE(PG8_SB(1, 1), cB + hstepB + kstep, voffB);
        PG8_WAIT_V(6); PG8_BAR;
    }
    for (;;) {
        const bool has_next = S.next(ui + 1, nxt);
        const char* nA = has_next ? (const char*)g.A + (size_t)nxt.pm * tstepA : cA; const char* nB = has_next ? (const char*)g.Bt + (size_t)nxt.pn * tstepB : cB;
        for (int t = 0; t < nt; t += 2) {
            const bool last = (t == nt - 2);
            const char* a1 = cA + (size_t)(t + 1) * kstep;
            const char* a2 = last ? nA : cA + (size_t)(t + 2) * kstep; const char* b2 = last ? nB : cB + (size_t)(t + 2) * kstep;
            const char* a3 = a2 + kstep; const char* b3 = b2 + kstep;
            if (last && has_next) S.a_ready(nxt);
            if constexpr (Epi::HAS_MID) { if (t == Epi::TMID) E.mid(acc, cur, wr, wc, fr, fq); }
            if constexpr (SP2) {
            PG8_LDB(B0, 0, 0); PG8_LDB(B1, 0, 1); PG8_SCHED; PG8_LDA(At, 0, 0); PG8_STAGE(PG8_SA(1, 1), a1 + hstepA, voffA);
            PG8_WAIT_V(8); PG8_WAIT_L(0); PG8_BAR; PG8_MMA(0, 0, At, B0); PG8_MMA(0, 1, At, B1); PG8_BAR; PG8_SCHED;
            PG8_LDA(At, 0, 1); PG8_STAGE(PG8_SB(0, 0), b2, voffB); PG8_STAGE(PG8_SB(0, 1), b2 + hstepB, voffB); PG8_STAGE(PG8_SA(0, 0), a2, voffA);
            PG8_WAIT_V(8); PG8_WAIT_L(0); PG8_BAR; PG8_MMA(1, 0, At, B0); PG8_MMA(1, 1, At, B1); PG8_BAR; PG8_SCHED;
            PG8_LDB(B0, 1, 0); PG8_LDB(B1, 1, 1); PG8_SCHED; PG8_LDA(At, 1, 0); PG8_STAGE(PG8_SA(0, 1), a2 + hstepA, voffA);
            PG8_WAIT_V(8); PG8_WAIT_L(0); PG8_BAR; PG8_MMA(0, 0, At, B0); PG8_MMA(0, 1, At, B1); PG8_BAR; PG8_SCHED;
            PG8_LDA(At, 1, 1); PG8_STAGE(PG8_SB(1, 0), b3, voffB); PG8_STAGE(PG8_SB(1, 1), b3 + hstepB, voffB); PG8_STAGE(PG8_SA(1, 0), a3, voffA);
            PG8_WAIT_V(8); PG8_WAIT_L(0); PG8_BAR; PG8_MMA(1, 0, At, B0); PG8_MMA(1, 1, At, B1); PG8_BAR; PG8_SCHED;
            } else {
            PG8_LDB(B0, 0, 0); PG8_SCHED; PG8_LDA(At, 0, 0); PG8_STAGE(PG8_SA(1, 1), a1 + hstepA, voffA);
            PG8_WAIT_L(8); PG8_BAR; PG8_WAIT_L(0); PG8_MMA(0, 0, At, B0); PG8_BAR; PG8_SCHED;
            PG8_LDB(B1, 0, 1); PG8_STAGE(PG8_SB(0, 0), b2, voffB);
            PG8_BAR; PG8_WAIT_L(0); PG8_MMA(0, 1, At, B1); PG8_BAR;
            PG8_LDA(At, 0, 1); PG8_STAGE(PG8_SA(0, 0), a2, voffA);
            PG8_BAR; PG8_WAIT_L(0); PG8_MMA(1, 0, At, B0); PG8_BAR; PG8_SCHED;
            PG8_STAGE(PG8_SB(0, 1), b2 + hstepB, voffB);
            PG8_WAIT_V(6); PG8_BAR; PG8_MMA(1, 1, At, B1); PG8_BAR;
            PG8_LDB(B0, 1, 0); PG8_SCHED; PG8_LDA(At, 1, 0); PG8_STAGE(PG8_SA(0, 1), a2 + hstepA, voffA);
            PG8_WAIT_L(8); PG8_BAR; PG8_WAIT_L(0); PG8_MMA(0, 0, At, B0); PG8_BAR; PG8_SCHED;
            PG8_LDB(B1, 1, 1); PG8_STAGE(PG8_SB(1, 0), b3, voffB);
            PG8_BAR; PG8_WAIT_L(0); PG8_MMA(0, 1, At, B1); PG8_BAR;
            PG8_LDA(At, 1, 1); PG8_STAGE(PG8_SA(1, 0), a3, voffA);
            PG8_BAR; PG8_WAIT_L(0); PG8_MMA(1, 0, At, B0); PG8_BAR; PG8_SCHED;
            PG8_STAGE(PG8_SB(1, 1), b3 + hstepB, voffB);
            PG8_WAIT_V(6); PG8_BAR; PG8_MMA(1, 1, At, B1); PG8_BAR;
            }
        }
        if constexpr (ALIGN_EPI) { if (wr == 0) PG8_BAR; }
        E(acc, cur, wr, wc, fr, fq); S.done(cur);
        if (!has_next) break;
#pragma unroll
        for (int a = 0; a < 2; ++a)
#pragma unroll
            for (int b = 0; b < 2; ++b)
#pragma unroll
                for (int m = 0; m < 4; ++m)
#pragma unroll
                    for (int n = 0; n < 2; ++n) acc[a][b][m][n] = (f32x4){0.f, 0.f, 0.f, 0.f};
        cur = nxt; cA = nA; cB = nB; ++ui;
        if constexpr (ALIGN_EPI) { if (wr == 1) PG8_BAR; }
    }
    PG8_WAIT_V(0);
    if constexpr (!ALIGN_EPI) { if (wr == 0) PG8_BAR; }
    PG8_BAR;
#undef PG8_SA
#undef PG8_SB
#undef PG8_STAGE
#undef PG8_LDA
#undef PG8_LDB
#undef PG8_MMA
#undef PG8_WAIT_V
#undef PG8_WAIT_L
#undef PG8_BAR
#undef PG8_SCHED
}

template <class Epi>
__device__ __forceinline__ void gemm_half_unit(PG8_LAS unsigned char* lds, const Gemm g, const Unit hu, const Epi& E) {
    const int tid = threadIdx.x, wid = __builtin_amdgcn_readfirstlane(tid >> 6), lane = tid & 63, wr = wid >> 2, wc = wid & 3, fr = lane & 15, fq = lane >> 4;
    const int nt = g.K / BK;
    unsigned voffA[2], voffB[2];
#pragma unroll
    for (int i = 0; i < 2; ++i) { int R, C; stage_rc(tid * 16 + i * 8192, R, C); const int Rb = Epi::PERM ? ((R & ~31) + perm32(R & 31)) : R;
        voffA[i] = (unsigned)(R * g.lda + C) * 2u; voffB[i] = (unsigned)(Rb * g.ldb + C) * 2u; }
    const size_t kstep = (size_t)(BK * 2), hstepA = (size_t)HALF * g.lda * 2, hstepB = (size_t)HALF * g.ldb * 2;
    const unsigned ldsw = (unsigned)wid * 1024u;
    const int aoff = lds_byte(wr * 64 + fr, fq * 8), boff = lds_byte(wc * 32 + fr, fq * 8);
#define PG8_SA(b, h) (((b) * 2 + (h)) * HTB)
#define PG8_SB(b, h) ((4 + (b) * 2 + (h)) * HTB)
#define PG8_STAGE(bufoff, gbase, voff) do { _Pragma("unroll") for (int _i = 0; _i < 2; ++_i) \
        __builtin_amdgcn_global_load_lds((const unsigned*)((const char*)(gbase) + (voff)[_i]), (PG8_LAS unsigned*)(lds + (bufoff) + ldsw + _i * 8192), 16, 0, 0); } while (0)
#define PG8_LDA(dst, b, h) do { _Pragma("unroll") for (int m = 0; m < 4; ++m) _Pragma("unroll") for (int k = 0; k < 2; ++k) dst[m][k] = *(const PG8_LAS bf16x8*)(lds + PG8_SA(b, h) + aoff + m * 2048 + k * 1024); } while (0)
#define PG8_LDB(dst, b, h) do { _Pragma("unroll") for (int n = 0; n < 2; ++n) _Pragma("unroll") for (int k = 0; k < 2; ++k) dst[n][k] = *(const PG8_LAS bf16x8*)(lds + PG8_SB(b, h) + boff + n * 2048 + k * 1024); } while (0)
#define PG8_MMA(ai, bj, At, Bt) do { _Pragma("unroll") for (int m = 0; m < 4; ++m) _Pragma("unroll") for (int n = 0; n < 2; ++n) _Pragma("unroll") for (int k = 0; k < 2; ++k) \
        acc[ai][bj][m][n] = __builtin_amdgcn_mfma_f32_16x16x32_bf16(Bt[n][k], At[m][k], acc[ai][bj][m][n], 0, 0, 0); } while (0)
#define PG8_STAGE3(b, tile) do { PG8_STAGE(PG8_SB(b, 0), cB + (size_t)(tile) * kstep, voffB); PG8_STAGE(PG8_SB(b, 1), cB + hstepB + (size_t)(tile) * kstep, voffB); PG8_STAGE(PG8_SA(b, 0), cA + (size_t)(tile) * kstep, voffA); } while (0)
    f32x4 acc[2][2][4][2];
#pragma unroll
    for (int b = 0; b < 2; ++b)
#pragma unroll
        for (int m = 0; m < 4; ++m)
#pragma unroll
            for (int n = 0; n < 2; ++n) acc[0][b][m][n] = (f32x4){0.f, 0.f, 0.f, 0.f};
    bf16x8 At[4][2], B0[2][2], B1[2][2];
    const char* cA = (const char*)g.A + (size_t)hu.pm * hstepA; const char* cB = (const char*)g.Bt + (size_t)hu.pn * 2 * hstepB;
    PG8_STAGE3(0, 0); PG8_STAGE3(1, 1);
    for (int t = 0; t < nt; t += 2) {
        const bool more = (t + 2 < nt);
        asm volatile("s_waitcnt vmcnt(6)" ::: "memory"); __builtin_amdgcn_s_barrier();
        PG8_LDB(B0, 0, 0); PG8_LDB(B1, 0, 1); PG8_LDA(At, 0, 0);
        asm volatile("s_waitcnt lgkmcnt(0)" ::: "memory"); __builtin_amdgcn_s_barrier();
        if (more) PG8_STAGE3(0, t + 2);
        PG8_MMA(0, 0, At, B0); PG8_MMA(0, 1, At, B1);
        if (more) asm volatile("s_waitcnt vmcnt(6)" ::: "memory"); else asm volatile("s_waitcnt vmcnt(0)" ::: "memory");
        __builtin_amdgcn_s_barrier();
        PG8_LDB(B0, 1, 0); PG8_LDB(B1, 1, 1); PG8_LDA(At, 1, 0);
        asm volatile("s_waitcnt lgkmcnt(0)" ::: "memory"); __builtin_amdgcn_s_barrier();
        if (more) PG8_STAGE3(1, t + 3);
        PG8_MMA(0, 0, At, B0); PG8_MMA(0, 1, At, B1);
    }
    E.template operator()<true>(acc, hu, wr, wc, fr, fq);
    __builtin_amdgcn_s_barrier();
#undef PG8_SA
#undef PG8_SB
#undef PG8_STAGE
#undef PG8_STAGE3
#undef PG8_LDA
#undef PG8_LDB
#undef PG8_MMA
}
}

#ifndef PG8_SP2
#define PG8_SP2 true
#endif
#ifndef PG8_ALIGN
#define PG8_ALIGN true
#endif

constexpr int NWAVES = 8;
constexpr int N_LAUNCHES = MK_N_LAUNCHES;
constexpr int PER_PHASE = 9;
constexpr int DM = 1024, SEQ = 2048, NB = 16, DEC_T = 32;
constexpr int MP = NB * SEQ, MS = NB * DEC_T, M = MP + MS;
constexpr int DIN = 6144, DFF = 2816, DFF2 = 5632;
constexpr int LDX = 1088, LDZ = 4160, LDW2 = 2112;
constexpr float EPS = 1e-6f;
static_assert(M % 256 == 0, "M");
enum { I_XP = 0, I_XS, I_SH, I_SC, I_GPRE, I_WIN, I_CW, I_CB, I_WA, I_BA, I_WX, I_BX, I_LAM, I_WBRA, I_LNG, I_LNB, I_WS, I_BS, I_WBRB, I_WOUT, I_GPOST, I_GFFN, I_WFI, I_WFO, I_GPF, N_IN };
constexpr size_t O_Y = 0, O_HP = (size_t)M * DM, O_CP = O_HP + NB * DM, O_HS = O_CP + (size_t)NB * 3 * DM, O_CS = O_HS + NB * DM, O_VS = O_CS + (size_t)NB * 3 * DM, O_END = O_VS + (size_t)MS * DM;
static_assert(O_END == 34734080, "output size");

constexpr size_t MiB = 1u << 20;
constexpr size_t WS_CTL = 0, CTL_ZERO_BYTES = 1 * MiB;
constexpr size_t WS_W1 = 1 * MiB;
constexpr size_t WS_W2 = WS_W1 + (size_t)DIN * LDX * 2;
constexpr size_t WS_W3 = WS_W2 + (size_t)DM * LDW2 * 2;
constexpr size_t WS_W4 = WS_W3 + (size_t)DM * LDX * 2;
constexpr size_t WS_W5 = WS_W4 + (size_t)DFF2 * LDX * 2;
constexpr size_t WS_GT = WS_W5 + (size_t)DM * DFF * 2;
constexpr size_t WS_WSM = WS_GT + 16 * 128 * 64 * 2;
constexpr size_t WS_WSS = WS_WSM + 8 * 128 * 128 * 2;
constexpr size_t WS_WEND = WS_WSS + 8 * 128 * 128 * 2;
constexpr size_t WS_XN = 39 * MiB;
constexpr size_t WS_Z = 109 * MiB;
constexpr size_t WS_GR = WS_Z + 265 * MiB, WS_GB = WS_GR + 65 * MiB;
constexpr size_t WS_MIX = WS_Z;
constexpr size_t WS_FIN = WS_Z + 70 * MiB;
constexpr size_t WS_F = WS_FIN + 179 * MiB;
constexpr size_t WS_STAT = 504 * MiB;
constexpr size_t WS_END = WS_STAT + (size_t)M * 16 * 2 * 4;
static_assert(WS_WEND <= WS_XN && WS_XN + (size_t)M * LDX * 2 <= WS_Z && WS_MIX + (size_t)M * LDX * 2 <= WS_FIN && WS_FIN + (size_t)M * DFF * 2 <= WS_F && WS_F + (size_t)M * LDX * 2 <= WS_STAT && WS_Z + (size_t)M * LDZ * 2 <= WS_GR && WS_GB + (size_t)M * DM * 2 <= WS_STAT && WS_END <= 512 * MiB, "d_ws map");
constexpr int CW_TMO = 0, CW_TKT = 2048, CW_BAR = 4096, CW_SEAM = 16384;
constexpr size_t WS_XCH = WS_STAT, WS_RSTD2 = WS_STAT + 1 * MiB;

constexpr int RING_OFF = 0, RING_BYTES = 131072;
constexpr int LDSCTL_OFF = 139264, MISC_OFF = LDSCTL_OFF + 320;
constexpr int LDS_BYTES = 147456;

#define GAS __attribute__((address_space(1)))
#define LAS __attribute__((address_space(3)))
typedef unsigned short bf16;
typedef unsigned v4u __attribute__((ext_vector_type(4)));
typedef unsigned v2u __attribute__((ext_vector_type(2)));
typedef float f32x4 __attribute__((ext_vector_type(4)));
typedef float f32x16 __attribute__((ext_vector_type(16)));
typedef short bf16x8 __attribute__((ext_vector_type(8)));
typedef GAS unsigned gu32;
#define RLX_AGENT __ATOMIC_RELAXED, __HIP_MEMORY_SCOPE_AGENT
#define LDS_WAIT() asm volatile("s_waitcnt lgkmcnt(0)" ::: "memory")
#define VM_WAIT() asm volatile("s_waitcnt vmcnt(0)" ::: "memory")
__device__ __forceinline__ unsigned f2bf(float f) { unsigned u = __builtin_bit_cast(unsigned, f); return (u + 0x7fffu + ((u >> 16) & 1u)) >> 16; }
__device__ __forceinline__ unsigned pk2(float lo, float hi) { unsigned r; asm volatile("v_cvt_pk_bf16_f32 %0, %1, %2" : "=v"(r) : "v"(lo), "v"(hi)); return r; }
__device__ __forceinline__ float bflo(unsigned w) { return __uint_as_float(w << 16); }
__device__ __forceinline__ float bfhi(unsigned w) { return __uint_as_float(w & 0xffff0000u); }

#define XB_TMO      128
#define XB_XCNT(j)  (256  + 64 * (j))
#define XB_XSUB(j)  (1280 + 64 * (j))
#define XB_XGEN(j)  (2304 + 64 * (j))
#define XB_TOP      3328
#define XB_TOPGEN   3392
#define XCD_BAR_WORDS 3456
#define XB_SPIN_CAP (1u << 22)

__device__ __forceinline__ unsigned xb_ld(unsigned* p)              { return __hip_atomic_load(p, __ATOMIC_RELAXED, __HIP_MEMORY_SCOPE_AGENT); }
__device__ __forceinline__ unsigned xb_add(unsigned* p, unsigned v) { return __hip_atomic_fetch_add(p, v, __ATOMIC_RELAXED, __HIP_MEMORY_SCOPE_AGENT); }
__device__ __forceinline__ unsigned xb_xcc_id() { return (unsigned)__builtin_amdgcn_s_getreg((3 << 11) | 20) & 0xFu; }
#define XB_SPIN(cond, bar) do { unsigned _sp = 0; while (cond) { __builtin_amdgcn_s_sleep(1); \
    if ((++_sp & 255u) == 0u) { if (xb_ld(&(bar)[XB_TMO])) break; if (_sp > XB_SPIN_CAP) { atomicAdd(&(bar)[XB_TMO], 1u); break; } } } } while (0)

struct XcdBarrier { unsigned* bar; unsigned x; volatile LAS unsigned* st; };

__device__ __forceinline__ XcdBarrier xcd_barrier_post(unsigned* bar, volatile LAS unsigned* st) {
    XcdBarrier b; b.bar = bar; b.x = xb_xcc_id(); b.st = st;
    if (threadIdx.x == 0) (void)xb_add(&bar[XB_XCNT(b.x)], 1u);
    return b;
}
__device__ __forceinline__ void xcd_barrier_complete(unsigned* bar, unsigned x, unsigned& nloc, unsigned& nx) {
    const unsigned G = gridDim.x * gridDim.y * gridDim.z;
    unsigned sum, cnt, mine, sp = 0u;
    for (;;) {
        sum = 0u; cnt = 0u; mine = 0u;
#pragma unroll
        for (unsigned j = 0; j < 16; ++j) { const unsigned c = xb_ld(&bar[XB_XCNT(j)]); sum += c; cnt += (c > 0u) ? 1u : 0u; mine = (j == x) ? c : mine; }
        if (sum == G) break;
        __builtin_amdgcn_s_sleep(1);
        if ((++sp & 255u) == 0u) { if (xb_ld(&bar[XB_TMO])) break; if (sp > XB_SPIN_CAP) { atomicAdd(&bar[XB_TMO], 1u); break; } }
    }
    nloc = mine > 0u ? mine : 1u; nx = cnt > 0u ? cnt : 1u;
}
__device__ __forceinline__ void xcd_barrier(const XcdBarrier& b) {
    asm volatile("s_waitcnt vmcnt(0)" ::: "memory");
    __syncthreads();
    if (threadIdx.x == 0) {
        unsigned* bar = b.bar;
        __builtin_amdgcn_s_waitcnt(0);
        unsigned nloc = b.st[0], nx = b.st[1];
        if (nloc == 0u) { xcd_barrier_complete(bar, b.x, nloc, nx); b.st[0] = nloc; b.st[1] = nx; }
        const unsigned old = xb_add(&bar[XB_XSUB(b.x)], 1u);
        const unsigned gen = old / nloc;
        if (old + 1u == (gen + 1u) * nloc) {
            __builtin_amdgcn_fence(__ATOMIC_RELEASE, "agent");
            asm volatile("s_waitcnt vmcnt(0)" ::: "memory");
            const unsigned og = xb_add(&bar[XB_TOP], 1u);
            const unsigned tg = og / nx;
            if (og + 1u == (tg + 1u) * nx) xb_add(&bar[XB_TOPGEN], 1u);
            else XB_SPIN(xb_ld(&bar[XB_TOPGEN]) == tg, bar);
            __builtin_amdgcn_fence(__ATOMIC_ACQUIRE, "agent");
            xb_add(&bar[XB_XGEN(b.x)], 1u);
            asm volatile("s_waitcnt vmcnt(0)" ::: "memory");
        } else {
            XB_SPIN(xb_ld(&bar[XB_XGEN(b.x)]) == gen, bar);
            __builtin_amdgcn_fence(__ATOMIC_ACQUIRE, "agent");
            asm volatile("s_waitcnt vmcnt(0)" ::: "memory");
        }
    }
    __syncthreads();
}

struct Args { const float* in[N_IN]; float* out; unsigned char* ws; int ph_lo, ph_hi, li, pad; };
struct Frame {
    LAS unsigned char* lds;
    volatile LAS unsigned* MISC;
    gu32* ctl;
    int tid, lane, wave, vcu, G;
    int rank;
};
__device__ __forceinline__ float wave_sum(float v) {
#pragma unroll
    for (int o = 1; o < 64; o <<= 1) v += __shfl_xor(v, o);
    return v;
}
__device__ __forceinline__ const float* xrow_ptr(const Args& a, int m) { return m < MP ? a.in[I_XP] + (size_t)m * DM : a.in[I_XS] + (size_t)(m - MP) * DM; }

__device__ __forceinline__ void p0_transpose_item(const float* W, int N, bf16* WT, int ldk, int dcol0, int k0, int n0, int drow0, LAS float* scr, int lane, const float* kscale = nullptr) {
    { const float* wp = W + (size_t)(k0 + (lane >> 5)) * N + n0 + (lane & 31); LAS float* sp = scr + (lane >> 5) * 33 + (lane & 31); float v[32];
#pragma unroll
      for (int i = 0; i < 32; ++i) v[i] = __builtin_nontemporal_load(wp + (size_t)(2 * i) * N);
#pragma unroll
      for (int i = 0; i < 32; ++i) sp[2 * i * 33] = v[i]; }
    LDS_WAIT(); asm volatile("" ::: "memory");
    const int c = lane & 7;
    f32x4 k0v = (f32x4){1.f, 1.f, 1.f, 1.f}, k1v = k0v;
    if (kscale) { k0v = *(const GAS f32x4*)(kscale + k0 + 8 * c); k1v = *(const GAS f32x4*)(kscale + k0 + 8 * c + 4); }
#pragma unroll
    for (int j = 0; j < 4; ++j) { const int n = (lane >> 3) + 8 * j; const LAS float* s = scr + (8 * c) * 33 + n;
        const float s0 = s[0 * 33], s1 = s[1 * 33], s2 = s[2 * 33], s3 = s[3 * 33], s4 = s[4 * 33], s5 = s[5 * 33], s6 = s[6 * 33], s7 = s[7 * 33];
        v4u o; o.x = pk2(s0 * k0v.x, s1 * k0v.y); o.y = pk2(s2 * k0v.z, s3 * k0v.w); o.z = pk2(s4 * k1v.x, s5 * k1v.y); o.w = pk2(s6 * k1v.z, s7 * k1v.w);
        *(GAS v4u*)(WT + (size_t)(drow0 + n) * ldk + dcol0 + k0 + 8 * c) = o; }
    LDS_WAIT(); asm volatile("" ::: "memory");
}

__device__ __forceinline__ void p0_items(Frame& F, const Args& a, int stage, int gw, int NGW, int lim = 0x7fffffff) {
    unsigned char* ws = a.ws;
    LAS float* scr = (LAS float*)(F.lds + RING_OFF + F.wave * 16384);
    constexpr int I1 = (DM / 64) * (DIN / 32), I2 = (DM / 64) * (DM / 32), I4 = (DM / 64) * (DFF2 / 32), I5 = (DFF / 64) * (DM / 32), IG = 64;
    if (stage == 0) {
        for (int it = gw; it < I1 + IG; it += NGW) {
            int r = it;
            if (r < I1) { const int nb = DIN / 32, kb = r / nb, n0 = 32 * (r % nb); const int c = n0 - 4096, drow0 = (c < 0) ? n0 : 4096 + 256 * ((c & 1023) >> 7) + 128 * (c >> 10) + (c & 127);
                          p0_transpose_item(a.in[I_WIN], DIN, (bf16*)(ws + WS_W1), LDX, 0, 64 * kb, n0, drow0, scr, F.lane); continue; } r -= I1;
            { const int hd = r >> 2, which = (r >> 1) & 1, n0 = 32 * (r & 1);
              p0_transpose_item((which ? a.in[I_WX] : a.in[I_WA]) + (size_t)hd * 4096, 64, (bf16*)(ws + WS_GT) + (size_t)hd * 8192, 64, 0, 0, n0, which * 64 + n0, scr, F.lane); }
        }
    } else if (stage == 1) {
        for (int it = gw; it < (3 * I2 + I4 < lim ? 3 * I2 + I4 : lim); it += NGW) {
            int r = it;
            if (r < I2) { const int nb = DM / 32, kb = r / nb, n0 = 32 * (r % nb); p0_transpose_item(a.in[I_WBRA], DM, (bf16*)(ws + WS_W2), LDW2, 0, 64 * kb, n0, n0, scr, F.lane); continue; } r -= I2;
            if (r < I2) { const int nb = DM / 32, kb = r / nb, n0 = 32 * (r % nb); p0_transpose_item(a.in[I_WBRB], DM, (bf16*)(ws + WS_W2), LDW2, 1024, 64 * kb, n0, n0, scr, F.lane); continue; } r -= I2;
            if (r < I2) { const int nb = DM / 32, kb = r / nb, n0 = 32 * (r % nb); p0_transpose_item(a.in[I_WOUT], DM, (bf16*)(ws + WS_W3), LDX, 0, 64 * kb, n0, n0, scr, F.lane); continue; } r -= I2;
            { const int nb = DFF2 / 32, kb = r / nb, n0 = 32 * (r % nb); const int s = n0 / DFF, j0 = n0 % DFF, drow0 = 256 * (j0 / 128) + 128 * s + (j0 % 128);
              p0_transpose_item(a.in[I_WFI], DFF2, (bf16*)(ws + WS_W4), LDX, 0, 64 * kb, n0, drow0, scr, F.lane, a.in[I_GFFN]); }
        }
    } else {
        for (int it = gw; it < (I5 < lim ? I5 : lim); it += NGW) { const int nb = DM / 32, kb = it / nb, n0 = 32 * (it % nb); p0_transpose_item(a.in[I_WFO], DM, (bf16*)(ws + WS_W5), DFF, 0, 64 * kb, n0, n0, scr, F.lane); }
    }
}
template <int R>
__device__ __forceinline__ void xn_rows(const Args& a, bf16* XN, int m0, int lane, const f32x4 (&gg)[4]) {
    f32x4 v[R][4];
#pragma unroll
    for (int r = 0; r < R; ++r) { const GAS f32x4* xr = (const GAS f32x4*)xrow_ptr(a, m0 + r) + lane;
#pragma unroll
        for (int j = 0; j < 4; ++j) v[r][j] = __builtin_nontemporal_load(xr + 64 * j); }
#pragma unroll
    for (int r = 0; r < R; ++r) { float s = 0.f;
#pragma unroll
        for (int j = 0; j < 4; ++j) s += (v[r][j].x * v[r][j].x + v[r][j].y * v[r][j].y) + (v[r][j].z * v[r][j].z + v[r][j].w * v[r][j].w);
        const float rstd = __builtin_amdgcn_rsqf(wave_sum(s) * (1.f / DM) + EPS);
        GAS v2u* o8 = (GAS v2u*)(XN + (size_t)(m0 + r) * LDX) + lane;
#pragma unroll
        for (int j = 0; j < 4; ++j) { v2u o; o.x = pk2(v[r][j].x * rstd * gg[j].x, v[r][j].y * rstd * gg[j].y); o.y = pk2(v[r][j].z * rstd * gg[j].z, v[r][j].w * rstd * gg[j].w);
            __hip_atomic_store((unsigned long long*)(o8 + 64 * j), (unsigned long long)o.x | ((unsigned long long)o.y << 32), __ATOMIC_RELAXED, __HIP_MEMORY_SCOPE_AGENT); } }
}
__device__ __forceinline__ void p0_prologue(Frame& F, const Args& a) {
    unsigned char* ws = a.ws;
    const int gw = F.vcu * NWAVES + F.wave, NGW = F.G * NWAVES;
    p0_items(F, a, 0, gw, NGW);
    { const float* wsp = a.in[I_WS]; bf16* wsm = (bf16*)(ws + WS_WSM); bf16* wss = (bf16*)(ws + WS_WSS);
      for (int i = gw * 64 + F.lane; i < 8 * 128 * 128; i += NGW * 64) { const int g = i >> 14, p = (i >> 7) & 127, q = i & 127;
          wsm[i] = (bf16)(((q >> 6) <= (p >> 6)) ? f2bf(wsp[i]) : 0u);
          wss[i] = (bf16)(((q >> 5) == (p >> 5)) ? f2bf(wsp[(g << 14) + ((p & 31) << 7) + (q & 31)]) : 0u); } }
    { const GAS f32x4* gp = (const GAS f32x4*)a.in[I_GPRE] + F.lane; f32x4 gg[4];
#pragma unroll
      for (int j = 0; j < 4; ++j) gg[j] = gp[64 * j];
      bf16* XN = (bf16*)(ws + WS_XN);
      for (int m0 = gw * 4; m0 < MP; m0 += NGW * 4) xn_rows<4>(a, XN, m0, F.lane, gg);
      { const int ms = MP + (NGW - 1 - gw); if (ms < M) xn_rows<1>(a, XN, ms, F.lane, gg); } }
}

__device__ __forceinline__ void p2a_item(Frame& F, const Args& a, int row0, int T, int hd, const float* h0, const float* cprev, float* out_h, float* out_conv) {
    LAS unsigned char* lds = F.lds;
    LAS float* XC = (LAS float*)(lds);
    LAS float* AS = (LAS float*)(lds + 32768);
    LAS float* US = (LAS float*)(lds + 65536);
    LAS bf16* XCB = (LAS bf16*)(lds + 98304);
    LAS float* SEGA = (LAS float*)(lds + 116736);
    LAS float* SEGB = (LAS float*)(lds + 118784);
    LAS float* CAR = (LAS float*)(lds + 120832);
    bf16* Z = (bf16*)(a.ws + WS_Z);
    const int tid = F.tid, lane = F.lane, wave = F.wave;
    const int tr = tid >> 3, cg = tid & 7, ch0 = hd * 64 + cg * 8;
    const int tb = wave >> 1, cb = wave & 1, jl = cb * 32 + (lane & 31), hi = lane >> 5;
    __syncthreads();
    typedef float f32x2c __attribute__((ext_vector_type(2)));
    f32x2c cw2[4][4], cbv2[4];
#pragma unroll
    for (int k = 0; k < 4; ++k) { const f32x4 w0 = *(const GAS f32x4*)(a.in[I_CW] + k * DM + ch0), w1 = *(const GAS f32x4*)(a.in[I_CW] + k * DM + ch0 + 4);
        cw2[k][0] = (f32x2c){w0.x, w0.y}; cw2[k][1] = (f32x2c){w0.z, w0.w}; cw2[k][2] = (f32x2c){w1.x, w1.y}; cw2[k][3] = (f32x2c){w1.z, w1.w}; }
    { const f32x4 w0 = *(const GAS f32x4*)(a.in[I_CB] + ch0), w1 = *(const GAS f32x4*)(a.in[I_CB] + ch0 + 4);
      cbv2[0] = (f32x2c){w0.x, w0.y}; cbv2[1] = (f32x2c){w0.z, w0.w}; cbv2[2] = (f32x2c){w1.x, w1.y}; cbv2[3] = (f32x2c){w1.z, w1.w}; }
    bf16x8 Br[4], Bi[4];
    { const bf16* gt = (const bf16*)(a.ws + WS_GT) + (size_t)hd * 8192;
#pragma unroll
      for (int ks = 0; ks < 4; ++ks) { Br[ks] = *(const GAS bf16x8*)(gt + jl * 64 + ks * 16 + hi * 8); Bi[ks] = *(const GAS bf16x8*)(gt + (64 + jl) * 64 + ks * 16 + hi * 8); } }
    float nba = -1.4426950408889634f * a.in[I_BA][hd * 64 + jl], nbx = -1.4426950408889634f * a.in[I_BX][hd * 64 + jl];
    float cA = -8.0f * log1pf(expf(-a.in[I_LAM][hd * 64 + jl])) * 1.4426950408889634f;
    asm volatile("" : "+v"(cA), "+v"(nba), "+v"(nbx));
    if (tid < 64) CAR[tid] = h0 ? h0[hd * 64 + tid] : 0.f;
    const int ntiles = (T + 127) >> 7;
    typedef float f32x2 __attribute__((ext_vector_type(2)));
    v4u xr[5], gg[2];
    const unsigned zbase = (unsigned)row0 * LDZ + ch0;
#define P2A_ISSUE(t0n) do { _Pragma("unroll") for (int r = 0; r < 5; ++r) { int tt = (t0n) + 2 * tr - 3 + r; tt = tt < 0 ? 0 : (tt > T - 1 ? T - 1 : tt); \
        xr[r] = *(const GAS v4u*)(Z + (zbase + (unsigned)tt * LDZ)); } } while (0)
    P2A_ISSUE(0);
    const int pc = tid & 31, sg8 = tid >> 5;
    for (int tile = 0; tile < ntiles; ++tile) {
        const int t0 = tile << 7, nrows = (T - t0) < 128 ? (T - t0) : 128, par = tile & 1;
        {
            f32x2 f[5][4];
#pragma unroll
            for (int r = 0; r < 5; ++r) { const v4u w = xr[r];
                f[r][0] = (f32x2){bflo(w.x), bfhi(w.x)}; f[r][1] = (f32x2){bflo(w.y), bfhi(w.y)}; f[r][2] = (f32x2){bflo(w.z), bfhi(w.z)}; f[r][3] = (f32x2){bflo(w.w), bfhi(w.w)}; }
            if (tile == 0 || nrows < 128) {
#pragma unroll
                for (int r = 0; r < 5; ++r) { const int tt = t0 + 2 * tr - 3 + r;
                    if (tt < 0) {
                        if (cprev) { const f32x4 p0 = *(const GAS f32x4*)(cprev + (tt + 3) * DM + ch0), p1 = *(const GAS f32x4*)(cprev + (tt + 3) * DM + ch0 + 4);
                            f[r][0] = (f32x2){p0.x, p0.y}; f[r][1] = (f32x2){p0.z, p0.w}; f[r][2] = (f32x2){p1.x, p1.y}; f[r][3] = (f32x2){p1.z, p1.w}; }
                        else {
#pragma unroll
                            for (int e = 0; e < 4; ++e) f[r][e] = (f32x2){0.f, 0.f}; }
                    } else if (tt >= T) {
#pragma unroll
                        for (int e = 0; e < 4; ++e) f[r][e] = (f32x2){0.f, 0.f}; } } }
            if (tile + 1 < ntiles) P2A_ISSUE(t0 + 128);
#pragma unroll
            for (int rr = 0; rr < 2; ++rr) { int tl = 2 * tr + rr; tl = tl < nrows ? tl : nrows - 1; gg[rr] = *(const GAS v4u*)(Z + (zbase + (unsigned)(t0 + tl) * LDZ + 1024u)); }
#pragma unroll
            for (int rr = 0; rr < 2; ++rr) { const int tl = 2 * tr + rr, t = t0 + tl; f32x2 xc[4];
#pragma unroll
                for (int e = 0; e < 4; ++e) xc[e] = cbv2[e] + cw2[0][e] * f[rr][e] + cw2[1][e] * f[rr + 1][e] + cw2[2][e] * f[rr + 2][e] + cw2[3][e] * f[rr + 3][e];
                *(LAS f32x4*)(XC + tl * 64 + cg * 8) = (f32x4){xc[0].x, xc[0].y, xc[1].x, xc[1].y}; *(LAS f32x4*)(XC + tl * 64 + cg * 8 + 4) = (f32x4){xc[2].x, xc[2].y, xc[3].x, xc[3].y};
                v4u pw; pw.x = pk2(xc[0].x, xc[0].y); pw.y = pk2(xc[1].x, xc[1].y); pw.z = pk2(xc[2].x, xc[2].y); pw.w = pk2(xc[3].x, xc[3].y);
                *(LAS v4u*)(XCB + tl * 72 + cg * 8) = pw;
                if (tile == ntiles - 1 && t >= T - 3 && t < T) { float* oc = out_conv + (size_t)(t - (T - 3)) * DM + ch0;
                    *(GAS f32x4*)oc = (f32x4){f[rr + 3][0].x, f[rr + 3][0].y, f[rr + 3][1].x, f[rr + 3][1].y}; *(GAS f32x4*)(oc + 4) = (f32x4){f[rr + 3][2].x, f[rr + 3][2].y, f[rr + 3][3].x, f[rr + 3][3].y}; }
            }
        }
        __syncthreads();
        if (tb * 32 < nrows) {
            f32x16 accr, acci;
#pragma unroll
            for (int i = 0; i < 16; ++i) { accr[i] = 0.f; acci[i] = 0.f; }
#pragma unroll
            for (int ks = 0; ks < 4; ++ks) { const bf16x8 A = *(const LAS bf16x8*)(XCB + (tb * 32 + (lane & 31)) * 72 + ks * 16 + hi * 8);
                accr = __builtin_amdgcn_mfma_f32_32x32x16_bf16(A, Br[ks], accr, 0, 0, 0);
                acci = __builtin_amdgcn_mfma_f32_32x32x16_bf16(A, Bi[ks], acci, 0, 0, 0); }
#pragma unroll
            for (int rg = 0; rg < 16; rg += 2) { const int tl = tb * 32 + (rg & 3) + 8 * (rg >> 2) + 4 * hi;
                const f32x2 xcv = (f32x2){XC[tl * 64 + jl], XC[tl * 64 + 64 + jl]};
                f32x2 er = (f32x2){accr[rg], accr[rg + 1]} * -1.4426950408889634f + nba, ei = (f32x2){acci[rg], acci[rg + 1]} * -1.4426950408889634f + nbx;
                er = (f32x2){__builtin_amdgcn_exp2f(er.x), __builtin_amdgcn_exp2f(er.y)} + 1.0f; ei = (f32x2){__builtin_amdgcn_exp2f(ei.x), __builtin_amdgcn_exp2f(ei.y)} + 1.0f;
                const f32x2 r = (f32x2){__builtin_amdgcn_rcpf(er.x), __builtin_amdgcn_rcpf(er.y)}, ig = (f32x2){__builtin_amdgcn_rcpf(ei.x), __builtin_amdgcn_rcpf(ei.y)};
                const f32x2 l2a = r * cA;
                const f32x2 av = (f32x2){__builtin_amdgcn_exp2f(l2a.x), __builtin_amdgcn_exp2f(l2a.y)};
                const f32x2 y = l2a * 1.3862943611198906f;
                const f32x2 ser = -y * (1.0f + y * (0.5f + y * 0.16666667f)), dir = 1.0f - av * av;
                const f32x2 om = (f32x2){(y.x > -0.02f) ? ser.x : dir.x, (y.y > -0.02f) ? ser.y : dir.y};
                const f32x2 uv = (f32x2){__builtin_amdgcn_sqrtf(om.x), __builtin_amdgcn_sqrtf(om.y)} * (ig * xcv);
                AS[tl * 64 + jl] = av.x; AS[tl * 64 + 64 + jl] = av.y; US[tl * 64 + jl] = uv.x; US[tl * 64 + 64 + jl] = uv.y; }
        }
        __syncthreads();
        if (tid < 256 && sg8 * 16 < nrows) { f32x2 Ap = (f32x2){1.f, 1.f}, Bp = (f32x2){0.f, 0.f};
#pragma unroll
            for (int s2 = 0; s2 < 16; ++s2) { const f32x2 av = *(const LAS f32x2*)(AS + (sg8 * 16 + s2) * 64 + 2 * pc), uv = *(const LAS f32x2*)(US + (sg8 * 16 + s2) * 64 + 2 * pc); Bp = av * Bp + uv; Ap *= av; }
            *(LAS f32x2*)(SEGA + sg8 * 64 + 2 * pc) = Ap; *(LAS f32x2*)(SEGB + sg8 * 64 + 2 * pc) = Bp; }
        __syncthreads();
        if (tid < 256 && sg8 * 16 < nrows) { f32x2 h = *(const LAS f32x2*)(CAR + par * 64 + 2 * pc);
            for (int sg = 0; sg < sg8; ++sg) h = *(const LAS f32x2*)(SEGA + sg * 64 + 2 * pc) * h + *(const LAS f32x2*)(SEGB + sg * 64 + 2 * pc);
#pragma unroll
            for (int s2 = 0; s2 < 16; ++s2) { const int tl = sg8 * 16 + s2; h = *(const LAS f32x2*)(AS + tl * 64 + 2 * pc) * h + *(const LAS f32x2*)(US + tl * 64 + 2 * pc); *(LAS f32x2*)(US + tl * 64 + 2 * pc) = h; }
            if (t0 + sg8 * 16 + 15 == T - 1) *(f32x2*)(out_h + hd * 64 + 2 * pc) = h;
            if (sg8 == 7) *(LAS f32x2*)(CAR + (par ^ 1) * 64 + 2 * pc) = h; }
        __syncthreads();
#pragma unroll
        for (int rr = 0; rr < 2; ++rr) { const int tl = 2 * tr + rr;
            if (tl < nrows) { const v4u w = gg[rr];
                const f32x4 h0v = *(const LAS f32x4*)(US + tl * 64 + cg * 8), h1v = *(const LAS f32x4*)(US + tl * 64 + cg * 8 + 4);
                const f32x2 y0 = (f32x2){h0v.x, h0v.y} * (f32x2){bflo(w.x), bfhi(w.x)}, y1 = (f32x2){h0v.z, h0v.w} * (f32x2){bflo(w.y), bfhi(w.y)};
                const f32x2 y2 = (f32x2){h1v.x, h1v.y} * (f32x2){bflo(w.z), bfhi(w.z)}, y3 = (f32x2){h1v.z, h1v.w} * (f32x2){bflo(w.w), bfhi(w.w)};
                v4u o; o.x = pk2(y0.x, y0.y); o.y = pk2(y1.x, y1.y); o.z = pk2(y2.x, y2.y); o.w = pk2(y3.x, y3.y);
                *(GAS v4u*)(Z + (zbase + (unsigned)(t0 + tl) * LDZ + 1024u)) = o; } }
    }
#undef P2A_ISSUE
}

__device__ __forceinline__ int vt_off(int d, int q) { return d * 256 + ((((q >> 3) ^ (d & 15) ^ ((d >> 4) & 7)) & 15) << 4) + (q & 7) * 2; }
__device__ __forceinline__ void p2b_item(Frame& F, const Args& a, int item, int g_lo, int g_hi) {
    LAS unsigned char* lds = F.lds;
    LAS unsigned char* VT = lds;
    LAS unsigned char* WM = lds + 32768;
    LAS float* SG = (LAS float*)(lds + 65536);
    LAS float* ST = (LAS float*)(lds + 65536 + 67584);
    bf16* Z = (bf16*)(a.ws + WS_Z);
    const int tid = F.tid, lane = F.lane, wave = F.wave;
    const bool sample = item >= MP / 128;
    const int row0 = item * 128;
    const bf16* Wm = (const bf16*)(a.ws + (sample ? WS_WSS : WS_WSM));
    const int cchunk = tid & 15, qg = tid >> 4;
    const int db = wave & 3, pb0 = (wave >> 2) * 2, hi = lane >> 5, l31 = lane & 31;
    typedef float f32x2 __attribute__((ext_vector_type(2)));
    v4u gvr[4], wmr[4]; f32x4 lgr[2], lbr[2]; float bsr[2];
    const unsigned zv0 = (unsigned)(row0 + qg * 4) * LDZ + 3072u + cchunk * 8;
    const unsigned zu0 = (unsigned)(row0 + (tid >> 4)) * LDZ + 2048u + (tid & 15) * 8;
    const unsigned lno = cchunk * 8, bso0 = sample ? l31 : pb0 * 32 + l31, bso1 = sample ? l31 : (pb0 + 1) * 32 + l31;
    const float* lng = a.in[I_LNG]; const float* lnb = a.in[I_LNB]; const float* bsp = a.in[I_BS];
#define P2B_ISSUE(g) do { lgr[0] = *(const GAS f32x4*)(lng + ((g) * 128 + lno)); lgr[1] = *(const GAS f32x4*)(lng + ((g) * 128 + lno + 4)); \
        lbr[0] = *(const GAS f32x4*)(lnb + ((g) * 128 + lno)); lbr[1] = *(const GAS f32x4*)(lnb + ((g) * 128 + lno + 4)); \
        bsr[0] = bsp[(g) * 128 + bso0]; bsr[1] = bsp[(g) * 128 + bso1]; \
        _Pragma("unroll") for (int r = 0; r < 4; ++r) { gvr[r] = *(const GAS v4u*)(Z + (zv0 + (unsigned)r * LDZ + (unsigned)(g) * 128u)); \
        wmr[r] = *(const GAS v4u*)(Wm + ((unsigned)(g) * 16384u + (unsigned)(tid + 512 * r) * 8u)); } } while (0)
    P2B_ISSUE(g_lo);
    __syncthreads();
    if (tid < 128) { const GAS f32x4* sp = (const GAS f32x4*)((const float*)(a.ws + WS_STAT) + (size_t)(row0 + tid) * 32); f32x4 w[8];
#pragma unroll
        for (int i = 0; i < 8; ++i) w[i] = sp[i];
        float s = 0.f, ss = 0.f;
#pragma unroll
        for (int i = 0; i < 8; ++i) { s += w[i].x; ss += w[i].y; s += w[i].z; ss += w[i].w; }
        const float mean = s * (1.f / 1024.f), var = fmaxf(ss * (1.f / 1024.f) - mean * mean, 0.f);
        ST[tid * 2] = mean; ST[tid * 2 + 1] = __builtin_amdgcn_rsqf(var + EPS); }
    __syncthreads();
    for (int g = g_lo; g < g_hi; ++g) {
        { const int d0 = cchunk * 8, col = g * 128 + d0;
          const f32x2 lg2[4] = {(f32x2){lgr[0].x, lgr[0].y}, (f32x2){lgr[0].z, lgr[0].w}, (f32x2){lgr[1].x, lgr[1].y}, (f32x2){lgr[1].z, lgr[1].w}};
          const f32x2 lb2[4] = {(f32x2){lbr[0].x, lbr[0].y}, (f32x2){lbr[0].z, lbr[0].w}, (f32x2){lbr[1].x, lbr[1].y}, (f32x2){lbr[1].z, lbr[1].w}};
          f32x2 vn[4][4];
#pragma unroll
          for (int r = 0; r < 4; ++r) { const int q = qg * 4 + r; const v4u w = gvr[r];
              const f32x2 ms = *(const LAS f32x2*)(ST + q * 2); const float rstd = ms.y, nmr = -ms.x * ms.y;
              vn[r][0] = ((f32x2){bflo(w.x), bfhi(w.x)} * rstd + nmr) * lg2[0] + lb2[0]; vn[r][1] = ((f32x2){bflo(w.y), bfhi(w.y)} * rstd + nmr) * lg2[1] + lb2[1];
              vn[r][2] = ((f32x2){bflo(w.z), bfhi(w.z)} * rstd + nmr) * lg2[2] + lb2[2]; vn[r][3] = ((f32x2){bflo(w.w), bfhi(w.w)} * rstd + nmr) * lg2[3] + lb2[3];
              if (sample) { float* ov = a.out + O_VS + (size_t)(row0 - MP + q) * DM + col;
                  *(GAS f32x4*)ov = (f32x4){vn[r][0].x, vn[r][0].y, vn[r][1].x, vn[r][1].y}; *(GAS f32x4*)(ov + 4) = (f32x4){vn[r][2].x, vn[r][2].y, vn[r][3].x, vn[r][3].y}; } }
#pragma unroll
          for (int ep = 0; ep < 4; ++ep) { v2u o; o.x = pk2(vn[0][ep].x, vn[1][ep].x); o.y = pk2(vn[2][ep].x, vn[3][ep].x); *(LAS v2u*)(VT + vt_off(d0 + 2 * ep, qg * 4)) = o;
              o.x = pk2(vn[0][ep].y, vn[1][ep].y); o.y = pk2(vn[2][ep].y, vn[3][ep].y); *(LAS v2u*)(VT + vt_off(d0 + 2 * ep + 1, qg * 4)) = o; }
#pragma unroll
          for (int r = 0; r < 4; ++r) { const int ch = tid + 512 * r; *(LAS v4u*)(WM + vt_off(ch >> 4, (ch & 15) * 8)) = wmr[r]; } }
        const float bs0 = bsr[0], bs1 = bsr[1];
        v4u gur[4];
#pragma unroll
        for (int r = 0; r < 4; ++r) gur[r] = *(const GAS v4u*)(Z + (zu0 + (unsigned)(32 * r) * LDZ + (unsigned)g * 128u));
        if (g + 1 < g_hi) P2B_ISSUE(g + 1);
        __syncthreads();
        { f32x16 acc[2];
#pragma unroll
          for (int i = 0; i < 16; ++i) { acc[0][i] = 0.f; acc[1][i] = 0.f; }
          const int kmax = (!sample && pb0 == 0) ? 4 : 8;
          const int d = db * 32 + l31;
#pragma unroll
          for (int ks = 0; ks < 8; ++ks) { if (ks < kmax) { const bf16x8 A = *(const LAS bf16x8*)(VT + vt_off(d, ks * 16 + hi * 8));
#pragma unroll
              for (int pi = 0; pi < 2; ++pi) { const bf16x8 B = *(const LAS bf16x8*)(WM + vt_off((pb0 + pi) * 32 + l31, ks * 16 + hi * 8));
                  acc[pi] = __builtin_amdgcn_mfma_f32_32x32x16_bf16(A, B, acc[pi], 0, 0, 0); } } }
#pragma unroll
          for (int pi = 0; pi < 2; ++pi) { const int p = (pb0 + pi) * 32 + l31; const float bs = pi ? bs1 : bs0;
#pragma unroll
              for (int rq = 0; rq < 4; ++rq) *(LAS f32x4*)(SG + p * 132 + db * 32 + 8 * rq + 4 * hi) = (f32x4){acc[pi][rq * 4 + 0], acc[pi][rq * 4 + 1], acc[pi][rq * 4 + 2], acc[pi][rq * 4 + 3]} + bs; } }
        __syncthreads();
#pragma unroll
        for (int r = 0; r < 4; ++r) { const int p = (tid >> 4) + 32 * r, c8 = (tid & 15) * 8;
            const f32x4 s0 = *(const LAS f32x4*)(SG + p * 132 + c8), s1 = *(const LAS f32x4*)(SG + p * 132 + c8 + 4); const v4u w = gur[r];
            const f32x2 y0 = (f32x2){s0.x, s0.y} * (f32x2){bflo(w.x), bfhi(w.x)}, y1 = (f32x2){s0.z, s0.w} * (f32x2){bflo(w.y), bfhi(w.y)};
            const f32x2 y2 = (f32x2){s1.x, s1.y} * (f32x2){bflo(w.z), bfhi(w.z)}, y3 = (f32x2){s1.z, s1.w} * (f32x2){bflo(w.w), bfhi(w.w)};
            v4u o; o.x = pk2(y0.x, y0.y); o.y = pk2(y1.x, y1.y); o.z = pk2(y2.x, y2.y); o.w = pk2(y3.x, y3.y);
            *(GAS v4u*)(Z + (zu0 + (unsigned)(32 * r) * LDZ + (unsigned)g * 128u)) = o; }
    }
#undef P2B_ISSUE
}

__device__ __forceinline__ void p5_rows(Frame& F, const Args& a) {
    const int gw = F.vcu * NWAVES + F.wave, NGW = F.G * NWAVES, lane = F.lane;
    const bf16* MIX = (const bf16*)(a.ws + WS_MIX); bf16* X1 = (bf16*)(a.ws + WS_XN); float* RS2 = (float*)(a.ws + WS_RSTD2);
    f32x4 g1[4];
#pragma unroll
    for (int j = 0; j < 4; ++j) g1[j] = ((const GAS f32x4*)a.in[I_GPOST])[lane + 64 * j];
#define P5_LOAD(m_, x_, w_) do { const GAS f32x4* xr = (const GAS f32x4*)xrow_ptr(a, (m_)) + lane; const GAS v2u* mr = (const GAS v2u*)(MIX + (size_t)(m_) * LDX) + lane; \
        _Pragma("unroll") for (int j = 0; j < 4; ++j) { x_[j] = __builtin_nontemporal_load(xr + 64 * j); w_[j] = mr[64 * j]; } } while (0)
#define P5_FINISH(m_, x_, w_) do { f32x4 mx[4]; float s = 0.f; \
        _Pragma("unroll") for (int j = 0; j < 4; ++j) { const v2u w = w_[j]; mx[j] = (f32x4){bflo(w.x), bfhi(w.x), bflo(w.y), bfhi(w.y)}; \
            s += (mx[j].x * mx[j].x + mx[j].y * mx[j].y) + (mx[j].z * mx[j].z + mx[j].w * mx[j].w); } \
        const float r1 = __builtin_amdgcn_rsqf(wave_sum(s) * (1.f / DM) + EPS); float s2 = 0.f; \
        _Pragma("unroll") for (int j = 0; j < 4; ++j) { x_[j] = x_[j] + mx[j] * r1 * g1[j]; s2 += (x_[j].x * x_[j].x + x_[j].y * x_[j].y) + (x_[j].z * x_[j].z + x_[j].w * x_[j].w); } \
        const float ms2 = wave_sum(s2) * (1.f / DM) + EPS, r2 = __builtin_amdgcn_rsqf(ms2); \
        if (lane == 0) RS2[(m_)] = ms2 * r2;        \
        GAS v2u* o8 = (GAS v2u*)(X1 + (size_t)(m_) * LDX) + lane; \
        _Pragma("unroll") for (int j = 0; j < 4; ++j) { const f32x4 h = x_[j] * r2; v2u o; o.x = pk2(h.x, h.y); o.y = pk2(h.z, h.w); __hip_atomic_store((unsigned long long*)(o8 + 64 * j), (unsigned long long)o.x | ((unsigned long long)o.y << 32), __ATOMIC_RELAXED, __HIP_MEMORY_SCOPE_AGENT); } } while (0)
    { f32x4 xa[4], xb[4]; v2u wa[4], wb[4];
      const bool extra = gw < MS;
      if (extra) P5_LOAD(MP + gw, xb, wb);
      P5_LOAD(gw, xa, wa);
      if (extra) P5_FINISH(MP + gw, xb, wb);
      P5_FINISH(gw, xa, wa);
      for (int m = gw + NGW; m < MP; m += NGW) { P5_LOAD(m, xa, wa); P5_FINISH(m, xa, wa); } }
#undef P5_LOAD
#undef P5_FINISH
}
__device__ __forceinline__ void p8_rows(Frame& F, const Args& a) {
    const int gw = F.vcu * NWAVES + F.wave, NGW = F.G * NWAVES, lane = F.lane;
    const bf16* MIX = (const bf16*)(a.ws + WS_MIX); const bf16* FF = (const bf16*)(a.ws + WS_F);
    f32x4 g1[4], g3[4];
#pragma unroll
    for (int j = 0; j < 4; ++j) { g1[j] = ((const GAS f32x4*)a.in[I_GPOST])[lane + 64 * j]; g3[j] = ((const GAS f32x4*)a.in[I_GPF])[lane + 64 * j]; }
    for (int m = MP + gw; m < M; m += NGW) { const GAS f32x4* xr = (const GAS f32x4*)xrow_ptr(a, m) + lane; const GAS v2u* mr = (const GAS v2u*)(MIX + (size_t)m * LDX) + lane; const GAS v2u* fr = (const GAS v2u*)(FF + (size_t)m * LDX) + lane;
        f32x4 x[4], mx[4], fx[4]; float s = 0.f, sf = 0.f;
#pragma unroll
        for (int j = 0; j < 4; ++j) { x[j] = xr[64 * j]; const v2u w = mr[64 * j]; mx[j] = (f32x4){bflo(w.x), bfhi(w.x), bflo(w.y), bfhi(w.y)}; const v2u wf = fr[64 * j]; fx[j] = (f32x4){bflo(wf.x), bfhi(wf.x), bflo(wf.y), bfhi(wf.y)};
            s += (mx[j].x * mx[j].x + mx[j].y * mx[j].y) + (mx[j].z * mx[j].z + mx[j].w * mx[j].w); sf += (fx[j].x * fx[j].x + fx[j].y * fx[j].y) + (fx[j].z * fx[j].z + fx[j].w * fx[j].w); }
        const float r1 = __builtin_amdgcn_rsqf(wave_sum(s) * (1.f / DM) + EPS), r3 = __builtin_amdgcn_rsqf(wave_sum(sf) * (1.f / DM) + EPS);
        GAS f32x4* o = (GAS f32x4*)(a.out + O_Y + (size_t)m * DM) + lane;
#pragma unroll
        for (int j = 0; j < 4; ++j) o[64 * j] = x[j] + mx[j] * r1 * g1[j] + fx[j] * r3 * g3[j]; }
}

typedef float f32x4s __attribute__((ext_vector_type(4)));
template <int MODE, int NSTEPS>
__device__ __forceinline__ void small_gemm2(Frame& F, const bf16* A, int lda, const bf16* Bt, int ldb, bf16* O, int ldo, const bf16* Zg) {
    constexpr int NS = 2 * NSTEPS, SLOT = 24576, NSLOT = 5;
    LAS unsigned char* lds = F.lds;
    LAS float* RED = (LAS float*)F.lds;
    const int tid = F.tid, lane = F.lane, wave = F.wave, kc = lane >> 4, l15 = lane & 15;
    int aR[2], aC[2], bR, bC;
#pragma unroll
    for (int i = 0; i < 2; ++i) { const int b = tid * 16 + i * 8192, st = b >> 10, in = b & 1023, sb = in ^ (((in >> 9) & 1) << 5); aR[i] = (st >> 2) * 16 + (sb >> 6); aC[i] = (st & 3) * 32 + ((sb & 63) >> 1); }
    { const int b = tid * 16, st = b >> 10, in = b & 1023, sb = in ^ (((in >> 9) & 1) << 5); bR = (st >> 2) * 16 + (sb >> 6); bC = (st & 3) * 32 + ((sb & 63) >> 1); }
    const int ob = l15 * 64 + kc * 16, inner = ob ^ (((ob >> 9) & 1) << 5);
    const int ti = wave >> 1, tj = wave & 1;
    for (int task = blockIdx.x; task < 256; task += F.G) {
        const int mt = task & 7, nt = task >> 3;
        const int r0 = MP + mt * 64, c0 = nt * 32;
        const char* pa0 = (const char*)(A + (size_t)(r0 + aR[0]) * lda + aC[0]); const char* pa1 = (const char*)(A + (size_t)(r0 + aR[1]) * lda + aC[1]);
        const char* pb0 = (const char*)(Bt + (size_t)(c0 + bR) * ldb + bC);
#define SG2_STAGE(t) do { LAS unsigned char* sl = lds + ((t) % NSLOT) * SLOT + wave * 1024; \
            __builtin_amdgcn_global_load_lds((const unsigned*)(pa0 + (size_t)(t) * 256), (LAS unsigned*)sl, 16, 0, 0); \
            __builtin_amdgcn_global_load_lds((const unsigned*)(pa1 + (size_t)(t) * 256), (LAS unsigned*)(sl + 8192), 16, 0, 0); \
            __builtin_amdgcn_global_load_lds((const unsigned*)(pb0 + (size_t)(t) * 256), (LAS unsigned*)(sl + 16384), 16, 0, 0); } while (0)
        f32x4s accA = (f32x4s){0.f, 0.f, 0.f, 0.f}, accB = accA;
        __syncthreads();
#pragma unroll
        for (int t = 0; t < 4; ++t) if (t < NS) SG2_STAGE(t);
        for (int t = 0; t < NS; ++t) {
            const int rem = NS - 1 - t;
            if (rem >= 3) asm volatile("s_waitcnt vmcnt(9)" ::: "memory"); else if (rem == 2) asm volatile("s_waitcnt vmcnt(6)" ::: "memory"); else if (rem == 1) asm volatile("s_waitcnt vmcnt(3)" ::: "memory"); else asm volatile("s_waitcnt vmcnt(0)" ::: "memory");
            __builtin_amdgcn_s_barrier();
            if (t + 4 < NS) SG2_STAGE(t + 4);
            const LAS unsigned char* sl = lds + (t % NSLOT) * SLOT;
            bf16x8 fa[4], fb[4];
#pragma unroll
            for (int q = 0; q < 4; ++q) { fa[q] = *(const LAS bf16x8*)(sl + (ti * 4 + q) * 1024 + inner); fb[q] = *(const LAS bf16x8*)(sl + 16384 + (tj * 4 + q) * 1024 + inner); }
            if (MODE == 1 && t >= NS / 2) {
#pragma unroll
                for (int q = 0; q < 4; ++q) accB = __builtin_amdgcn_mfma_f32_16x16x32_bf16(fa[q], fb[q], accB, 0, 0, 0);
            } else {
#pragma unroll
                for (int q = 0; q < 4; ++q) accA = __builtin_amdgcn_mfma_f32_16x16x32_bf16(fa[q], fb[q], accA, 0, 0, 0);
            }
        }
#undef SG2_STAGE
        __syncthreads();
#pragma unroll
        for (int rg = 0; rg < 4; ++rg) { RED[(16 * ti + 4 * kc + rg) * 36 + 16 * tj + l15] = accA[rg]; if (MODE == 1) RED[2304 + (16 * ti + 4 * kc + rg) * 36 + 16 * tj + l15] = accB[rg]; }
        __syncthreads();
        { const int row = tid >> 3, c4 = (tid & 7) * 4, col = c0 + c4; f32x4 v = *(const LAS f32x4*)(RED + row * 36 + c4);
            if (MODE == 1) { const f32x4 oa = v, ob2 = *(const LAS f32x4*)(RED + 2304 + row * 36 + c4);
                const int rg = r0 + row, rr = rg & 255, cc = col & 127;
                const size_t go = ((size_t)(rg >> 8) * 8 + (col >> 7)) * 32768 + (size_t)(((rr >> 7) * 4 + ((rr >> 4) & 3)) * 512 + ((((rr >> 6) & 1) * 4 + (cc >> 5)) * 64 + ((cc >> 3) & 3) * 16 + (rr & 15))) * 8 + (cc & 7);
                const v2u ga = *(const GAS v2u*)(Zg + go), gb = *(const GAS v2u*)(Zg + (WS_GB - WS_GR) / 2 + go);
                v.x = bflo(gb.x) * (bflo(ga.x) * oa.x + ob2.x); v.y = bfhi(gb.x) * (bfhi(ga.x) * oa.y + ob2.y); v.z = bflo(gb.y) * (bflo(ga.y) * oa.z + ob2.z); v.w = bfhi(gb.y) * (bfhi(ga.y) * oa.w + ob2.w); }
            v2u o; o.x = pk2(v.x, v.y); o.y = pk2(v.z, v.w);
            *(GAS v2u*)(O + (size_t)(r0 + row) * ldo + col) = o; }
    }
    __syncthreads();
}
template <class Epi, int STAGE, int NPN, int NIT, bool RANK>
__device__ __forceinline__ void tail_tasks(Frame& F, const Args& a, const pg8::Gemm& g, const Epi& E, unsigned* ticket) {
    constexpr int NHU = 4 * NPN, NCH = (NIT + NWAVES - 1) / NWAVES;
    bool have = false;
    if (RANK) {
        if (F.tid == 0) { const unsigned r = __hip_atomic_fetch_add(ticket + 32, 1u, RLX_AGENT), t0 = __hip_atomic_fetch_add(ticket, 1u, RLX_AGENT); F.MISC[17] = r; F.MISC[16] = t0; }
        __syncthreads(); F.rank = __builtin_amdgcn_readfirstlane((int)F.MISC[17]); have = true; }
    for (;;) {
        if (!have) { if (F.tid == 0) F.MISC[16] = __hip_atomic_fetch_add(ticket, 1u, RLX_AGENT); __syncthreads(); }
        have = false;
        const int t = (int)F.MISC[16];
        __syncthreads();
        if (t < NHU) { pg8::Unit hu{MP / 128 + (t & 3), t >> 2}; pg8::gemm_half_unit<Epi>(F.lds + RING_OFF, g, hu, E); }
        else if (t < NHU + NCH) { const int c = t - NHU; p0_items(F, a, STAGE, NWAVES * c + F.wave, NWAVES, NWAVES * c + NWAVES); }
        else break;
    }
}

__global__ void __launch_bounds__(NWAVES * 64, 2) hawk_fwd(Args args) {
    extern __shared__ __attribute__((aligned(16))) unsigned char lds[];
    Frame F;
    F.lds = (LAS unsigned char*)lds;
    F.MISC = (volatile LAS unsigned*)(F.lds + MISC_OFF);
    F.tid = threadIdx.x; F.lane = F.tid & 63; F.wave = __builtin_amdgcn_readfirstlane(F.tid >> 6);
    F.rank = (int)blockIdx.x; F.G = gridDim.x; { const int bx = blockIdx.x; F.vcu = (F.G % 8 == 0) ? (bx % 8) * (F.G / 8) + bx / 8 : bx; }
    unsigned char* ws = args.ws;
    F.ctl = (gu32*)(ws + WS_CTL);
    for (int u = F.tid; u < (LDS_BYTES - LDSCTL_OFF) / 4; u += NWAVES * 64) ((LAS unsigned*)(F.lds + LDSCTL_OFF))[u] = 0u;
    __syncthreads();
    XcdBarrier bar; bar.bar = (unsigned*)(F.ctl + CW_BAR); bar.x = 0; bar.st = nullptr;
    if (N_LAUNCHES != PER_PHASE) bar = xcd_barrier_post((unsigned*)(F.ctl + CW_BAR), F.MISC + 8);
#define GRID_BAR() do { if (N_LAUNCHES != PER_PHASE) xcd_barrier(bar); } while (0)
    volatile LAS unsigned long long* tsb = (volatile LAS unsigned long long*)(F.lds + LDSCTL_OFF + 1024);
#define TS(i) do { if (PROBE_TA >= 0 && blockIdx.x == PROBE_BLK && F.tid == 0) tsb[i] = __builtin_amdgcn_s_memrealtime(); } while (0)
    TS(63);
    const int lo = args.ph_lo, hi = args.ph_hi;
#define IN(k) (lo <= (k) && (k) < hi)
#define BOTH(k) (IN(k) && IN((k) + 1))
    bf16* XN = (bf16*)(ws + WS_XN); bf16* Z = (bf16*)(ws + WS_Z);

#define PH0() do { p0_prologue(F, args); } while (0)
#define PH1() do { pg8::Gemm g{XN, (const bf16*)(ws + WS_W1), LDX, LDX, DM}; pg8::StaticOrder S; S.init(MP, DIN, F.G, (int)blockIdx.x); pg8::EpiZ E{Z, LDZ, (float*)(ws + WS_STAT), (bf16*)(ws + WS_GR), (bf16*)(ws + WS_GB)}; \
        pg8::gemm_phase<pg8::EpiZ, pg8::StaticOrder, PG8_ALIGN, PG8_SP2>(F.lds + RING_OFF, g, S, E); TS(50); \
        tail_tasks<pg8::EpiZ, 1, DIN / 256, 3 * (DM / 64) * (DM / 32) + (DM / 64) * (DFF2 / 32), true>(F, args, g, E, (unsigned*)(F.ctl + CW_TKT)); } while (0)
#define PH3() do { pg8::Gemm g{Z + 1024, (const bf16*)(ws + WS_W2), LDZ, LDW2, 2048}; pg8::StaticOrder S; S.init(MP, DM, F.G, (int)blockIdx.x); pg8::EpiGate E{(const bf16*)(ws + WS_GR), (const bf16*)(ws + WS_GB), XN, LDX}; \
        const bool small_first3 = (blockIdx.x & 4) == 0;     \
        if (small_first3) small_gemm2<1, 8>(F, Z + 1024, LDZ, (const bf16*)(ws + WS_W2), LDW2, XN, LDX, (const bf16*)(ws + WS_GR)); \
        pg8::gemm_phase<pg8::EpiGate, pg8::StaticOrder, PG8_ALIGN, PG8_SP2>(F.lds + RING_OFF, g, S, E); \
        if (!small_first3) small_gemm2<1, 8>(F, Z + 1024, LDZ, (const bf16*)(ws + WS_W2), LDW2, XN, LDX, (const bf16*)(ws + WS_GR)); } while (0)
#define PH4() do { pg8::Gemm g{XN, (const bf16*)(ws + WS_W3), LDX, LDX, DM}; pg8::StaticOrder S; S.init(MP, DM, F.G, (int)blockIdx.x); pg8::EpiBf16 E{(bf16*)(ws + WS_MIX), LDX}; \
        pg8::gemm_phase<pg8::EpiBf16, pg8::StaticOrder, PG8_ALIGN, PG8_SP2>(F.lds + RING_OFF, g, S, E); \
        small_gemm2<2, 4>(F, XN, LDX, (const bf16*)(ws + WS_W3), LDX, (bf16*)(ws + WS_MIX), LDX, nullptr); } while (0)
#define PH5() do { p5_rows(F, args); } while (0)
#define PH6() do { pg8::Gemm g{XN, (const bf16*)(ws + WS_W4), LDX, LDX, DM}; pg8::StaticOrder S; S.init(MP, DFF2, F.G, (int)blockIdx.x); pg8::EpiSwiGLU E{(bf16*)(ws + WS_FIN), DFF}; \
          \
        for (int id = F.rank; id < 4 * (DFF2 / 256); id += F.G) { pg8::Unit hu{MP / 128 + (id & 3), id >> 2}; pg8::gemm_half_unit<pg8::EpiSwiGLU>(F.lds + RING_OFF, g, hu, E); } \
        pg8::gemm_phase<pg8::EpiSwiGLU, pg8::StaticOrder, PG8_ALIGN, PG8_SP2>(F.lds + RING_OFF, g, S, E); TS(52); \
        tail_tasks<pg8::EpiSwiGLU, 2, 0, (DFF / 64) * (DM / 32), false>(F, args, g, E, (unsigned*)(F.ctl + CW_TKT + 64)); } while (0)
#define PH7() do { pg8::Gemm g{(const bf16*)(ws + WS_FIN), (const bf16*)(ws + WS_W5), DFF, DFF, DFF}; pg8::StaticOrder S; S.init(MP, DM, F.G, (int)blockIdx.x); \
        pg8::EpiFinal E{XN, LDX, (const float*)(ws + WS_RSTD2), args.in[I_GPF], args.out, (float*)(ws + WS_CTL + 512 * 1024), (unsigned*)(F.ctl + CW_SEAM), F.lds + RING_BYTES};     \
        const bool small_first = (blockIdx.x & 4) == 0;     \
        if (small_first) small_gemm2<2, 11>(F, (const bf16*)(ws + WS_FIN), DFF, (const bf16*)(ws + WS_W5), DFF, (bf16*)(ws + WS_F), LDX, nullptr); \
        pg8::gemm_phase<pg8::EpiFinal, pg8::StaticOrder, PG8_ALIGN, PG8_SP2>(F.lds + RING_OFF, g, S, E); \
        if (!small_first) small_gemm2<2, 11>(F, (const bf16*)(ws + WS_FIN), DFF, (const bf16*)(ws + WS_W5), DFF, (bf16*)(ws + WS_F), LDX, nullptr); } while (0)
#define PH8() do { p8_rows(F, args); } while (0)
#define RUN(k, PH) do { if (IN(k)) { PH(); if (PROBE_DOUBLE == (k)) { GRID_BAR(); PH(); } TS(2 * (k)); if (BOTH(k)) GRID_BAR(); TS(2 * (k) + 1); } } while (0)
    RUN(0, PH0);
    RUN(1, PH1);
    if (IN(2)) {
        for (int it = blockIdx.x; it < 2 * NB * 16; it += F.G) {
            if (it < NB * 16) { const int b = it >> 4, hd = it & 15;
                p2a_item(F, args, b * SEQ, SEQ, hd, nullptr, nullptr, args.out + O_HP + (size_t)b * DM, args.out + O_CP + (size_t)b * 3 * DM); }
            else { const int b = (it - NB * 16) >> 4, hd = it & 15;
                p2a_item(F, args, MP + b * DEC_T, DEC_T, hd, args.in[I_SH] + (size_t)b * DM, args.in[I_SC] + (size_t)b * 3 * DM, args.out + O_HS + (size_t)b * DM, args.out + O_CS + (size_t)b * 3 * DM); }
        }
        TS(40);
        for (int it = blockIdx.x; it < MP / 128; it += F.G) p2b_item(F, args, it, 0, 8);
        for (int it = blockIdx.x; it < 32; it += F.G) p2b_item(F, args, MP / 128 + (it >> 3), it & 7, (it & 7) + 1);
        TS(4);
        if (BOTH(2)) GRID_BAR();
        TS(5);
    }
    RUN(3, PH3);
    RUN(4, PH4);
    RUN(5, PH5);
    RUN(6, PH6);
    RUN(7, PH7);
    RUN(8, PH8);
    if (PROBE_TA >= 0 && blockIdx.x == PROBE_BLK && F.tid == 0) { unsigned long long d = (tsb[PROBE_TB] - tsb[PROBE_TA]) * PROBE_MULT; if (PROBE_TA == 100) { d = 0; for (int k = 0; k < 8; ++k) d += (tsb[2 * k + 1] - tsb[2 * k]) * PROBE_MULT; } const unsigned long long t0 = __builtin_amdgcn_s_memrealtime();
        while (__builtin_amdgcn_s_memrealtime() - t0 < d) __builtin_amdgcn_s_sleep(16); }
#undef IN
#undef BOTH
#undef GRID_BAR
}

extern "C" void kernel_launch(void* const* d_in, const int* in_sizes, int n_in, void* d_out, int out_size, void* d_ws, size_t ws_size, hipStream_t stream) {
    static int grid = 0;
    if (grid == 0) {
        if (n_in != N_IN || in_sizes[0] != MP * DM || (size_t)out_size != O_END || ws_size < WS_END) {
            fprintf(stderr, "kernel_launch: shape mismatch (n_in %d, in0 %d, out %d, ws %zu; need ws >= %zu); nothing launched\n", n_in, n_in > 0 ? in_sizes[0] : -1, out_size, ws_size, (size_t)WS_END); grid = -1; return; }
        int dev = 0, cus = 0, per_cu = 0;
        if (hipGetDevice(&dev) != hipSuccess || hipDeviceGetAttribute(&cus, hipDeviceAttributeMultiprocessorCount, dev) != hipSuccess) { fprintf(stderr, "kernel_launch: device query failed\n"); grid = -1; return; }
        if (hipFuncSetAttribute((const void*)hawk_fwd, hipFuncAttributeMaxDynamicSharedMemorySize, LDS_BYTES) != hipSuccess) { fprintf(stderr, "kernel_launch: hipFuncSetAttribute failed\n"); grid = -1; return; }
        if (hipOccupancyMaxActiveBlocksPerMultiprocessor(&per_cu, (const void*)hawk_fwd, NWAVES * 64, LDS_BYTES) != hipSuccess || per_cu < 1) {
            fprintf(stderr, "kernel_launch: occupancy query reports %d workgroups per CU; nothing launched\n", per_cu); (void)hipGetLastError(); grid = -1; return; }
        grid = cus;
    }
    if (grid < 0) return;
    if (hipMemsetAsync((char*)d_ws + WS_CTL, 0, CTL_ZERO_BYTES, stream) != hipSuccess) { fprintf(stderr, "kernel_launch: memset failed\n"); return; }
    Args a{};
    for (int i = 0; i < N_IN; ++i) a.in[i] = (const float*)d_in[i];
    a.out = (float*)d_out; a.ws = (unsigned char*)d_ws;
    for (int li = 0; li < N_LAUNCHES; ++li) {
        a.ph_lo = (N_LAUNCHES == PER_PHASE) ? li : 0; a.ph_hi = (N_LAUNCHES == PER_PHASE) ? li + 1 : PER_PHASE; a.li = li;
        hipLaunchKernelGGL(hawk_fwd, dim3(grid), dim3(NWAVES * 64), LDS_BYTES, stream, a);
        const hipError_t le = hipPeekAtLastError();
        if (le != hipSuccess) { fprintf(stderr, "kernel_launch: launch %d failed: %s\n", li, hipGetErrorName(le)); break; }
    }
}
```
